# Optimizing an MI355X kernel written in HIP

```python
import jax, jax.numpy as jnp
from jax import lax
import numpy as np

D_MODEL = 1024
BATCH = 16
SEQ = 2048
DEPTH = 1

GRID_W = 64
NA_HEADS = 8
NA_HEAD_DIM = 64
NA_WIN_H_MAX = 8
NA_WIN_W = 16
NA_WIDTH = NA_HEADS * NA_HEAD_DIM
MLA_HEADS = 8
MLA_Q_RANK = 384
MLA_KV_RANK = 256
MLA_NOPE_DIM = 64
MLA_ROPE_DIM = 32
MLA_V_DIM = 64
MLA_WIDTH = MLA_HEADS * MLA_V_DIM
ROPE_BASE = 10000.0
Q_BLOCK = 128
MIX_WIDTH = NA_WIDTH + MLA_WIDTH
IN_PROJ_WIDTH = 3 * NA_WIDTH + MLA_Q_RANK + MLA_KV_RANK + MLA_ROPE_DIM
PEER_HEADS = 8
PEER_N_KEYS = 128
PEER_N_EXPERTS = PEER_N_KEYS * PEER_N_KEYS
PEER_KEY_DIM = 256
PEER_TOPK = 16
PEER_CHUNK = 128
PLE_DIM = 256
DN_ALPHA = float((2 * DEPTH) ** 0.25)
DN_BETA = float((8 * DEPTH) ** -0.25)
LN_EPS = 1e-5

kernel_name = "hybrid_na_mla_peer_deepnorm_block"


def layer_norm(x, g, b):
    xf = x.astype(jnp.float32)
    mu = jnp.mean(xf, axis=-1, keepdims=True)
    var = jnp.mean(jnp.square(xf - mu), axis=-1, keepdims=True)
    y = (xf - mu) * lax.rsqrt(var + LN_EPS)
    return (y * g.astype(jnp.float32) + b.astype(jnp.float32)).astype(x.dtype)


def rms_norm(x, g):
    xf = x.astype(jnp.float32)
    y = xf * lax.rsqrt(jnp.mean(jnp.square(xf), axis=-1, keepdims=True) + LN_EPS)
    return (y * g.astype(jnp.float32)).astype(x.dtype)


def rope_2d_tables(seq, dtype):
    t = jnp.arange(seq)
    row = (t // GRID_W).astype(jnp.float32)
    col = (t % GRID_W).astype(jnp.float32)
    axis_dim = MLA_ROPE_DIM // 2
    inv = ROPE_BASE ** (-jnp.arange(0, axis_dim, 2, dtype=jnp.float32) / axis_dim)
    ang = jnp.concatenate([row[:, None] * inv[None, :], col[:, None] * inv[None, :]], axis=-1)
    return jnp.cos(ang).astype(dtype), jnp.sin(ang).astype(dtype)


def apply_rope(x, cos, sin):
    xp = x.reshape(x.shape[:-1] + (MLA_ROPE_DIM // 2, 2))
    x1, x2 = xp[..., 0], xp[..., 1]
    out = jnp.stack([x1 * cos - x2 * sin, x1 * sin + x2 * cos], axis=-1)
    return out.reshape(x.shape)


def neighbourhood_attention(q, k, v, rpb):
    b, s, h, dh = q.shape
    rows = s // GRID_W
    kh = min(NA_WIN_H_MAX, rows)
    kw = NA_WIN_W
    qg = q.reshape(b, rows, GRID_W, h, dh)
    kg = k.reshape(b, rows, GRID_W, h, dh)
    vg = v.reshape(b, rows, GRID_W, h, dh)
    cols = jnp.arange(GRID_W)
    col_start = jnp.clip(cols - kw // 2, 0, GRID_W - kw)
    col_idx = col_start[:, None] + jnp.arange(kw)[None, :]
    dj = col_idx - cols[:, None] + (NA_WIN_W - 1)
    row_ids = jnp.arange(rows)
    row_start = jnp.clip(row_ids - kh // 2, 0, rows - kh)
    scale = dh ** -0.5

    def one_row(args):
        q_row, r, rs = args
        k_band = lax.dynamic_slice_in_dim(kg, rs, kh, axis=1)
        v_band = lax.dynamic_slice_in_dim(vg, rs, kh, axis=1)
        k_win = k_band[:, :, col_idx]
        v_win = v_band[:, :, col_idx]
        di = rs + jnp.arange(kh) - r + (NA_WIN_H_MAX - 1)
        bias = rpb[:, di][:, :, dj]
        bias = jnp.transpose(bias, (0, 2, 1, 3)).astype(jnp.float32)
        sc = jnp.einsum('bqhd,biqjhd->bhqij', q_row * scale, k_win).astype(jnp.float32) + bias[None]
        pr = jax.nn.softmax(sc.reshape(b, h, GRID_W, kh * kw), axis=-1)
        pr = pr.reshape(b, h, GRID_W, kh, kw).astype(v.dtype)
        return jnp.einsum('bhqij,biqjhd->bqhd', pr, v_win)

    out = lax.map(one_row, (jnp.moveaxis(qg, 1, 0), row_ids, row_start))
    return jnp.moveaxis(out, 0, 1).reshape(b, s, h * dh)


def latent_attention(c_q, c_kv, k_r, q_norm_g, kv_norm_g, w_uq, w_ukv, cos, sin):
    b, s, _ = c_kv.shape
    qd = MLA_NOPE_DIM + MLA_ROPE_DIM
    q = (rms_norm(c_q, q_norm_g) @ w_uq).reshape(b, s, MLA_HEADS, qd)
    q_nope, q_rope = q[..., :MLA_NOPE_DIM], q[..., MLA_NOPE_DIM:]
    q_rope = apply_rope(q_rope, cos[:, None, :], sin[:, None, :])
    kv = (rms_norm(c_kv, kv_norm_g) @ w_ukv).reshape(b, s, MLA_HEADS, MLA_NOPE_DIM + MLA_V_DIM)
    k_nope, v = kv[..., :MLA_NOPE_DIM], kv[..., MLA_NOPE_DIM:]
    k_rope = apply_rope(k_r, cos, sin)
    k_rope = jnp.broadcast_to(k_rope[:, :, None, :], (b, s, MLA_HEADS, MLA_ROPE_DIM))
    q = jnp.concatenate([q_nope, q_rope], axis=-1) * (qd ** -0.5)
    k = jnp.concatenate([k_nope, k_rope], axis=-1)
    nq = s // Q_BLOCK
    qb = jnp.moveaxis(q.reshape(b, nq, Q_BLOCK, MLA_HEADS, qd), 1, 0)

    def one_block(q_blk):
        sc = jnp.einsum('bqhd,bkhd->bhqk', q_blk, k).astype(jnp.float32)
        pr = jax.nn.softmax(sc, axis=-1).astype(v.dtype)
        return jnp.einsum('bhqk,bkhd->bqhd', pr, v)

    out = lax.map(one_block, qb)
    return jnp.moveaxis(out, 0, 1).reshape(b, s, MLA_WIDTH)


def peer_ffn(x, w_q, sub_keys, u_table, v_table):
    b, s, d = x.shape
    half = PEER_KEY_DIM // 2
    xc = x.reshape((b * s) // PEER_CHUNK, PEER_CHUNK, d)

    def one_chunk(xb):
        q = (xb @ w_q).reshape(PEER_CHUNK, PEER_HEADS, PEER_KEY_DIM)
        s1 = jnp.einsum('thd,kd->thk', q[..., :half], sub_keys[0])
        s2 = jnp.einsum('thd,kd->thk', q[..., half:], sub_keys[1])
        v1, i1 = lax.top_k(s1, PEER_TOPK)
        v2, i2 = lax.top_k(s2, PEER_TOPK)
        cand = (v1[..., :, None] + v2[..., None, :]).reshape(PEER_CHUNK, PEER_HEADS, PEER_TOPK * PEER_TOPK)
        cv, ci = lax.top_k(cand, PEER_TOPK)
        e1 = jnp.take_along_axis(i1, ci // PEER_TOPK, axis=-1)
        e2 = jnp.take_along_axis(i2, ci % PEER_TOPK, axis=-1)
        idx = (e1 * PEER_N_KEYS + e2).reshape(PEER_CHUNK, PEER_HEADS * PEER_TOPK)
        g = jax.nn.softmax(cv.astype(jnp.float32), axis=-1).reshape(PEER_CHUNK, -1).astype(xb.dtype)
        u = u_table[idx]
        hpre = jnp.einsum('td,ted->te', xb, u)
        act = g * jax.nn.gelu(hpre, approximate=False)
        return jnp.einsum('te,ted->td', act, v_table[idx])

    return lax.map(one_chunk, xc).reshape(b, s, d)


def setup_inputs(seed: int = 0) -> dict:
    key = jax.random.key(seed)
    ks = jax.random.split(key, 24)
    f32 = jnp.float32
    nrm = lambda k, shape, sc: jax.random.normal(k, shape, f32) * sc
    D = D_MODEL
    qd = MLA_NOPE_DIM + MLA_ROPE_DIM
    return {
        "x": nrm(ks[0], (BATCH, SEQ, D), 1.0),
        "p": nrm(ks[1], (DEPTH, BATCH, SEQ, PLE_DIM), 1.0),
        "emb_ln_g": 1.0 + nrm(ks[2], (D,), 0.02),
        "emb_ln_b": nrm(ks[3], (D,), 0.02),
        "w_in": nrm(ks[4], (DEPTH, D, IN_PROJ_WIDTH), D ** -0.5),
        "mla_q_norm_g": 1.0 + nrm(ks[5], (DEPTH, MLA_Q_RANK), 0.02),
        "mla_kv_norm_g": 1.0 + nrm(ks[6], (DEPTH, MLA_KV_RANK), 0.02),
        "w_uq": nrm(ks[7], (DEPTH, MLA_Q_RANK, MLA_HEADS * qd), MLA_Q_RANK ** -0.5),
        "w_ukv": nrm(ks[8], (DEPTH, MLA_KV_RANK, MLA_HEADS * (MLA_NOPE_DIM + MLA_V_DIM)), MLA_KV_RANK ** -0.5),
        "na_rpb": nrm(ks[9], (DEPTH, NA_HEADS, 2 * NA_WIN_H_MAX - 1, 2 * NA_WIN_W - 1), 0.5),
        "w_o": nrm(ks[10], (DEPTH, MIX_WIDTH, D), MIX_WIDTH ** -0.5 * DN_BETA),
        "ln1_g": 1.0 + nrm(ks[11], (DEPTH, D), 0.02),
        "ln1_b": nrm(ks[12], (DEPTH, D), 0.02),
        "peer_w_q": nrm(ks[13], (DEPTH, D, PEER_HEADS * PEER_KEY_DIM), D ** -0.5),
        "peer_sub_keys": nrm(ks[14], (DEPTH, 2, PEER_N_KEYS, PEER_KEY_DIM // 2), (PEER_KEY_DIM // 2) ** -0.5),
        "peer_u": nrm(ks[15], (DEPTH, PEER_N_EXPERTS, D), D ** -0.5),
        "peer_v": nrm(ks[16], (DEPTH, PEER_N_EXPERTS, D), DN_BETA * PEER_HEADS ** -0.5),
        "ple_w": nrm(ks[17], (DEPTH, PLE_DIM, D), PLE_DIM ** -0.5 * DN_BETA),
        "ple_gate_w": nrm(ks[18], (DEPTH, D, D), D ** -0.5),
        "ple_gate_b": nrm(ks[19], (DEPTH, D), 0.02),
        "ln2_g": 1.0 + nrm(ks[20], (DEPTH, D), 0.02),
        "ln2_b": nrm(ks[21], (DEPTH, D), 0.02),
    }


def reference(x, p, emb_ln_g, emb_ln_b, w_in, mla_q_norm_g, mla_kv_norm_g, w_uq, w_ukv,
              na_rpb, w_o, ln1_g, ln1_b, peer_w_q, peer_sub_keys, peer_u, peer_v,
              ple_w, ple_gate_w, ple_gate_b, ln2_g, ln2_b):
    b, s, _ = x.shape
    cos, sin = rope_2d_tables(s, x.dtype)
    split_points = list(np.cumsum([NA_WIDTH, NA_WIDTH, NA_WIDTH, MLA_Q_RANK, MLA_KV_RANK]))
    h = layer_norm(x, emb_ln_g, emb_ln_b)
    for i in range(DEPTH):
        z = h @ w_in[i]
        q_na, k_na, v_na, c_q, c_kv, k_r = jnp.split(z, split_points, axis=-1)
        hd = (b, s, NA_HEADS, NA_HEAD_DIM)
        a_na = neighbourhood_attention(q_na.reshape(hd), k_na.reshape(hd), v_na.reshape(hd), na_rpb[i])
        a_mla = latent_attention(c_q, c_kv, k_r, mla_q_norm_g[i], mla_kv_norm_g[i], w_uq[i], w_ukv[i], cos, sin)
        mix = jnp.concatenate([a_na, a_mla], axis=-1) @ w_o[i]
        h = layer_norm(DN_ALPHA * h + mix, ln1_g[i], ln1_b[i])
        ffn = peer_ffn(h, peer_w_q[i], peer_sub_keys[i], peer_u[i], peer_v[i])
        gate = jax.nn.sigmoid(h @ ple_gate_w[i] + ple_gate_b[i])
        ple = gate * (p[i] @ ple_w[i])
        h = layer_norm(DN_ALPHA * h + ffn + ple, ln2_g[i], ln2_b[i])
    return h
```

```cpp
#include <hip/hip_runtime.h>
#include <hip/hip_cooperative_groups.h>
#include <stdint.h>
#include <stdio.h>

#ifndef MEGA
#define MEGA 0
#endif
#ifndef NAIVE_GEMM
#define NAIVE_GEMM 0
#endif
#ifndef NAIVE_ATTN
#define NAIVE_ATTN 0
#endif

namespace cg = cooperative_groups;

#define DI __device__ __forceinline__
typedef unsigned short bf16_t;
using bf16x8 = __attribute__((ext_vector_type(8))) short;
using f32x16 = __attribute__((ext_vector_type(16))) float;
using f32x4  = __attribute__((ext_vector_type(4))) float;
using u32x4  = __attribute__((ext_vector_type(4))) unsigned;
using u32x2  = __attribute__((ext_vector_type(2))) unsigned;

#define MFMA32(a, b, c) __builtin_amdgcn_mfma_f32_32x32x16_bf16((a), (b), (c), 0, 0, 0)

constexpr int NTOK = 32768;
constexpr int DM = 1024;
constexpr float DN_ALPHA = 1.189207115002721f;
constexpr float LN_EPS = 1e-5f;
constexpr float LOG2E = 1.4426950408889634f;
constexpr float QNA_SCALE = 0.125f * LOG2E;
constexpr float QM_SCALE = 0.10206207261596577f * LOG2E;

constexpr size_t MBy = 1ull << 20;
constexpr size_t OFF_WINT = 0;
constexpr size_t OFF_WUQT = 5 * MBy;
constexpr size_t OFF_WUKVT = 6 * MBy;
constexpr size_t OFF_WOT = 7 * MBy;
constexpr size_t OFF_WQT = 9 * MBy;
constexpr size_t OFF_SUBK = 13 * MBy;
constexpr size_t OFF_ROPE = 14 * MBy;
constexpr size_t OFF_PLEWT = 15 * MBy;
constexpr size_t OFF_GATEWT = 16 * MBy;
constexpr size_t OFF_RQ = 18 * MBy;
constexpr size_t OFF_RKV = 18 * MBy + 256 * 1024;
constexpr size_t OFF_BAR = 19 * MBy;
constexpr size_t OFF_UBF = 20 * MBy;
constexpr size_t OFF_VBF = 52 * MBy;
constexpr size_t OFF_PB = 84 * MBy;
constexpr size_t OFF_H = 100 * MBy;
constexpr size_t OFF_QNA = 164 * MBy;
constexpr size_t OFF_KNA = 196 * MBy;
constexpr size_t OFF_VNAT = 228 * MBy;
constexpr size_t OFF_CQ = 260 * MBy;
constexpr size_t OFF_CKV = 284 * MBy;
constexpr size_t OFF_KR = 300 * MBy;
constexpr size_t OFF_QM = 304 * MBy;
constexpr size_t OFF_KM = 352 * MBy;
constexpr size_t OFF_VMT = 400 * MBy;
constexpr size_t OFF_MIX = 432 * MBy;
constexpr size_t OFF_QP = 164 * MBy;
constexpr size_t OFF_G = 292 * MBy;
constexpr size_t OFF_IDX = 356 * MBy;
constexpr size_t OFF_GW = 372 * MBy;

constexpr int SMEM_BYTES = 73728;

struct Params {
  const float *x, *p, *emb_g, *emb_b, *w_in, *qg, *kvg, *w_uq, *w_ukv, *rpb, *w_o, *ln1g, *ln1b, *w_q, *subk, *pu, *pv,
      *ple_w, *gate_w, *gate_b, *ln2g, *ln2b;
  float* out;
  char* ws;
};

DI unsigned short f2bf(float x) {
  unsigned u = __float_as_uint(x);
  u += 0x7fffu + ((u >> 16) & 1u);
  return (unsigned short)(u >> 16);
}
DI float bf2f(unsigned short b) { return __uint_as_float(((unsigned)b) << 16); }
DI unsigned pack2(float lo, float hi) { return (unsigned)f2bf(lo) | ((unsigned)f2bf(hi) << 16); }
DI float bflo(unsigned u) { return __uint_as_float(u << 16); }
DI float bfhi(unsigned u) { return __uint_as_float(u & 0xffff0000u); }
DI float wave_sum(float v) {
#pragma unroll
  for (int m = 32; m >= 1; m >>= 1) v += __shfl_xor(v, m);
  return v;
}
DI float fast_exp2(float x) { return __builtin_amdgcn_exp2f(x); }
DI int pi_swap23(int r) { return (r & ~12) | ((r & 4) << 1) | ((r & 8) >> 1); }

DI void transpose_cvt(const float* __restrict__ in, bf16_t* __restrict__ out, int K, int N, const float* __restrict__ g,
                      char* smem) {
  float* tile = (float*)smem;
  const int tk = K >> 5, tn = N >> 5;
  const int tx = threadIdx.x & 31, ty = threadIdx.x >> 5;
  for (int t = blockIdx.x; t < tk * tn; t += gridDim.x) {
    const int k0 = (t / tn) << 5, n0 = (t % tn) << 5;
    __syncthreads();
#pragma unroll
    for (int i = 0; i < 4; ++i) {
      const int k = k0 + ty + 8 * i;
      float v = in[(size_t)k * N + n0 + tx];
      if (g) v *= g[k];
      tile[(ty + 8 * i) * 33 + tx] = v;
    }
    __syncthreads();
#pragma unroll
    for (int i = 0; i < 4; ++i) {
      const int n = n0 + ty + 8 * i;
      out[(size_t)n * K + k0 + tx] = f2bf(tile[tx * 33 + ty + 8 * i]);
    }
  }
}

DI void straight_cvt(const float* __restrict__ in, bf16_t* __restrict__ out, size_t n) {
  const size_t n4 = n >> 2;
  for (size_t i = (size_t)blockIdx.x * 256 + threadIdx.x; i < n4; i += (size_t)gridDim.x * 256) {
    const f32x4 v = *(const f32x4*)(in + i * 4);
    u32x2 o;
    o[0] = pack2(v[0], v[1]);
    o[1] = pack2(v[2], v[3]);
    *(u32x2*)(out + i * 4) = o;
  }
}

DI void ln_rows16(float (&v)[16], const float* __restrict__ gam, const float* __restrict__ bet, int lane) {
  float s = 0.f;
#pragma unroll
  for (int i = 0; i < 16; ++i) s += v[i];
  const float mu = wave_sum(s) * (1.f / 1024.f);
  float q = 0.f;
#pragma unroll
  for (int i = 0; i < 16; ++i) {
    v[i] -= mu;
    q += v[i] * v[i];
  }
  const float rstd = rsqrtf(wave_sum(q) * (1.f / 1024.f) + LN_EPS);
#pragma unroll
  for (int g = 0; g < 4; ++g) {
    const f32x4 gg = *(const f32x4*)(gam + g * 256 + lane * 4);
    const f32x4 bb = *(const f32x4*)(bet + g * 256 + lane * 4);
#pragma unroll
    for (int c = 0; c < 4; ++c) v[g * 4 + c] = v[g * 4 + c] * rstd * gg[c] + bb[c];
  }
}

DI void phase0(const Params& P, char* smem) {
  char* ws = P.ws;
  transpose_cvt(P.w_in, (bf16_t*)(ws + OFF_WINT), 1024, 2208, nullptr, smem);
  transpose_cvt(P.w_uq, (bf16_t*)(ws + OFF_WUQT), 384, 768, P.qg, smem);
  transpose_cvt(P.w_ukv, (bf16_t*)(ws + OFF_WUKVT), 256, 1024, P.kvg, smem);
  transpose_cvt(P.w_o, (bf16_t*)(ws + OFF_WOT), 1024, 1024, nullptr, smem);
  transpose_cvt(P.w_q, (bf16_t*)(ws + OFF_WQT), 1024, 2048, nullptr, smem);
  transpose_cvt(P.ple_w, (bf16_t*)(ws + OFF_PLEWT), 256, 1024, nullptr, smem);
  transpose_cvt(P.gate_w, (bf16_t*)(ws + OFF_GATEWT), 1024, 1024, nullptr, smem);
  straight_cvt(P.subk, (bf16_t*)(ws + OFF_SUBK), 2 * 128 * 128);
  straight_cvt(P.pu, (bf16_t*)(ws + OFF_UBF), (size_t)16384 * 1024);
  straight_cvt(P.pv, (bf16_t*)(ws + OFF_VBF), (size_t)16384 * 1024);
  straight_cvt(P.p, (bf16_t*)(ws + OFF_PB), (size_t)NTOK * 256);
  float* rope = (float*)(ws + OFF_ROPE);
  for (int i = blockIdx.x * 256 + threadIdx.x; i < 2048 * 16; i += gridDim.x * 256) {
    const int s = i >> 4, j = i & 15;
    const float inv = powf(10000.f, -(float)(2 * (j & 7)) / 16.f);
    const float pos = (j < 8) ? (float)(s >> 6) : (float)(s & 63);
    const float ang = pos * inv;
    rope[s * 32 + j] = cosf(ang);
    rope[s * 32 + 16 + j] = sinf(ang);
  }
  const int lane = threadIdx.x & 63, w = threadIdx.x >> 6;
  bf16_t* h0 = (bf16_t*)(ws + OFF_H);
  for (int tok = blockIdx.x * 4 + w; tok < NTOK; tok += gridDim.x * 4) {
    float v[16];
#pragma unroll
    for (int g = 0; g < 4; ++g) {
      const f32x4 t = *(const f32x4*)(P.x + (size_t)tok * 1024 + g * 256 + lane * 4);
#pragma unroll
      for (int c = 0; c < 4; ++c) v[g * 4 + c] = t[c];
    }
    ln_rows16(v, P.emb_g, P.emb_b, lane);
#pragma unroll
    for (int g = 0; g < 4; ++g) {
      u32x2 o;
      o[0] = pack2(v[g * 4 + 0], v[g * 4 + 1]);
      o[1] = pack2(v[g * 4 + 2], v[g * 4 + 3]);
      *(u32x2*)(h0 + (size_t)tok * 1024 + g * 256 + lane * 4) = o;
    }
  }
}

template <class Epi>
DI void gemm_phase(const bf16_t* __restrict__ A, int lda, const bf16_t* __restrict__ Bt, int ldb, int M, int N, int K,
                   char* smem, const Epi& epi) {
  const int tid = threadIdx.x, lane = tid & 63, w = tid >> 6;
#if NAIVE_GEMM
  const int nb = (N + 63) >> 6;
  for (int item = blockIdx.x * 4 + w; item < M * nb; item += gridDim.x * 4) {
    const int row = item / nb, col = (item - row * nb) * 64 + lane;
    const int cc = col < N ? col : N - 1;
    float acc = 0.f;
    for (int k = 0; k < K; k += 8) {
      const u32x4 a = *(const u32x4*)(A + (size_t)row * lda + k);
      const u32x4 b = *(const u32x4*)(Bt + (size_t)cc * ldb + k);
#pragma unroll
      for (int j = 0; j < 4; ++j) acc += bflo(a[j]) * bflo(b[j]) + bfhi(a[j]) * bfhi(b[j]);
    }
    epi(row, col, acc);
  }
#else
  const int r = lane & 31, hh = lane >> 5;
  const int wm = w >> 1, wn = w & 1;
  const int nt = (N + 127) >> 7;
  const int ntiles = (M >> 7) * nt;
  bf16_t* As = (bf16_t*)smem;
  bf16_t* Bs = As + 2 * 128 * 72;
  const int nk = K >> 6;
  const int lrow = tid >> 3, lkc = (tid & 7) * 8;
  for (int tile = blockIdx.x; tile < ntiles; tile += gridDim.x) {
    const int tm = tile / nt, tn = tile - tm * nt;
    const int m0 = tm << 7, n0 = tn << 7;
    f32x16 acc[2][2];
#pragma unroll
    for (int i = 0; i < 2; ++i)
#pragma unroll
      for (int j = 0; j < 2; ++j)
#pragma unroll
        for (int e = 0; e < 16; ++e) acc[i][j][e] = 0.f;
    const bf16_t* ag = A + (size_t)(m0 + lrow) * lda + lkc;
    size_t boff[4];
#pragma unroll
    for (int i = 0; i < 4; ++i) {
      int n = n0 + lrow + 32 * i;
      n = n < N ? n : N - 1;
      boff[i] = (size_t)n * ldb + lkc;
    }
    u32x4 pa[4], pb[4];
#pragma unroll
    for (int i = 0; i < 4; ++i) {
      pa[i] = *(const u32x4*)(ag + (size_t)(32 * i) * lda);
      pb[i] = *(const u32x4*)(Bt + boff[i]);
    }
#pragma unroll
    for (int i = 0; i < 4; ++i) {
      *(u32x4*)(As + (lrow + 32 * i) * 72 + lkc) = pa[i];
      *(u32x4*)(Bs + (lrow + 32 * i) * 72 + lkc) = pb[i];
    }
    __syncthreads();
    for (int kt = 0; kt < nk; ++kt) {
      const int cur = kt & 1;
      if (kt + 1 < nk) {
        const int k0 = (kt + 1) << 6;
#pragma unroll
        for (int i = 0; i < 4; ++i) {
          pa[i] = *(const u32x4*)(ag + (size_t)(32 * i) * lda + k0);
          pb[i] = *(const u32x4*)(Bt + boff[i] + k0);
        }
      }
      const bf16_t* as = As + cur * (128 * 72) + (wm * 64 + r) * 72 + hh * 8;
      const bf16_t* bs = Bs + cur * (128 * 72) + (wn * 64 + r) * 72 + hh * 8;
#pragma unroll
      for (int ks = 0; ks < 4; ++ks) {
        const bf16x8 a0 = *(const bf16x8*)(as + ks * 16);
        const bf16x8 a1 = *(const bf16x8*)(as + 32 * 72 + ks * 16);
        const bf16x8 b0 = *(const bf16x8*)(bs + ks * 16);
        const bf16x8 b1 = *(const bf16x8*)(bs + 32 * 72 + ks * 16);
        acc[0][0] = MFMA32(a0, b0, acc[0][0]);
        acc[0][1] = MFMA32(a0, b1, acc[0][1]);
        acc[1][0] = MFMA32(a1, b0, acc[1][0]);
        acc[1][1] = MFMA32(a1, b1, acc[1][1]);
      }
      if (kt + 1 < nk) {
        const int nx = cur ^ 1;
#pragma unroll
        for (int i = 0; i < 4; ++i) {
          *(u32x4*)(As + nx * (128 * 72) + (lrow + 32 * i) * 72 + lkc) = pa[i];
          *(u32x4*)(Bs + nx * (128 * 72) + (lrow + 32 * i) * 72 + lkc) = pb[i];
        }
      }
      __syncthreads();
    }
#pragma unroll
    for (int mi = 0; mi < 2; ++mi)
#pragma unroll
      for (int ni = 0; ni < 2; ++ni) {
#pragma unroll
        for (int e = 0; e < 16; ++e) {
          const int row = m0 + wm * 64 + mi * 32 + (e & 3) + 8 * (e >> 2) + 4 * hh;
          const int col = n0 + wn * 64 + ni * 32 + r;
          epi(row, col, acc[mi][ni][e]);
        }
        asm volatile("" ::: "memory");
      }
  }
#endif
}

struct EpiInProj {
  bf16_t *qna, *kna, *vnat, *cq, *ckv;
  float* kr;
  DI void operator()(int row, int col, float v) const {
    if (col >= 2208) return;
    const int b = row >> 11, s = row & 2047;
    if (col < 1536) {
      const int sec = col >> 9, c = col & 511, h = c >> 6, d = c & 63;
      const size_t bh = (size_t)(b * 8 + h);
      if (sec == 0) qna[(bh * 2048 + s) * 64 + d] = f2bf(v * QNA_SCALE);
      else if (sec == 1) kna[(bh * 2048 + s) * 64 + d] = f2bf(v);
      else vnat[(bh * 64 + d) * 2048 + s] = f2bf(v);
    } else if (col < 1920) {
      cq[(size_t)row * 384 + (col - 1536)] = f2bf(v);
    } else if (col < 2176) {
      ckv[(size_t)row * 256 + (col - 1920)] = f2bf(v);
    } else {
      kr[(size_t)row * 32 + (col - 2176)] = v;
    }
  }
};
struct EpiUpQ {
  const float* rq;
  const float* rope;
  bf16_t* qm;
  DI void operator()(int row, int col, float v) const {
    v *= rq[row];
    const float pv = __shfl_xor(v, 1);
    const int hd = col / 96, d = col - hd * 96;
    const int b = row >> 11, s = row & 2047;
    float o = v;
    if (d >= 64) {
      const int i = (d - 64) >> 1;
      const float c = rope[s * 32 + i], sn = rope[s * 32 + 16 + i];
      o = (d & 1) ? (pv * sn + v * c) : (v * c - pv * sn);
    }
    qm[((size_t)(b * 8 + hd) * 2048 + s) * 96 + d] = f2bf(o * QM_SCALE);
  }
};
struct EpiUpKV {
  const float* rkv;
  bf16_t *km, *vmt;
  DI void operator()(int row, int col, float v) const {
    v *= rkv[row];
    const int hd = col >> 7, d = col & 127;
    const int b = row >> 11, s = row & 2047;
    const size_t bh = (size_t)(b * 8 + hd);
    if (d < 64) km[(bh * 2048 + s) * 96 + d] = f2bf(v);
    else vmt[(bh * 64 + (d - 64)) * 2048 + s] = f2bf(v);
  }
};
struct EpiWo {
  const bf16_t* h0;
  float* y1;
  DI void operator()(int row, int col, float v) const {
    const size_t i = (size_t)row * 1024 + col;
    y1[i] = DN_ALPHA * bf2f(h0[i]) + v;
  }
};
struct EpiPeerQ {
  bf16_t* qp;
  DI void operator()(int row, int col, float v) const { qp[(size_t)row * 2048 + col] = f2bf(v); }
};
struct EpiGate {
  const float* gb;
  bf16_t* G;
  DI void operator()(int row, int col, float v) const {
    G[(size_t)row * 1024 + col] = f2bf(1.f / (1.f + __expf(-(v + gb[col]))));
  }
};
struct EpiPle {
  const bf16_t *h1, *G;
  float* y2;
  DI void operator()(int row, int col, float v) const {
    const size_t i = (size_t)row * 1024 + col;
    y2[i] = DN_ALPHA * bf2f(h1[i]) + bf2f(G[i]) * v;
  }
};

DI void phase_stats(const Params& P) {
  char* ws = P.ws;
  const bf16_t* cq = (const bf16_t*)(ws + OFF_CQ);
  const bf16_t* ckv = (const bf16_t*)(ws + OFF_CKV);
  const float* kr = (const float*)(ws + OFF_KR);
  const float* rope = (const float*)(ws + OFF_ROPE);
  float* rq = (float*)(ws + OFF_RQ);
  float* rkv = (float*)(ws + OFF_RKV);
  bf16_t* km = (bf16_t*)(ws + OFF_KM);
  const int lane = threadIdx.x & 63, w = threadIdx.x >> 6;
  for (int tok = blockIdx.x * 4 + w; tok < NTOK; tok += gridDim.x * 4) {
    float s1 = 0.f, s2 = 0.f;
#pragma unroll
    for (int i = 0; i < 6; ++i) {
      const float v = bf2f(cq[(size_t)tok * 384 + i * 64 + lane]);
      s1 += v * v;
    }
#pragma unroll
    for (int i = 0; i < 4; ++i) {
      const float v = bf2f(ckv[(size_t)tok * 256 + i * 64 + lane]);
      s2 += v * v;
    }
    s1 = wave_sum(s1);
    s2 = wave_sum(s2);
    if (lane == 0) {
      rq[tok] = rsqrtf(s1 * (1.f / 384.f) + LN_EPS);
      rkv[tok] = rsqrtf(s2 * (1.f / 256.f) + LN_EPS);
    }
    if (lane < 16) {
      const int b = tok >> 11, s = tok & 2047;
      const float x1 = kr[(size_t)tok * 32 + 2 * lane], x2 = kr[(size_t)tok * 32 + 2 * lane + 1];
      const float c = rope[s * 32 + lane], sn = rope[s * 32 + 16 + lane];
      const unsigned o = pack2(x1 * c - x2 * sn, x1 * sn + x2 * c);
#pragma unroll
      for (int h = 0; h < 8; ++h) *(unsigned*)(km + ((size_t)(b * 8 + h) * 2048 + s) * 96 + 64 + 2 * lane) = o;
    }
  }
}

DI bf16x8 pack8(const f32x16& x, int base) {
  u32x4 p;
  p[0] = pack2(x[base + 0], x[base + 1]);
  p[1] = pack2(x[base + 2], x[base + 3]);
  p[2] = pack2(x[base + 4], x[base + 5]);
  p[3] = pack2(x[base + 6], x[base + 7]);
  return __builtin_bit_cast(bf16x8, p);
}

DI void softmax_step(f32x16 (&sacc)[2], float& m, float& l, f32x16 (&oacc)[2], bf16x8 (&pf)[4]) {
  float mx = sacc[0][0];
#pragma unroll
  for (int e = 1; e < 16; ++e) mx = fmaxf(mx, sacc[0][e]);
#pragma unroll
  for (int e = 0; e < 16; ++e) mx = fmaxf(mx, sacc[1][e]);
  mx = fmaxf(mx, __shfl_xor(mx, 32));
  const float mnew = fmaxf(m, mx);
  const float alpha = fast_exp2(m - mnew);
  m = mnew;
  float ps = 0.f;
#pragma unroll
  for (int t = 0; t < 2; ++t)
#pragma unroll
    for (int e = 0; e < 16; ++e) {
      const float p = fast_exp2(sacc[t][e] - mnew);
      sacc[t][e] = p;
      ps += p;
    }
  l = l * alpha + ps;
#pragma unroll
  for (int t = 0; t < 2; ++t)
#pragma unroll
    for (int e = 0; e < 16; ++e) oacc[t][e] *= alpha;
  pf[0] = pack8(sacc[0], 0);
  pf[1] = pack8(sacc[0], 8);
  pf[2] = pack8(sacc[1], 0);
  pf[3] = pack8(sacc[1], 8);
}

DI void store_o(const f32x16 (&oacc)[2], float l, bf16_t* dst  , int hh) {
  const float lt = l + __shfl_xor(l, 32);
  const float inv = 1.f / lt;
#pragma unroll
  for (int dt = 0; dt < 2; ++dt)
#pragma unroll
    for (int g = 0; g < 4; ++g) {
      u32x2 o;
      o[0] = pack2(oacc[dt][4 * g + 0] * inv, oacc[dt][4 * g + 1] * inv);
      o[1] = pack2(oacc[dt][4 * g + 2] * inv, oacc[dt][4 * g + 3] * inv);
      *(u32x2*)(dst + 32 * dt + 8 * g + 4 * hh) = o;
    }
}

DI void phase_attn(const Params& P, char* smem) {
  char* ws = P.ws;
  const bf16_t* QNA = (const bf16_t*)(ws + OFF_QNA);
  const bf16_t* KNA = (const bf16_t*)(ws + OFF_KNA);
  const bf16_t* VNAT = (const bf16_t*)(ws + OFF_VNAT);
  const bf16_t* QM = (const bf16_t*)(ws + OFF_QM);
  const bf16_t* KM = (const bf16_t*)(ws + OFF_KM);
  const bf16_t* VMT = (const bf16_t*)(ws + OFF_VMT);
  bf16_t* mix = (bf16_t*)(ws + OFF_MIX);
  const int tid = threadIdx.x, lane = tid & 63, w = tid >> 6;
#if NAIVE_ATTN
  (void)smem;
  const int gt = blockIdx.x * 256 + tid, nth = gridDim.x * 256;
  for (int idx = gt; idx < 128 * 2048; idx += nth) {
    const int bh = idx >> 11, s = idx & 2047, h = bh & 7, b = bh >> 3;
    const int rr = s >> 6, qc = s & 63;
    int rs = rr - 4; rs = rs < 0 ? 0 : (rs > 24 ? 24 : rs);
    int cs = qc - 8; cs = cs < 0 ? 0 : (cs > 48 ? 48 : cs);
    float q[64], o[64];
#pragma unroll
    for (int d = 0; d < 64; ++d) { q[d] = bf2f(QNA[((size_t)bh * 2048 + s) * 64 + d]); o[d] = 0.f; }
    float m = -1e30f, l = 0.f;
    for (int i = 0; i < 8; ++i)
      for (int j = 0; j < 16; ++j) {
        const int key = (rs + i) * 64 + cs + j;
        const bf16_t* kp = KNA + ((size_t)bh * 2048 + key) * 64;
        float sc = 0.f;
#pragma unroll
        for (int d = 0; d < 64; ++d) sc += q[d] * bf2f(kp[d]);
        sc += P.rpb[h * 465 + (rs + i - rr + 7) * 31 + (cs + j - qc + 15)] * LOG2E;
        const float mn = fmaxf(m, sc), al = exp2f(m - mn), pp = exp2f(sc - mn);
        m = mn; l = l * al + pp;
#pragma unroll
        for (int d = 0; d < 64; ++d) o[d] = o[d] * al + pp * bf2f(VNAT[((size_t)bh * 64 + d) * 2048 + key]);
      }
    const float inv = 1.f / l;
#pragma unroll
    for (int d = 0; d < 64; ++d) mix[((size_t)b * 2048 + s) * 1024 + h * 64 + d] = f2bf(o[d] * inv);
  }
  for (int idx = gt; idx < 128 * 2048; idx += nth) {
    const int bh = idx >> 11, s = idx & 2047, h = bh & 7, b = bh >> 3;
    float q[96], o[64];
#pragma unroll
    for (int d = 0; d < 96; ++d) q[d] = bf2f(QM[((size_t)bh * 2048 + s) * 96 + d]);
#pragma unroll
    for (int d = 0; d < 64; ++d) o[d] = 0.f;
    float m = -1e30f, l = 0.f;
    for (int key = 0; key < 2048; ++key) {
      const bf16_t* kp = KM + ((size_t)bh * 2048 + key) * 96;
      float sc = 0.f;
#pragma unroll
      for (int d = 0; d < 96; ++d) sc += q[d] * bf2f(kp[d]);
      const float mn = fmaxf(m, sc), al = exp2f(m - mn), pp = exp2f(sc - mn);
      m = mn; l = l * al + pp;
#pragma unroll
      for (int d = 0; d < 64; ++d) o[d] = o[d] * al + pp * bf2f(VMT[((size_t)bh * 64 + d) * 2048 + key]);
    }
    const float inv = 1.f / l;
#pragma unroll
    for (int d = 0; d < 64; ++d) mix[((size_t)b * 2048 + s) * 1024 + 512 + h * 64 + d] = f2bf(o[d] * inv);
  }
#else
  const int r = lane & 31, hh = lane >> 5;
  const int pr = pi_swap23(r);
  float* bl = (float*)(smem + 45056);
  __syncthreads();
  for (int i = tid; i < 8 * 465; i += 256) bl[i] = P.rpb[i] * LOG2E;
  __syncthreads();
  for (int item = blockIdx.x * 4 + w; item < 8192; item += gridDim.x * 4) {
    const int half = item & 1, h = (item >> 1) & 7, rr = (item >> 4) & 31, b = item >> 9;
    const size_t bh = (size_t)(b * 8 + h);
    int rs = rr - 4; rs = rs < 0 ? 0 : (rs > 24 ? 24 : rs);
    const int qc = 32 * half + r;
    int cs = qc - 8; cs = cs < 0 ? 0 : (cs > 48 ? 48 : cs);
    bf16x8 qf[4];
#pragma unroll
    for (int s = 0; s < 4; ++s) qf[s] = *(const bf16x8*)(QNA + (bh * 2048 + rr * 64 + qc) * 64 + 16 * s + 8 * hh);
    f32x16 oacc[2];
#pragma unroll
    for (int t = 0; t < 2; ++t)
#pragma unroll
      for (int e = 0; e < 16; ++e) oacc[t][e] = 0.f;
    float m = -1e30f, l = 0.f;
    for (int i = 0; i < 8; ++i) {
      const int key0 = (rs + i) * 64;
      f32x16 sacc[2];
#pragma unroll
      for (int t = 0; t < 2; ++t)
#pragma unroll
        for (int e = 0; e < 16; ++e) sacc[t][e] = 0.f;
#pragma unroll
      for (int kt = 0; kt < 2; ++kt)
#pragma unroll
        for (int s = 0; s < 4; ++s) {
          const bf16x8 kf = *(const bf16x8*)(KNA + (bh * 2048 + key0 + 32 * kt + pr) * 64 + 16 * s + 8 * hh);
          sacc[kt] = MFMA32(kf, qf[s], sacc[kt]);
        }
      const float* brow = bl + h * 465 + (rs + i - rr + 7) * 31;
#pragma unroll
      for (int kt = 0; kt < 2; ++kt)
#pragma unroll
        for (int e = 0; e < 16; ++e) {
          const int kc = 32 * kt + (e & 7) + 8 * hh + 16 * (e >> 3);
          const bool valid = (unsigned)(kc - cs) < 16u;
          int dj = kc - qc + 15;
          dj = dj < 0 ? 0 : (dj > 30 ? 30 : dj);
          const float bias = brow[dj];
          sacc[kt][e] = valid ? sacc[kt][e] + bias : -INFINITY;
        }
      bf16x8 pf[4];
      softmax_step(sacc, m, l, oacc, pf);
#pragma unroll
      for (int dt = 0; dt < 2; ++dt)
#pragma unroll
        for (int s = 0; s < 4; ++s) {
          const bf16x8 vf = *(const bf16x8*)(VNAT + (bh * 64 + 32 * dt + r) * 2048 + key0 + 16 * s + 8 * hh);
          oacc[dt] = MFMA32(vf, pf[s], oacc[dt]);
        }
    }
    store_o(oacc, l, mix + ((size_t)b * 2048 + rr * 64 + qc) * 1024 + h * 64, hh);
  }
  bf16_t* Ks = (bf16_t*)smem;
  bf16_t* Vs = (bf16_t*)(smem + 2 * 13312);
  for (int item = blockIdx.x; item < 2048; item += gridDim.x) {
    const int bh = item >> 4, qt = item & 15;
    const int b = bh >> 3, h = bh & 7;
    const int q0 = qt * 128 + w * 32;
    bf16x8 qf[6];
#pragma unroll
    for (int s = 0; s < 6; ++s) qf[s] = *(const bf16x8*)(QM + ((size_t)bh * 2048 + q0 + r) * 96 + 16 * s + 8 * hh);
    f32x16 oacc[2];
#pragma unroll
    for (int t = 0; t < 2; ++t)
#pragma unroll
      for (int e = 0; e < 16; ++e) oacc[t][e] = 0.f;
    float m = -1e30f, l = 0.f;
    const bf16_t* kg = KM + (size_t)bh * 2048 * 96;
    const bf16_t* vg = VMT + (size_t)bh * 64 * 2048;
    u32x4 pk[3], pv[2];
    int klds[3], vlds[2];
    size_t vgo[2];
#pragma unroll
    for (int i = 0; i < 3; ++i) {
      const int c = tid + 256 * i;
      klds[i] = (c / 12) * 104 + (c % 12) * 8;
    }
#pragma unroll
    for (int i = 0; i < 2; ++i) {
      const int c = tid + 256 * i;
      vlds[i] = (c >> 3) * 72 + (c & 7) * 8;
      vgo[i] = (size_t)(c >> 3) * 2048 + (c & 7) * 8;
    }
    __syncthreads();
#pragma unroll
    for (int i = 0; i < 3; ++i) pk[i] = *(const u32x4*)(kg + (size_t)(tid + 256 * i) * 8);
#pragma unroll
    for (int i = 0; i < 2; ++i) pv[i] = *(const u32x4*)(vg + vgo[i]);
#pragma unroll
    for (int i = 0; i < 3; ++i) *(u32x4*)(Ks + klds[i]) = pk[i];
#pragma unroll
    for (int i = 0; i < 2; ++i) *(u32x4*)(Vs + vlds[i]) = pv[i];
    __syncthreads();
    for (int j = 0; j < 32; ++j) {
      const int cur = j & 1;
      if (j + 1 < 32) {
        const bf16_t* kgn = kg + (size_t)(j + 1) * 64 * 96;
#pragma unroll
        for (int i = 0; i < 3; ++i) pk[i] = *(const u32x4*)(kgn + (size_t)(tid + 256 * i) * 8);
#pragma unroll
        for (int i = 0; i < 2; ++i) pv[i] = *(const u32x4*)(vg + vgo[i] + (j + 1) * 64);
      }
      const bf16_t* ks = Ks + cur * (64 * 104);
      const bf16_t* vs = Vs + cur * (64 * 72);
      f32x16 sacc[2];
#pragma unroll
      for (int t = 0; t < 2; ++t)
#pragma unroll
        for (int e = 0; e < 16; ++e) sacc[t][e] = 0.f;
#pragma unroll
      for (int kt = 0; kt < 2; ++kt)
#pragma unroll
        for (int s = 0; s < 6; ++s) {
          const bf16x8 kf = *(const bf16x8*)(ks + (32 * kt + pr) * 104 + 16 * s + 8 * hh);
          sacc[kt] = MFMA32(kf, qf[s], sacc[kt]);
        }
      bf16x8 pf[4];
      softmax_step(sacc, m, l, oacc, pf);
#pragma unroll
      for (int dt = 0; dt < 2; ++dt)
#pragma unroll
        for (int s = 0; s < 4; ++s) {
          const bf16x8 vf = *(const bf16x8*)(vs + (32 * dt + r) * 72 + 16 * s + 8 * hh);
          oacc[dt] = MFMA32(vf, pf[s], oacc[dt]);
        }
      if (j + 1 < 32) {
        const int nx = cur ^ 1;
#pragma unroll
        for (int i = 0; i < 3; ++i) *(u32x4*)(Ks + nx * (64 * 104) + klds[i]) = pk[i];
#pragma unroll
        for (int i = 0; i < 2; ++i) *(u32x4*)(Vs + nx * (64 * 72) + vlds[i]) = pv[i];
      }
      __syncthreads();
    }
    store_o(oacc, l, mix + ((size_t)b * 2048 + q0 + r) * 1024 + 512 + h * 64, hh);
  }
#endif
}

DI void phase_ln1(const Params& P) {
  const int lane = threadIdx.x & 63, w = threadIdx.x >> 6;
  bf16_t* h1 = (bf16_t*)(P.ws + OFF_H);
  for (int tok = blockIdx.x * 4 + w; tok < NTOK; tok += gridDim.x * 4) {
    float v[16];
#pragma unroll
    for (int g = 0; g < 4; ++g) {
      const f32x4 t = *(const f32x4*)(P.out + (size_t)tok * 1024 + g * 256 + lane * 4);
#pragma unroll
      for (int c = 0; c < 4; ++c) v[g * 4 + c] = t[c];
    }
    ln_rows16(v, P.ln1g, P.ln1b, lane);
#pragma unroll
    for (int g = 0; g < 4; ++g) {
      u32x2 o;
      o[0] = pack2(v[g * 4 + 0], v[g * 4 + 1]);
      o[1] = pack2(v[g * 4 + 2], v[g * 4 + 3]);
      *(u32x2*)(h1 + (size_t)tok * 1024 + g * 256 + lane * 4) = o;
    }
  }
}

DI void wave_argmax(float& bv, int& bi) {
#pragma unroll
  for (int msk = 32; msk >= 1; msk >>= 1) {
    const float ov = __shfl_xor(bv, msk);
    const int oi = __shfl_xor(bi, msk);
    const bool take = (ov > bv) || (ov == bv && oi < bi);
    bv = take ? ov : bv;
    bi = take ? oi : bi;
  }
}

DI void phase_topk(const Params& P, char* smem) {
  char* ws = P.ws;
  const bf16_t* qp = (const bf16_t*)(ws + OFF_QP);
  const bf16_t* subk = (const bf16_t*)(ws + OFF_SUBK);
  int* idx_out = (int*)(ws + OFF_IDX);
  float* g_out = (float*)(ws + OFF_GW);
  const int tid = threadIdx.x, lane = tid & 63, w = tid >> 6;
  bf16_t* skT = (bf16_t*)smem;
  float* qs = (float*)(smem + 65536) + w * 256;
  __syncthreads();
  for (int i = tid; i < 2 * 128 * 128; i += 256) {
    const int c = i >> 14, k = (i >> 7) & 127, d = i & 127;
    skT[(c * 128 + d) * 128 + k] = subk[i];
  }
  __syncthreads();
  for (int item = blockIdx.x * 4 + w; item < NTOK * 8; item += gridDim.x * 4) {
    const int tok = item >> 3, h = item & 7;
#pragma unroll
    for (int i = 0; i < 4; ++i) qs[i * 64 + lane] = bf2f(qp[(size_t)tok * 2048 + h * 256 + i * 64 + lane]);
    float sc[2][2];
#pragma unroll
    for (int c = 0; c < 2; ++c) {
      float a0 = 0.f, a1 = 0.f;
#pragma unroll 4
      for (int d = 0; d < 128; ++d) {
        const float qd = qs[c * 128 + d];
        a0 += qd * bf2f(skT[(c * 128 + d) * 128 + lane]);
        a1 += qd * bf2f(skT[(c * 128 + d) * 128 + 64 + lane]);
      }
      sc[c][0] = a0;
      sc[c][1] = a1;
    }
    float tv[2];
    int ti[2];
#pragma unroll
    for (int c = 0; c < 2; ++c) {
      float v0 = sc[c][0], v1 = sc[c][1];
      float keepv = 0.f;
      int keepi = 0;
#pragma unroll 1
      for (int rnd = 0; rnd < 16; ++rnd) {
        float bv = (v0 >= v1) ? v0 : v1;
        int bi = (v0 >= v1) ? lane : lane + 64;
        wave_argmax(bv, bi);
        if (bi == lane) v0 = -INFINITY;
        if (bi == lane + 64) v1 = -INFINITY;
        if (lane == rnd) { keepv = bv; keepi = bi; }
      }
      tv[c] = keepv;
      ti[c] = keepi;
    }
    const float va = __shfl(tv[0], lane >> 2);
    float cand[4];
#pragma unroll
    for (int j = 0; j < 4; ++j) cand[j] = va + __shfl(tv[1], (lane & 3) * 4 + j);
    float cv = 0.f;
    int cci = 0;
#pragma unroll 1
    for (int rnd = 0; rnd < 16; ++rnd) {
      float bv = cand[0];
      int bi = 4 * lane;
#pragma unroll
      for (int j = 1; j < 4; ++j)
        if (cand[j] > bv) { bv = cand[j]; bi = 4 * lane + j; }
      wave_argmax(bv, bi);
#pragma unroll
      for (int j = 0; j < 4; ++j)
        if (bi == 4 * lane + j) cand[j] = -INFINITY;
      if (lane == rnd) { cv = bv; cci = bi; }
    }
    const int e1 = __shfl(ti[0], (cci >> 4) & 15);
    const int e2 = __shfl(ti[1], cci & 15);
    const float mx = __shfl(cv, 0);
    const float ex = (lane < 16) ? __expf(cv - mx) : 0.f;
    const float sum = wave_sum(ex);
    if (lane < 16) {
      idx_out[(size_t)tok * 128 + h * 16 + lane] = e1 * 128 + e2;
      g_out[(size_t)tok * 128 + h * 16 + lane] = ex / sum;
    }
  }
}

DI void phase_gather(const Params& P) {
  char* ws = P.ws;
  const bf16_t* h1 = (const bf16_t*)(ws + OFF_H);
  const bf16_t* U = (const bf16_t*)(ws + OFF_UBF);
  const bf16_t* V = (const bf16_t*)(ws + OFF_VBF);
  const int* idxb = (const int*)(ws + OFF_IDX);
  const float* gwb = (const float*)(ws + OFF_GW);
  const int lane = threadIdx.x & 63, w = threadIdx.x >> 6;
  for (int tok = blockIdx.x * 4 + w; tok < NTOK; tok += gridDim.x * 4) {
    float xv[16];
    {
      const u32x4 a = *(const u32x4*)(h1 + (size_t)tok * 1024 + 8 * lane);
      const u32x4 b = *(const u32x4*)(h1 + (size_t)tok * 1024 + 512 + 8 * lane);
#pragma unroll
      for (int j = 0; j < 4; ++j) {
        xv[2 * j] = bflo(a[j]); xv[2 * j + 1] = bfhi(a[j]);
        xv[8 + 2 * j] = bflo(b[j]); xv[8 + 2 * j + 1] = bfhi(b[j]);
      }
    }
    const int id0 = idxb[(size_t)tok * 128 + lane], id1 = idxb[(size_t)tok * 128 + 64 + lane];
    const float g0 = gwb[(size_t)tok * 128 + lane], g1 = gwb[(size_t)tok * 128 + 64 + lane];
    float act0 = 0.f, act1 = 0.f;
    for (int e = 0; e < 128; ++e) {
      const int id = __shfl(e < 64 ? id0 : id1, e & 63);
      const u32x4 a = *(const u32x4*)(U + (size_t)id * 1024 + 8 * lane);
      const u32x4 b = *(const u32x4*)(U + (size_t)id * 1024 + 512 + 8 * lane);
      float d = 0.f;
#pragma unroll
      for (int j = 0; j < 4; ++j) {
        d += xv[2 * j] * bflo(a[j]) + xv[2 * j + 1] * bfhi(a[j]);
        d += xv[8 + 2 * j] * bflo(b[j]) + xv[8 + 2 * j + 1] * bfhi(b[j]);
      }
      d = wave_sum(d);
      if (e < 64) { if (lane == e) act0 = d; }
      else { if (lane == e - 64) act1 = d; }
    }
    act0 = g0 * 0.5f * act0 * (1.f + erff(act0 * 0.70710678118654752f));
    act1 = g1 * 0.5f * act1 * (1.f + erff(act1 * 0.70710678118654752f));
    float acc[16];
#pragma unroll
    for (int i = 0; i < 16; ++i) acc[i] = 0.f;
    for (int e = 0; e < 128; ++e) {
      const int id = __shfl(e < 64 ? id0 : id1, e & 63);
      const float a_e = __shfl(e < 64 ? act0 : act1, e & 63);
      const u32x4 a = *(const u32x4*)(V + (size_t)id * 1024 + 8 * lane);
      const u32x4 b = *(const u32x4*)(V + (size_t)id * 1024 + 512 + 8 * lane);
#pragma unroll
      for (int j = 0; j < 4; ++j) {
        acc[2 * j] += a_e * bflo(a[j]); acc[2 * j + 1] += a_e * bfhi(a[j]);
        acc[8 + 2 * j] += a_e * bflo(b[j]); acc[8 + 2 * j + 1] += a_e * bfhi(b[j]);
      }
    }
    float* orow = P.out + (size_t)tok * 1024;
    float y[16];
#pragma unroll
    for (int hlf = 0; hlf < 2; ++hlf)
#pragma unroll
      for (int q = 0; q < 2; ++q) {
        const f32x4 t = *(const f32x4*)(orow + hlf * 512 + 8 * lane + 4 * q);
#pragma unroll
        for (int c = 0; c < 4; ++c) y[hlf * 8 + q * 4 + c] = t[c] + acc[hlf * 8 + q * 4 + c];
      }
    float s = 0.f;
#pragma unroll
    for (int i = 0; i < 16; ++i) s += y[i];
    const float mu = wave_sum(s) * (1.f / 1024.f);
    float qq = 0.f;
#pragma unroll
    for (int i = 0; i < 16; ++i) { y[i] -= mu; qq += y[i] * y[i]; }
    const float rstd = rsqrtf(wave_sum(qq) * (1.f / 1024.f) + LN_EPS);
#pragma unroll
    for (int hlf = 0; hlf < 2; ++hlf)
#pragma unroll
      for (int q = 0; q < 2; ++q) {
        const int off = hlf * 512 + 8 * lane + 4 * q;
        const f32x4 gg = *(const f32x4*)(P.ln2g + off);
        const f32x4 bb = *(const f32x4*)(P.ln2b + off);
        f32x4 o;
#pragma unroll
        for (int c = 0; c < 4; ++c) o[c] = y[hlf * 8 + q * 4 + c] * rstd * gg[c] + bb[c];
        *(f32x4*)(orow + off) = o;
      }
  }
}

template <int PH>
DI void run_phase(const Params& P, char* smem) {
  char* ws = P.ws;
  if constexpr (PH == 0) {
    phase0(P, smem);
  } else if constexpr (PH == 1) {
    EpiInProj e{(bf16_t*)(ws + OFF_QNA), (bf16_t*)(ws + OFF_KNA), (bf16_t*)(ws + OFF_VNAT), (bf16_t*)(ws + OFF_CQ),
                (bf16_t*)(ws + OFF_CKV), (float*)(ws + OFF_KR)};
    gemm_phase((const bf16_t*)(ws + OFF_H), 1024, (const bf16_t*)(ws + OFF_WINT), 1024, NTOK, 2208, 1024, smem, e);
  } else if constexpr (PH == 2) {
    phase_stats(P);
  } else if constexpr (PH == 3) {
    EpiUpQ eq{(const float*)(ws + OFF_RQ), (const float*)(ws + OFF_ROPE), (bf16_t*)(ws + OFF_QM)};
    gemm_phase((const bf16_t*)(ws + OFF_CQ), 384, (const bf16_t*)(ws + OFF_WUQT), 384, NTOK, 768, 384, smem, eq);
    EpiUpKV ek{(const float*)(ws + OFF_RKV), (bf16_t*)(ws + OFF_KM), (bf16_t*)(ws + OFF_VMT)};
    gemm_phase((const bf16_t*)(ws + OFF_CKV), 256, (const bf16_t*)(ws + OFF_WUKVT), 256, NTOK, 1024, 256, smem, ek);
  } else if constexpr (PH == 4) {
    phase_attn(P, smem);
  } else if constexpr (PH == 5) {
    EpiWo e{(const bf16_t*)(ws + OFF_H), P.out};
    gemm_phase((const bf16_t*)(ws + OFF_MIX), 1024, (const bf16_t*)(ws + OFF_WOT), 1024, NTOK, 1024, 1024, smem, e);
  } else if constexpr (PH == 6) {
    phase_ln1(P);
  } else if constexpr (PH == 7) {
    EpiPeerQ e{(bf16_t*)(ws + OFF_QP)};
    gemm_phase((const bf16_t*)(ws + OFF_H), 1024, (const bf16_t*)(ws + OFF_WQT), 1024, NTOK, 2048, 1024, smem, e);
    EpiGate eg{P.gate_b, (bf16_t*)(ws + OFF_G)};
    gemm_phase((const bf16_t*)(ws + OFF_H), 1024, (const bf16_t*)(ws + OFF_GATEWT), 1024, NTOK, 1024, 1024, smem, eg);
  } else if constexpr (PH == 8) {
    EpiPle e{(const bf16_t*)(ws + OFF_H), (const bf16_t*)(ws + OFF_G), P.out};
    gemm_phase((const bf16_t*)(ws + OFF_PB), 256, (const bf16_t*)(ws + OFF_PLEWT), 256, NTOK, 1024, 256, smem, e);
  } else if constexpr (PH == 9) {
    phase_topk(P, smem);
  } else if constexpr (PH == 10) {
    phase_gather(P);
  }
}

constexpr int NPHASE = 11;

template <int PH>
__global__ void __launch_bounds__(256, 2) k_phase(Params P) {
  __shared__ __attribute__((aligned(16))) char smem[SMEM_BYTES];
  run_phase<PH>(P, smem);
}

__global__ void __launch_bounds__(256, 2) k_mega(Params P) {
  __shared__ __attribute__((aligned(16))) char smem[SMEM_BYTES];
  cg::grid_group grid = cg::this_grid();
  run_phase<0>(P, smem); grid.sync();
  run_phase<1>(P, smem); grid.sync();
  run_phase<2>(P, smem); grid.sync();
  run_phase<3>(P, smem); grid.sync();
  run_phase<4>(P, smem); grid.sync();
  run_phase<5>(P, smem); grid.sync();
  run_phase<6>(P, smem); grid.sync();
  run_phase<7>(P, smem); grid.sync();
  run_phase<8>(P, smem);
  run_phase<9>(P, smem); grid.sync();
  run_phase<10>(P, smem);
}

extern "C" void kernel_launch(void* const* d_in, const int* in_sizes, int n_in, void* d_out, int out_size, void* d_ws,
                              size_t ws_size, hipStream_t stream) {
  (void)in_sizes; (void)n_in; (void)out_size; (void)ws_size;
  Params P{};
  const float** pp = (const float**)&P;
  for (int i = 0; i < 22; ++i) pp[i] = (const float*)d_in[i];
  P.out = (float*)d_out;
  P.ws = (char*)d_ws;
  const int grid = 512;
#if MEGA
  void* args[] = {&P};
  hipError_t e = hipLaunchCooperativeKernel((void*)k_mega, dim3(grid), dim3(256), args, 0, stream);
  if (e != hipSuccess) fprintf(stderr, "cooperative launch failed: %s\n", hipGetErrorString(e));
#else
  k_phase<0><<<grid, 256, 0, stream>>>(P);
  k_phase<1><<<grid, 256, 0, stream>>>(P);
  k_phase<2><<<grid, 256, 0, stream>>>(P);
  k_phase<3><<<grid, 256, 0, stream>>>(P);
  k_phase<4><<<grid, 256, 0, stream>>>(P);
  k_phase<5><<<grid, 256, 0, stream>>>(P);
  k_phase<6><<<grid, 256, 0, stream>>>(P);
  k_phase<7><<<grid, 256, 0, stream>>>(P);
  k_phase<8><<<grid, 256, 0, stream>>>(P);
  k_phase<9><<<grid, 256, 0, stream>>>(P);
  k_phase<10><<<grid, 256, 0, stream>>>(P);
#endif
}
```

```cpp
#include <hip/hip_runtime.h>
#include <hip/hip_cooperative_groups.h>
#include <stdint.h>
#include <stdio.h>

#ifndef MEGA
#define MEGA 1
#endif
#ifndef NAIVE_GEMM
#define NAIVE_GEMM 0
#endif
#ifndef NAIVE_ATTN
#define NAIVE_ATTN 0
#endif

namespace cg = cooperative_groups;

#define DI __device__ __forceinline__
typedef unsigned short bf16_t;
using bf16x8 = __attribute__((ext_vector_type(8))) short;
using f32x16 = __attribute__((ext_vector_type(16))) float;
using f32x4  = __attribute__((ext_vector_type(4))) float;
using u32x4  = __attribute__((ext_vector_type(4))) unsigned;
using u32x2  = __attribute__((ext_vector_type(2))) unsigned;

#define MFMA32(a, b, c) __builtin_amdgcn_mfma_f32_32x32x16_bf16((a), (b), (c), 0, 0, 0)

constexpr int NTOK = 32768;
constexpr int DM = 1024;
constexpr float DN_ALPHA = 1.189207115002721f;
constexpr float LN_EPS = 1e-5f;
constexpr float LOG2E = 1.4426950408889634f;
constexpr float QNA_SCALE = 0.125f * LOG2E;
constexpr float QM_SCALE = 0.10206207261596577f * LOG2E;

constexpr size_t MBy = 1ull << 20;
constexpr size_t OFF_WINT = 0;
constexpr size_t OFF_WUQT = 5 * MBy;
constexpr size_t OFF_WUKVT = 6 * MBy;
constexpr size_t OFF_WOT = 7 * MBy;
constexpr size_t OFF_WQT = 9 * MBy;
constexpr size_t OFF_SUBK = 13 * MBy;
constexpr size_t OFF_ROPE = 14 * MBy;
constexpr size_t OFF_PLEWT = 15 * MBy;
constexpr size_t OFF_GATEWT = 16 * MBy;
constexpr size_t OFF_RQ = 18 * MBy;
constexpr size_t OFF_RKV = 18 * MBy + 256 * 1024;
constexpr size_t OFF_BAR = 19 * MBy;
constexpr size_t OFF_UBF = 20 * MBy;
constexpr size_t OFF_VBF = 52 * MBy;
constexpr size_t OFF_PB = 84 * MBy;
constexpr size_t OFF_H = 100 * MBy;
constexpr size_t OFF_QNA = 164 * MBy;
constexpr size_t OFF_KNA = 196 * MBy;
constexpr size_t OFF_VNAT = 228 * MBy;
constexpr size_t OFF_CQ = 260 * MBy;
constexpr size_t OFF_CKV = 284 * MBy;
constexpr size_t OFF_KR = 300 * MBy;
constexpr size_t OFF_QM = 304 * MBy;
constexpr size_t OFF_KM = 352 * MBy;
constexpr size_t OFF_VMT = 400 * MBy;
constexpr size_t OFF_MIX = 432 * MBy;
constexpr size_t OFF_QP = 164 * MBy;
constexpr size_t OFF_G = 292 * MBy;
constexpr size_t OFF_IDX = 356 * MBy;
constexpr size_t OFF_GW = 372 * MBy;

constexpr int SMEM_BYTES = 73728;

struct Params {
  const float *x, *p, *emb_g, *emb_b, *w_in, *qg, *kvg, *w_uq, *w_ukv, *rpb, *w_o, *ln1g, *ln1b, *w_q, *subk, *pu, *pv,
      *ple_w, *gate_w, *gate_b, *ln2g, *ln2b;
  float* out;
  char* ws;
};

DI unsigned short f2bf(float x) {
  unsigned u = __float_as_uint(x);
  u += 0x7fffu + ((u >> 16) & 1u);
  return (unsigned short)(u >> 16);
}
DI float bf2f(unsigned short b) { return __uint_as_float(((unsigned)b) << 16); }
DI unsigned pack2(float lo, float hi) { return (unsigned)f2bf(lo) | ((unsigned)f2bf(hi) << 16); }
DI float bflo(unsigned u) { return __uint_as_float(u << 16); }
DI float bfhi(unsigned u) { return __uint_as_float(u & 0xffff0000u); }
DI float wave_sum(float v) {
#pragma unroll
  for (int m = 32; m >= 1; m >>= 1) v += __shfl_xor(v, m);
  return v;
}
DI float fast_exp2(float x) { return __builtin_amdgcn_exp2f(x); }
DI int pi_swap23(int r) { return (r & ~12) | ((r & 4) << 1) | ((r & 8) >> 1); }

DI void transpose_cvt(const float* __restrict__ in, bf16_t* __restrict__ out, int K, int N, const float* __restrict__ g,
                      char* smem) {
  float* tile = (float*)smem;
  const int tk = K >> 5, tn = N >> 5;
  const int tx = threadIdx.x & 31, ty = threadIdx.x >> 5;
  for (int t = blockIdx.x; t < tk * tn; t += gridDim.x) {
    const int k0 = (t / tn) << 5, n0 = (t % tn) << 5;
    __syncthreads();
#pragma unroll
    for (int i = 0; i < 4; ++i) {
      const int k = k0 + ty + 8 * i;
      float v = in[(size_t)k * N + n0 + tx];
      if (g) v *= g[k];
      tile[(ty + 8 * i) * 33 + tx] = v;
    }
    __syncthreads();
#pragma unroll
    for (int i = 0; i < 4; ++i) {
      const int n = n0 + ty + 8 * i;
      out[(size_t)n * K + k0 + tx] = f2bf(tile[tx * 33 + ty + 8 * i]);
    }
  }
}

DI void straight_cvt(const float* __restrict__ in, bf16_t* __restrict__ out, size_t n) {
  const size_t n4 = n >> 2;
  for (size_t i = (size_t)blockIdx.x * 256 + threadIdx.x; i < n4; i += (size_t)gridDim.x * 256) {
    const f32x4 v = *(const f32x4*)(in + i * 4);
    u32x2 o;
    o[0] = pack2(v[0], v[1]);
    o[1] = pack2(v[2], v[3]);
    *(u32x2*)(out + i * 4) = o;
  }
}

DI void ln_rows16(float (&v)[16], const float* __restrict__ gam, const float* __restrict__ bet, int lane) {
  float s = 0.f;
#pragma unroll
  for (int i = 0; i < 16; ++i) s += v[i];
  const float mu = wave_sum(s) * (1.f / 1024.f);
  float q = 0.f;
#pragma unroll
  for (int i = 0; i < 16; ++i) {
    v[i] -= mu;
    q += v[i] * v[i];
  }
  const float rstd = rsqrtf(wave_sum(q) * (1.f / 1024.f) + LN_EPS);
#pragma unroll
  for (int g = 0; g < 4; ++g) {
    const f32x4 gg = *(const f32x4*)(gam + g * 256 + lane * 4);
    const f32x4 bb = *(const f32x4*)(bet + g * 256 + lane * 4);
#pragma unroll
    for (int c = 0; c < 4; ++c) v[g * 4 + c] = v[g * 4 + c] * rstd * gg[c] + bb[c];
  }
}

DI void phase0(const Params& P, char* smem) {
  char* ws = P.ws;
  transpose_cvt(P.w_in, (bf16_t*)(ws + OFF_WINT), 1024, 2208, nullptr, smem);
  transpose_cvt(P.w_uq, (bf16_t*)(ws + OFF_WUQT), 384, 768, P.qg, smem);
  transpose_cvt(P.w_ukv, (bf16_t*)(ws + OFF_WUKVT), 256, 1024, P.kvg, smem);
  transpose_cvt(P.w_o, (bf16_t*)(ws + OFF_WOT), 1024, 1024, nullptr, smem);
  transpose_cvt(P.w_q, (bf16_t*)(ws + OFF_WQT), 1024, 2048, nullptr, smem);
  transpose_cvt(P.ple_w, (bf16_t*)(ws + OFF_PLEWT), 256, 1024, nullptr, smem);
  transpose_cvt(P.gate_w, (bf16_t*)(ws + OFF_GATEWT), 1024, 1024, nullptr, smem);
  straight_cvt(P.subk, (bf16_t*)(ws + OFF_SUBK), 2 * 128 * 128);
  straight_cvt(P.pu, (bf16_t*)(ws + OFF_UBF), (size_t)16384 * 1024);
  straight_cvt(P.pv, (bf16_t*)(ws + OFF_VBF), (size_t)16384 * 1024);
  straight_cvt(P.p, (bf16_t*)(ws + OFF_PB), (size_t)NTOK * 256);
  float* rope = (float*)(ws + OFF_ROPE);
  for (int i = blockIdx.x * 256 + threadIdx.x; i < 2048 * 16; i += gridDim.x * 256) {
    const int s = i >> 4, j = i & 15;
    const float inv = powf(10000.f, -(float)(2 * (j & 7)) / 16.f);
    const float pos = (j < 8) ? (float)(s >> 6) : (float)(s & 63);
    const float ang = pos * inv;
    rope[s * 32 + j] = cosf(ang);
    rope[s * 32 + 16 + j] = sinf(ang);
  }
  const int lane = threadIdx.x & 63, w = threadIdx.x >> 6;
  bf16_t* h0 = (bf16_t*)(ws + OFF_H);
  for (int tok = blockIdx.x * 4 + w; tok < NTOK; tok += gridDim.x * 4) {
    float v[16];
#pragma unroll
    for (int g = 0; g < 4; ++g) {
      const f32x4 t = *(const f32x4*)(P.x + (size_t)tok * 1024 + g * 256 + lane * 4);
#pragma unroll
      for (int c = 0; c < 4; ++c) v[g * 4 + c] = t[c];
    }
    ln_rows16(v, P.emb_g, P.emb_b, lane);
#pragma unroll
    for (int g = 0; g < 4; ++g) {
      u32x2 o;
      o[0] = pack2(v[g * 4 + 0], v[g * 4 + 1]);
      o[1] = pack2(v[g * 4 + 2], v[g * 4 + 3]);
      *(u32x2*)(h0 + (size_t)tok * 1024 + g * 256 + lane * 4) = o;
    }
  }
}

template <class Epi>
DI void gemm_phase(const bf16_t* __restrict__ A, int lda, const bf16_t* __restrict__ Bt, int ldb, int M, int N, int K,
                   char* smem, const Epi& epi) {
  const int tid = threadIdx.x, lane = tid & 63, w = tid >> 6;
#if NAIVE_GEMM
  const int nb = (N + 63) >> 6;
  for (int item = blockIdx.x * 4 + w; item < M * nb; item += gridDim.x * 4) {
    const int row = item / nb, col = (item - row * nb) * 64 + lane;
    const int cc = col < N ? col : N - 1;
    float acc = 0.f;
    for (int k = 0; k < K; k += 8) {
      const u32x4 a = *(const u32x4*)(A + (size_t)row * lda + k);
      const u32x4 b = *(const u32x4*)(Bt + (size_t)cc * ldb + k);
#pragma unroll
      for (int j = 0; j < 4; ++j) acc += bflo(a[j]) * bflo(b[j]) + bfhi(a[j]) * bfhi(b[j]);
    }
    epi(row, col, acc);
  }
#else
  const int r = lane & 31, hh = lane >> 5;
  const int wm = w >> 1, wn = w & 1;
  const int nt = (N + 127) >> 7;
  const int ntiles = (M >> 7) * nt;
  bf16_t* As = (bf16_t*)smem;
  bf16_t* Bs = As + 2 * 128 * 72;
  const int nk = K >> 6;
  const int lrow = tid >> 3, lkc = (tid & 7) * 8;
  for (int tile = blockIdx.x; tile < ntiles; tile += gridDim.x) {
    const int tm = tile / nt, tn = tile - tm * nt;
    const int m0 = tm << 7, n0 = tn << 7;
    f32x16 acc[2][2];
#pragma unroll
    for (int i = 0; i < 2; ++i)
#pragma unroll
      for (int j = 0; j < 2; ++j)
#pragma unroll
        for (int e = 0; e < 16; ++e) acc[i][j][e] = 0.f;
    const bf16_t* ag = A + (size_t)(m0 + lrow) * lda + lkc;
    size_t boff[4];
#pragma unroll
    for (int i = 0; i < 4; ++i) {
      int n = n0 + lrow + 32 * i;
      n = n < N ? n : N - 1;
      boff[i] = (size_t)n * ldb + lkc;
    }
    u32x4 pa[4], pb[4];
#pragma unroll
    for (int i = 0; i < 4; ++i) {
      pa[i] = *(const u32x4*)(ag + (size_t)(32 * i) * lda);
      pb[i] = *(const u32x4*)(Bt + boff[i]);
    }
#pragma unroll
    for (int i = 0; i < 4; ++i) {
      *(u32x4*)(As + (lrow + 32 * i) * 72 + lkc) = pa[i];
      *(u32x4*)(Bs + (lrow + 32 * i) * 72 + lkc) = pb[i];
    }
    __syncthreads();
    for (int kt = 0; kt < nk; ++kt) {
      const int cur = kt & 1;
      if (kt + 1 < nk) {
        const int k0 = (kt + 1) << 6;
#pragma unroll
        for (int i = 0; i < 4; ++i) {
          pa[i] = *(const u32x4*)(ag + (size_t)(32 * i) * lda + k0);
          pb[i] = *(const u32x4*)(Bt + boff[i] + k0);
        }
      }
      const bf16_t* as = As + cur * (128 * 72) + (wm * 64 + r) * 72 + hh * 8;
      const bf16_t* bs = Bs + cur * (128 * 72) + (wn * 64 + r) * 72 + hh * 8;
#pragma unroll
      for (int ks = 0; ks < 4; ++ks) {
        const bf16x8 a0 = *(const bf16x8*)(as + ks * 16);
        const bf16x8 a1 = *(const bf16x8*)(as + 32 * 72 + ks * 16);
        const bf16x8 b0 = *(const bf16x8*)(bs + ks * 16);
        const bf16x8 b1 = *(const bf16x8*)(bs + 32 * 72 + ks * 16);
        acc[0][0] = MFMA32(a0, b0, acc[0][0]);
        acc[0][1] = MFMA32(a0, b1, acc[0][1]);
        acc[1][0] = MFMA32(a1, b0, acc[1][0]);
        acc[1][1] = MFMA32(a1, b1, acc[1][1]);
      }
      if (kt + 1 < nk) {
        const int nx = cur ^ 1;
#pragma unroll
        for (int i = 0; i < 4; ++i) {
          *(u32x4*)(As + nx * (128 * 72) + (lrow + 32 * i) * 72 + lkc) = pa[i];
          *(u32x4*)(Bs + nx * (128 * 72) + (lrow + 32 * i) * 72 + lkc) = pb[i];
        }
      }
      __syncthreads();
    }
#pragma unroll
    for (int mi = 0; mi < 2; ++mi)
#pragma unroll
      for (int ni = 0; ni < 2; ++ni) {
#pragma unroll
        for (int e = 0; e < 16; ++e) {
          const int row = m0 + wm * 64 + mi * 32 + (e & 3) + 8 * (e >> 2) + 4 * hh;
          const int col = n0 + wn * 64 + ni * 32 + r;
          epi(row, col, acc[mi][ni][e]);
        }
        asm volatile("" ::: "memory");
      }
  }
#endif
}

struct EpiInProj {
  bf16_t *qna, *kna, *vnat, *cq, *ckv;
  float* kr;
  DI void operator()(int row, int col, float v) const {
    if (col >= 2208) return;
    const int b = row >> 11, s = row & 2047;
    if (col < 1536) {
      const int sec = col >> 9, c = col & 511, h = c >> 6, d = c & 63;
      const size_t bh = (size_t)(b * 8 + h);
      if (sec == 0) qna[(bh * 2048 + s) * 64 + d] = f2bf(v * QNA_SCALE);
      else if (sec == 1) kna[(bh * 2048 + s) * 64 + d] = f2bf(v);
      else vnat[(bh * 64 + d) * 2048 + s] = f2bf(v);
    } else if (col < 1920) {
      cq[(size_t)row * 384 + (col - 1536)] = f2bf(v);
    } else if (col < 2176) {
      ckv[(size_t)row * 256 + (col - 1920)] = f2bf(v);
    } else {
      kr[(size_t)row * 32 + (col - 2176)] = v;
    }
  }
};
struct EpiUpQ {
  const float* rq;
  const float* rope;
  bf16_t* qm;
  DI void operator()(int row, int col, float v) const {
    v *= rq[row];
    const float pv = __shfl_xor(v, 1);
    const int hd = col / 96, d = col - hd * 96;
    const int b = row >> 11, s = row & 2047;
    float o = v;
    if (d >= 64) {
      const int i = (d - 64) >> 1;
      const float c = rope[s * 32 + i], sn = rope[s * 32 + 16 + i];
      o = (d & 1) ? (pv * sn + v * c) : (v * c - pv * sn);
    }
    qm[((size_t)(b * 8 + hd) * 2048 + s) * 96 + d] = f2bf(o * QM_SCALE);
  }
};
struct EpiUpKV {
  const float* rkv;
  bf16_t *km, *vmt;
  DI void operator()(int row, int col, float v) const {
    v *= rkv[row];
    const int hd = col >> 7, d = col & 127;
    const int b = row >> 11, s = row & 2047;
    const size_t bh = (size_t)(b * 8 + hd);
    if (d < 64) km[(bh * 2048 + s) * 96 + d] = f2bf(v);
    else vmt[(bh * 64 + (d - 64)) * 2048 + s] = f2bf(v);
  }
};
struct EpiWo {
  const bf16_t* h0;
  float* y1;
  DI void operator()(int row, int col, float v) const {
    const size_t i = (size_t)row * 1024 + col;
    y1[i] = DN_ALPHA * bf2f(h0[i]) + v;
  }
};
struct EpiPeerQ {
  bf16_t* qp;
  DI void operator()(int row, int col, float v) const { qp[(size_t)row * 2048 + col] = f2bf(v); }
};
struct EpiGate {
  const float* gb;
  bf16_t* G;
  DI void operator()(int row, int col, float v) const {
    G[(size_t)row * 1024 + col] = f2bf(1.f / (1.f + __expf(-(v + gb[col]))));
  }
};
struct EpiPle {
  const bf16_t *h1, *G;
  float* y2;
  DI void operator()(int row, int col, float v) const {
    const size_t i = (size_t)row * 1024 + col;
    y2[i] = DN_ALPHA * bf2f(h1[i]) + bf2f(G[i]) * v;
  }
};

DI void phase_stats(const Params& P) {
  char* ws = P.ws;
  const bf16_t* cq = (const bf16_t*)(ws + OFF_CQ);
  const bf16_t* ckv = (const bf16_t*)(ws + OFF_CKV);
  const float* kr = (const float*)(ws + OFF_KR);
  const float* rope = (const float*)(ws + OFF_ROPE);
  float* rq = (float*)(ws + OFF_RQ);
  float* rkv = (float*)(ws + OFF_RKV);
  bf16_t* km = (bf16_t*)(ws + OFF_KM);
  const int lane = threadIdx.x & 63, w = threadIdx.x >> 6;
  for (int tok = blockIdx.x * 4 + w; tok < NTOK; tok += gridDim.x * 4) {
    float s1 = 0.f, s2 = 0.f;
#pragma unroll
    for (int i = 0; i < 6; ++i) {
      const float v = bf2f(cq[(size_t)tok * 384 + i * 64 + lane]);
      s1 += v * v;
    }
#pragma unroll
    for (int i = 0; i < 4; ++i) {
      const float v = bf2f(ckv[(size_t)tok * 256 + i * 64 + lane]);
      s2 += v * v;
    }
    s1 = wave_sum(s1);
    s2 = wave_sum(s2);
    if (lane == 0) {
      rq[tok] = rsqrtf(s1 * (1.f / 384.f) + LN_EPS);
      rkv[tok] = rsqrtf(s2 * (1.f / 256.f) + LN_EPS);
    }
    if (lane < 16) {
      const int b = tok >> 11, s = tok & 2047;
      const float x1 = kr[(size_t)tok * 32 + 2 * lane], x2 = kr[(size_t)tok * 32 + 2 * lane + 1];
      const float c = rope[s * 32 + lane], sn = rope[s * 32 + 16 + lane];
      const unsigned o = pack2(x1 * c - x2 * sn, x1 * sn + x2 * c);
#pragma unroll
      for (int h = 0; h < 8; ++h) *(unsigned*)(km + ((size_t)(b * 8 + h) * 2048 + s) * 96 + 64 + 2 * lane) = o;
    }
  }
}

DI bf16x8 pack8(const f32x16& x, int base) {
  u32x4 p;
  p[0] = pack2(x[base + 0], x[base + 1]);
  p[1] = pack2(x[base + 2], x[base + 3]);
  p[2] = pack2(x[base + 4], x[base + 5]);
  p[3] = pack2(x[base + 6], x[base + 7]);
  return __builtin_bit_cast(bf16x8, p);
}

DI void softmax_step(f32x16 (&sacc)[2], float& m, float& l, f32x16 (&oacc)[2], bf16x8 (&pf)[4]) {
  float mx = sacc[0][0];
#pragma unroll
  for (int e = 1; e < 16; ++e) mx = fmaxf(mx, sacc[0][e]);
#pragma unroll
  for (int e = 0; e < 16; ++e) mx = fmaxf(mx, sacc[1][e]);
  mx = fmaxf(mx, __shfl_xor(mx, 32));
  const float mnew = fmaxf(m, mx);
  const float alpha = fast_exp2(m - mnew);
  m = mnew;
  float ps = 0.f;
#pragma unroll
  for (int t = 0; t < 2; ++t)
#pragma unroll
    for (int e = 0; e < 16; ++e) {
      const float p = fast_exp2(sacc[t][e] - mnew);
      sacc[t][e] = p;
      ps += p;
    }
  l = l * alpha + ps;
#pragma unroll
  for (int t = 0; t < 2; ++t)
#pragma unroll
    for (int e = 0; e < 16; ++e) oacc[t][e] *= alpha;
  pf[0] = pack8(sacc[0], 0);
  pf[1] = pack8(sacc[0], 8);
  pf[2] = pack8(sacc[1], 0);
  pf[3] = pack8(sacc[1], 8);
}

DI void store_o(const f32x16 (&oacc)[2], float l, bf16_t* dst  , int hh) {
  const float lt = l + __shfl_xor(l, 32);
  const float inv = 1.f / lt;
#pragma unroll
  for (int dt = 0; dt < 2; ++dt)
#pragma unroll
    for (int g = 0; g < 4; ++g) {
      u32x2 o;
      o[0] = pack2(oacc[dt][4 * g + 0] * inv, oacc[dt][4 * g + 1] * inv);
      o[1] = pack2(oacc[dt][4 * g + 2] * inv, oacc[dt][4 * g + 3] * inv);
      *(u32x2*)(dst + 32 * dt + 8 * g + 4 * hh) = o;
    }
}

DI void phase_attn(const Params& P, char* smem) {
  char* ws = P.ws;
  const bf16_t* QNA = (const bf16_t*)(ws + OFF_QNA);
  const bf16_t* KNA = (const bf16_t*)(ws + OFF_KNA);
  const bf16_t* VNAT = (const bf16_t*)(ws + OFF_VNAT);
  const bf16_t* QM = (const bf16_t*)(ws + OFF_QM);
  const bf16_t* KM = (const bf16_t*)(ws + OFF_KM);
  const bf16_t* VMT = (const bf16_t*)(ws + OFF_VMT);
  bf16_t* mix = (bf16_t*)(ws + OFF_MIX);
  const int tid = threadIdx.x, lane = tid & 63, w = tid >> 6;
#if NAIVE_ATTN
  (void)smem;
  const int gt = blockIdx.x * 256 + tid, nth = gridDim.x * 256;
  for (int idx = gt; idx < 128 * 2048; idx += nth) {
    const int bh = idx >> 11, s = idx & 2047, h = bh & 7, b = bh >> 3;
    const int rr = s >> 6, qc = s & 63;
    int rs = rr - 4; rs = rs < 0 ? 0 : (rs > 24 ? 24 : rs);
    int cs = qc - 8; cs = cs < 0 ? 0 : (cs > 48 ? 48 : cs);
    float q[64], o[64];
#pragma unroll
    for (int d = 0; d < 64; ++d) { q[d] = bf2f(QNA[((size_t)bh * 2048 + s) * 64 + d]); o[d] = 0.f; }
    float m = -1e30f, l = 0.f;
    for (int i = 0; i < 8; ++i)
      for (int j = 0; j < 16; ++j) {
        const int key = (rs + i) * 64 + cs + j;
        const bf16_t* kp = KNA + ((size_t)bh * 2048 + key) * 64;
        float sc = 0.f;
#pragma unroll
        for (int d = 0; d < 64; ++d) sc += q[d] * bf2f(kp[d]);
        sc += P.rpb[h * 465 + (rs + i - rr + 7) * 31 + (cs + j - qc + 15)] * LOG2E;
        const float mn = fmaxf(m, sc), al = exp2f(m - mn), pp = exp2f(sc - mn);
        m = mn; l = l * al + pp;
#pragma unroll
        for (int d = 0; d < 64; ++d) o[d] = o[d] * al + pp * bf2f(VNAT[((size_t)bh * 64 + d) * 2048 + key]);
      }
    const float inv = 1.f / l;
#pragma unroll
    for (int d = 0; d < 64; ++d) mix[((size_t)b * 2048 + s) * 1024 + h * 64 + d] = f2bf(o[d] * inv);
  }
  for (int idx = gt; idx < 128 * 2048; idx += nth) {
    const int bh = idx >> 11, s = idx & 2047, h = bh & 7, b = bh >> 3;
    float q[96], o[64];
#pragma unroll
    for (int d = 0; d < 96; ++d) q[d] = bf2f(QM[((size_t)bh * 2048 + s) * 96 + d]);
#pragma unroll
    for (int d = 0; d < 64; ++d) o[d] = 0.f;
    float m = -1e30f, l = 0.f;
    for (int key = 0; key < 2048; ++key) {
      const bf16_t* kp = KM + ((size_t)bh * 2048 + key) * 96;
      float sc = 0.f;
#pragma unroll
      for (int d = 0; d < 96; ++d) sc += q[d] * bf2f(kp[d]);
      const float mn = fmaxf(m, sc), al = exp2f(m - mn), pp = exp2f(sc - mn);
      m = mn; l = l * al + pp;
#pragma unroll
      for (int d = 0; d < 64; ++d) o[d] = o[d] * al + pp * bf2f(VMT[((size_t)bh * 64 + d) * 2048 + key]);
    }
    const float inv = 1.f / l;
#pragma unroll
    for (int d = 0; d < 64; ++d) mix[((size_t)b * 2048 + s) * 1024 + 512 + h * 64 + d] = f2bf(o[d] * inv);
  }
#else
  const int r = lane & 31, hh = lane >> 5;
  const int pr = pi_swap23(r);
  float* bl = (float*)(smem + 45056);
  __syncthreads();
  for (int i = tid; i < 8 * 465; i += 256) bl[i] = P.rpb[i] * LOG2E;
  __syncthreads();
  for (int item = blockIdx.x * 4 + w; item < 8192; item += gridDim.x * 4) {
    const int half = item & 1, h = (item >> 1) & 7, rr = (item >> 4) & 31, b = item >> 9;
    const size_t bh = (size_t)(b * 8 + h);
    int rs = rr - 4; rs = rs < 0 ? 0 : (rs > 24 ? 24 : rs);
    const int qc = 32 * half + r;
    int cs = qc - 8; cs = cs < 0 ? 0 : (cs > 48 ? 48 : cs);
    bf16x8 qf[4];
#pragma unroll
    for (int s = 0; s < 4; ++s) qf[s] = *(const bf16x8*)(QNA + (bh * 2048 + rr * 64 + qc) * 64 + 16 * s + 8 * hh);
    f32x16 oacc[2];
#pragma unroll
    for (int t = 0; t < 2; ++t)
#pragma unroll
      for (int e = 0; e < 16; ++e) oacc[t][e] = 0.f;
    float m = -1e30f, l = 0.f;
    for (int i = 0; i < 8; ++i) {
      const int key0 = (rs + i) * 64;
      f32x16 sacc[2];
#pragma unroll
      for (int t = 0; t < 2; ++t)
#pragma unroll
        for (int e = 0; e < 16; ++e) sacc[t][e] = 0.f;
#pragma unroll
      for (int kt = 0; kt < 2; ++kt)
#pragma unroll
        for (int s = 0; s < 4; ++s) {
          const bf16x8 kf = *(const bf16x8*)(KNA + (bh * 2048 + key0 + 32 * kt + pr) * 64 + 16 * s + 8 * hh);
          sacc[kt] = MFMA32(kf, qf[s], sacc[kt]);
        }
      const float* brow = bl + h * 465 + (rs + i - rr + 7) * 31;
#pragma unroll
      for (int kt = 0; kt < 2; ++kt)
#pragma unroll
        for (int e = 0; e < 16; ++e) {
          const int kc = 32 * kt + (e & 7) + 8 * hh + 16 * (e >> 3);
          const bool valid = (unsigned)(kc - cs) < 16u;
          int dj = kc - qc + 15;
          dj = dj < 0 ? 0 : (dj > 30 ? 30 : dj);
          const float bias = brow[dj];
          sacc[kt][e] = valid ? sacc[kt][e] + bias : -INFINITY;
        }
      bf16x8 pf[4];
      softmax_step(sacc, m, l, oacc, pf);
#pragma unroll
      for (int dt = 0; dt < 2; ++dt)
#pragma unroll
        for (int s = 0; s < 4; ++s) {
          const bf16x8 vf = *(const bf16x8*)(VNAT + (bh * 64 + 32 * dt + r) * 2048 + key0 + 16 * s + 8 * hh);
          oacc[dt] = MFMA32(vf, pf[s], oacc[dt]);
        }
    }
    store_o(oacc, l, mix + ((size_t)b * 2048 + rr * 64 + qc) * 1024 + h * 64, hh);
  }
  bf16_t* Ks = (bf16_t*)smem;
  bf16_t* Vs = (bf16_t*)(smem + 2 * 13312);
  for (int item = blockIdx.x; item < 2048; item += gridDim.x) {
    const int bh = item >> 4, qt = item & 15;
    const int b = bh >> 3, h = bh & 7;
    const int q0 = qt * 128 + w * 32;
    bf16x8 qf[6];
#pragma unroll
    for (int s = 0; s < 6; ++s) qf[s] = *(const bf16x8*)(QM + ((size_t)bh * 2048 + q0 + r) * 96 + 16 * s + 8 * hh);
    f32x16 oacc[2];
#pragma unroll
    for (int t = 0; t < 2; ++t)
#pragma unroll
      for (int e = 0; e < 16; ++e) oacc[t][e] = 0.f;
    float m = -1e30f, l = 0.f;
    const bf16_t* kg = KM + (size_t)bh * 2048 * 96;
    const bf16_t* vg = VMT + (size_t)bh * 64 * 2048;
    u32x4 pk[3], pv[2];
    int klds[3], vlds[2];
    size_t vgo[2];
#pragma unroll
    for (int i = 0; i < 3; ++i) {
      const int c = tid + 256 * i;
      klds[i] = (c / 12) * 104 + (c % 12) * 8;
    }
#pragma unroll
    for (int i = 0; i < 2; ++i) {
      const int c = tid + 256 * i;
      vlds[i] = (c >> 3) * 72 + (c & 7) * 8;
      vgo[i] = (size_t)(c >> 3) * 2048 + (c & 7) * 8;
    }
    __syncthreads();
#pragma unroll
    for (int i = 0; i < 3; ++i) pk[i] = *(const u32x4*)(kg + (size_t)(tid + 256 * i) * 8);
#pragma unroll
    for (int i = 0; i < 2; ++i) pv[i] = *(const u32x4*)(vg + vgo[i]);
#pragma unroll
    for (int i = 0; i < 3; ++i) *(u32x4*)(Ks + klds[i]) = pk[i];
#pragma unroll
    for (int i = 0; i < 2; ++i) *(u32x4*)(Vs + vlds[i]) = pv[i];
    __syncthreads();
    for (int j = 0; j < 32; ++j) {
      const int cur = j & 1;
      if (j + 1 < 32) {
        const bf16_t* kgn = kg + (size_t)(j + 1) * 64 * 96;
#pragma unroll
        for (int i = 0; i < 3; ++i) pk[i] = *(const u32x4*)(kgn + (size_t)(tid + 256 * i) * 8);
#pragma unroll
        for (int i = 0; i < 2; ++i) pv[i] = *(const u32x4*)(vg + vgo[i] + (j + 1) * 64);
      }
      const bf16_t* ks = Ks + cur * (64 * 104);
      const bf16_t* vs = Vs + cur * (64 * 72);
      f32x16 sacc[2];
#pragma unroll
      for (int t = 0; t < 2; ++t)
#pragma unroll
        for (int e = 0; e < 16; ++e) sacc[t][e] = 0.f;
#pragma unroll
      for (int kt = 0; kt < 2; ++kt)
#pragma unroll
        for (int s = 0; s < 6; ++s) {
          const bf16x8 kf = *(const bf16x8*)(ks + (32 * kt + pr) * 104 + 16 * s + 8 * hh);
          sacc[kt] = MFMA32(kf, qf[s], sacc[kt]);
        }
      bf16x8 pf[4];
      softmax_step(sacc, m, l, oacc, pf);
#pragma unroll
      for (int dt = 0; dt < 2; ++dt)
#pragma unroll
        for (int s = 0; s < 4; ++s) {
          const bf16x8 vf = *(const bf16x8*)(vs + (32 * dt + r) * 72 + 16 * s + 8 * hh);
          oacc[dt] = MFMA32(vf, pf[s], oacc[dt]);
        }
      if (j + 1 < 32) {
        const int nx = cur ^ 1;
#pragma unroll
        for (int i = 0; i < 3; ++i) *(u32x4*)(Ks + nx * (64 * 104) + klds[i]) = pk[i];
#pragma unroll
        for (int i = 0; i < 2; ++i) *(u32x4*)(Vs + nx * (64 * 72) + vlds[i]) = pv[i];
      }
      __syncthreads();
    }
    store_o(oacc, l, mix + ((size_t)b * 2048 + q0 + r) * 1024 + 512 + h * 64, hh);
  }
#endif
}

DI void phase_ln1(const Params& P) {
  const int lane = threadIdx.x & 63, w = threadIdx.x >> 6;
  bf16_t* h1 = (bf16_t*)(P.ws + OFF_H);
  for (int tok = blockIdx.x * 4 + w; tok < NTOK; tok += gridDim.x * 4) {
    float v[16];
#pragma unroll
    for (int g = 0; g < 4; ++g) {
      const f32x4 t = *(const f32x4*)(P.out + (size_t)tok * 1024 + g * 256 + lane * 4);
#pragma unroll
      for (int c = 0; c < 4; ++c) v[g * 4 + c] = t[c];
    }
    ln_rows16(v, P.ln1g, P.ln1b, lane);
#pragma unroll
    for (int g = 0; g < 4; ++g) {
      u32x2 o;
      o[0] = pack2(v[g * 4 + 0], v[g * 4 + 1]);
      o[1] = pack2(v[g * 4 + 2], v[g * 4 + 3]);
      *(u32x2*)(h1 + (size_t)tok * 1024 + g * 256 + lane * 4) = o;
    }
  }
}

DI void wave_argmax(float& bv, int& bi) {
#pragma unroll
  for (int msk = 32; msk >= 1; msk >>= 1) {
    const float ov = __shfl_xor(bv, msk);
    const int oi = __shfl_xor(bi, msk);
    const bool take = (ov > bv) || (ov == bv && oi < bi);
    bv = take ? ov : bv;
    bi = take ? oi : bi;
  }
}

DI void phase_topk(const Params& P, char* smem) {
  char* ws = P.ws;
  const bf16_t* qp = (const bf16_t*)(ws + OFF_QP);
  const bf16_t* subk = (const bf16_t*)(ws + OFF_SUBK);
  int* idx_out = (int*)(ws + OFF_IDX);
  float* g_out = (float*)(ws + OFF_GW);
  const int tid = threadIdx.x, lane = tid & 63, w = tid >> 6;
  bf16_t* skT = (bf16_t*)smem;
  float* qs = (float*)(smem + 65536) + w * 256;
  __syncthreads();
  for (int i = tid; i < 2 * 128 * 128; i += 256) {
    const int c = i >> 14, k = (i >> 7) & 127, d = i & 127;
    skT[(c * 128 + d) * 128 + k] = subk[i];
  }
  __syncthreads();
  for (int item = blockIdx.x * 4 + w; item < NTOK * 8; item += gridDim.x * 4) {
    const int tok = item >> 3, h = item & 7;
#pragma unroll
    for (int i = 0; i < 4; ++i) qs[i * 64 + lane] = bf2f(qp[(size_t)tok * 2048 + h * 256 + i * 64 + lane]);
    float sc[2][2];
#pragma unroll
    for (int c = 0; c < 2; ++c) {
      float a0 = 0.f, a1 = 0.f;
#pragma unroll 4
      for (int d = 0; d < 128; ++d) {
        const float qd = qs[c * 128 + d];
        a0 += qd * bf2f(skT[(c * 128 + d) * 128 + lane]);
        a1 += qd * bf2f(skT[(c * 128 + d) * 128 + 64 + lane]);
      }
      sc[c][0] = a0;
      sc[c][1] = a1;
    }
    float tv[2];
    int ti[2];
#pragma unroll
    for (int c = 0; c < 2; ++c) {
      float v0 = sc[c][0], v1 = sc[c][1];
      float keepv = 0.f;
      int keepi = 0;
#pragma unroll 1
      for (int rnd = 0; rnd < 16; ++rnd) {
        float bv = (v0 >= v1) ? v0 : v1;
        int bi = (v0 >= v1) ? lane : lane + 64;
        wave_argmax(bv, bi);
        if (bi == lane) v0 = -INFINITY;
        if (bi == lane + 64) v1 = -INFINITY;
        if (lane == rnd) { keepv = bv; keepi = bi; }
      }
      tv[c] = keepv;
      ti[c] = keepi;
    }
    const float va = __shfl(tv[0], lane >> 2);
    float cand[4];
#pragma unroll
    for (int j = 0; j < 4; ++j) cand[j] = va + __shfl(tv[1], (lane & 3) * 4 + j);
    float cv = 0.f;
    int cci = 0;
#pragma unroll 1
    for (int rnd = 0; rnd < 16; ++rnd) {
      float bv = cand[0];
      int bi = 4 * lane;
#pragma unroll
      for (int j = 1; j < 4; ++j)
        if (cand[j] > bv) { bv = cand[j]; bi = 4 * lane + j; }
      wave_argmax(bv, bi);
#pragma unroll
      for (int j = 0; j < 4; ++j)
        if (bi == 4 * lane + j) cand[j] = -INFINITY;
      if (lane == rnd) { cv = bv; cci = bi; }
    }
    const int e1 = __shfl(ti[0], (cci >> 4) & 15);
    const int e2 = __shfl(ti[1], cci & 15);
    const float mx = __shfl(cv, 0);
    const float ex = (lane < 16) ? __expf(cv - mx) : 0.f;
    const float sum = wave_sum(ex);
    if (lane < 16) {
      idx_out[(size_t)tok * 128 + h * 16 + lane] = e1 * 128 + e2;
      g_out[(size_t)tok * 128 + h * 16 + lane] = ex / sum;
    }
  }
}

DI void phase_gather(const Params& P) {
  char* ws = P.ws;
  const bf16_t* h1 = (const bf16_t*)(ws + OFF_H);
  const bf16_t* U = (const bf16_t*)(ws + OFF_UBF);
  const bf16_t* V = (const bf16_t*)(ws + OFF_VBF);
  const int* idxb = (const int*)(ws + OFF_IDX);
  const float* gwb = (const float*)(ws + OFF_GW);
  const int lane = threadIdx.x & 63, w = threadIdx.x >> 6;
  for (int tok = blockIdx.x * 4 + w; tok < NTOK; tok += gridDim.x * 4) {
    float xv[16];
    {
      const u32x4 a = *(const u32x4*)(h1 + (size_t)tok * 1024 + 8 * lane);
      const u32x4 b = *(const u32x4*)(h1 + (size_t)tok * 1024 + 512 + 8 * lane);
#pragma unroll
      for (int j = 0; j < 4; ++j) {
        xv[2 * j] = bflo(a[j]); xv[2 * j + 1] = bfhi(a[j]);
        xv[8 + 2 * j] = bflo(b[j]); xv[8 + 2 * j + 1] = bfhi(b[j]);
      }
    }
    const int id0 = idxb[(size_t)tok * 128 + lane], id1 = idxb[(size_t)tok * 128 + 64 + lane];
    const float g0 = gwb[(size_t)tok * 128 + lane], g1 = gwb[(size_t)tok * 128 + 64 + lane];
    float act0 = 0.f, act1 = 0.f;
    for (int e = 0; e < 128; ++e) {
      const int id = __shfl(e < 64 ? id0 : id1, e & 63);
      const u32x4 a = *(const u32x4*)(U + (size_t)id * 1024 + 8 * lane);
      const u32x4 b = *(const u32x4*)(U + (size_t)id * 1024 + 512 + 8 * lane);
      float d = 0.f;
#pragma unroll
      for (int j = 0; j < 4; ++j) {
        d += xv[2 * j] * bflo(a[j]) + xv[2 * j + 1] * bfhi(a[j]);
        d += xv[8 + 2 * j] * bflo(b[j]) + xv[8 + 2 * j + 1] * bfhi(b[j]);
      }
      d = wave_sum(d);
      if (e < 64) { if (lane == e) act0 = d; }
      else { if (lane == e - 64) act1 = d; }
    }
    act0 = g0 * 0.5f * act0 * (1.f + erff(act0 * 0.70710678118654752f));
    act1 = g1 * 0.5f * act1 * (1.f + erff(act1 * 0.70710678118654752f));
    float acc[16];
#pragma unroll
    for (int i = 0; i < 16; ++i) acc[i] = 0.f;
    for (int e = 0; e < 128; ++e) {
      const int id = __shfl(e < 64 ? id0 : id1, e & 63);
      const float a_e = __shfl(e < 64 ? act0 : act1, e & 63);
      const u32x4 a = *(const u32x4*)(V + (size_t)id * 1024 + 8 * lane);
      const u32x4 b = *(const u32x4*)(V + (size_t)id * 1024 + 512 + 8 * lane);
#pragma unroll
      for (int j = 0; j < 4; ++j) {
        acc[2 * j] += a_e * bflo(a[j]); acc[2 * j + 1] += a_e * bfhi(a[j]);
        acc[8 + 2 * j] += a_e * bflo(b[j]); acc[8 + 2 * j + 1] += a_e * bfhi(b[j]);
      }
    }
    float* orow = P.out + (size_t)tok * 1024;
    float y[16];
#pragma unroll
    for (int hlf = 0; hlf < 2; ++hlf)
#pragma unroll
      for (int q = 0; q < 2; ++q) {
        const f32x4 t = *(const f32x4*)(orow + hlf * 512 + 8 * lane + 4 * q);
#pragma unroll
        for (int c = 0; c < 4; ++c) y[hlf * 8 + q * 4 + c] = t[c] + acc[hlf * 8 + q * 4 + c];
      }
    float s = 0.f;
#pragma unroll
    for (int i = 0; i < 16; ++i) s += y[i];
    const float mu = wave_sum(s) * (1.f / 1024.f);
    float qq = 0.f;
#pragma unroll
    for (int i = 0; i < 16; ++i) { y[i] -= mu; qq += y[i] * y[i]; }
    const float rstd = rsqrtf(wave_sum(qq) * (1.f / 1024.f) + LN_EPS);
#pragma unroll
    for (int hlf = 0; hlf < 2; ++hlf)
#pragma unroll
      for (int q = 0; q < 2; ++q) {
        const int off = hlf * 512 + 8 * lane + 4 * q;
        const f32x4 gg = *(const f32x4*)(P.ln2g + off);
        const f32x4 bb = *(const f32x4*)(P.ln2b + off);
        f32x4 o;
#pragma unroll
        for (int c = 0; c < 4; ++c) o[c] = y[hlf * 8 + q * 4 + c] * rstd * gg[c] + bb[c];
        *(f32x4*)(orow + off) = o;
      }
  }
}

template <int PH>
DI void run_phase(const Params& P, char* smem) {
  char* ws = P.ws;
  if constexpr (PH == 0) {
    phase0(P, smem);
  } else if constexpr (PH == 1) {
    EpiInProj e{(bf16_t*)(ws + OFF_QNA), (bf16_t*)(ws + OFF_KNA), (bf16_t*)(ws + OFF_VNAT), (bf16_t*)(ws + OFF_CQ),
                (bf16_t*)(ws + OFF_CKV), (float*)(ws + OFF_KR)};
    gemm_phase((const bf16_t*)(ws + OFF_H), 1024, (const bf16_t*)(ws + OFF_WINT), 1024, NTOK, 2208, 1024, smem, e);
  } else if constexpr (PH == 2) {
    phase_stats(P);
  } else if constexpr (PH == 3) {
    EpiUpQ eq{(const float*)(ws + OFF_RQ), (const float*)(ws + OFF_ROPE), (bf16_t*)(ws + OFF_QM)};
    gemm_phase((const bf16_t*)(ws + OFF_CQ), 384, (const bf16_t*)(ws + OFF_WUQT), 384, NTOK, 768, 384, smem, eq);
    EpiUpKV ek{(const float*)(ws + OFF_RKV), (bf16_t*)(ws + OFF_KM), (bf16_t*)(ws + OFF_VMT)};
    gemm_phase((const bf16_t*)(ws + OFF_CKV), 256, (const bf16_t*)(ws + OFF_WUKVT), 256, NTOK, 1024, 256, smem, ek);
  } else if constexpr (PH == 4) {
    phase_attn(P, smem);
  } else if constexpr (PH == 5) {
    EpiWo e{(const bf16_t*)(ws + OFF_H), P.out};
    gemm_phase((const bf16_t*)(ws + OFF_MIX), 1024, (const bf16_t*)(ws + OFF_WOT), 1024, NTOK, 1024, 1024, smem, e);
  } else if constexpr (PH == 6) {
    phase_ln1(P);
  } else if constexpr (PH == 7) {
    EpiPeerQ e{(bf16_t*)(ws + OFF_QP)};
    gemm_phase((const bf16_t*)(ws + OFF_H), 1024, (const bf16_t*)(ws + OFF_WQT), 1024, NTOK, 2048, 1024, smem, e);
    EpiGate eg{P.gate_b, (bf16_t*)(ws + OFF_G)};
    gemm_phase((const bf16_t*)(ws + OFF_H), 1024, (const bf16_t*)(ws + OFF_GATEWT), 1024, NTOK, 1024, 1024, smem, eg);
  } else if constexpr (PH == 8) {
    EpiPle e{(const bf16_t*)(ws + OFF_H), (const bf16_t*)(ws + OFF_G), P.out};
    gemm_phase((const bf16_t*)(ws + OFF_PB), 256, (const bf16_t*)(ws + OFF_PLEWT), 256, NTOK, 1024, 256, smem, e);
  } else if constexpr (PH == 9) {
    phase_topk(P, smem);
  } else if constexpr (PH == 10) {
    phase_gather(P);
  }
}

constexpr int NPHASE = 11;

template <int PH>
__global__ void __launch_bounds__(256, 2) k_phase(Params P) {
  __shared__ __attribute__((aligned(16))) char smem[SMEM_BYTES];
  run_phase<PH>(P, smem);
}

__global__ void __launch_bounds__(256, 2) k_mega(Params P) {
  __shared__ __attribute__((aligned(16))) char smem[SMEM_BYTES];
  cg::grid_group grid = cg::this_grid();
  run_phase<0>(P, smem); grid.sync();
  run_phase<1>(P, smem); grid.sync();
  run_phase<2>(P, smem); grid.sync();
  run_phase<3>(P, smem); grid.sync();
  run_phase<4>(P, smem); grid.sync();
  run_phase<5>(P, smem); grid.sync();
  run_phase<6>(P, smem); grid.sync();
  run_phase<7>(P, smem); grid.sync();
  run_phase<8>(P, smem);
  run_phase<9>(P, smem); grid.sync();
  run_phase<10>(P, smem);
}

extern "C" void kernel_launch(void* const* d_in, const int* in_sizes, int n_in, void* d_out, int out_size, void* d_ws,
                              size_t ws_size, hipStream_t stream) {
  (void)in_sizes; (void)n_in; (void)out_size; (void)ws_size;
  Params P{};
  const float** pp = (const float**)&P;
  for (int i = 0; i < 22; ++i) pp[i] = (const float*)d_in[i];
  P.out = (float*)d_out;
  P.ws = (char*)d_ws;
#if MEGA
  static int grid = 0;
  if (!grid) {
    int dev = 0, cus = 0, per_cu = 0;
    hipGetDevice(&dev);
    hipDeviceGetAttribute(&cus, hipDeviceAttributeMultiprocessorCount, dev);
    hipOccupancyMaxActiveBlocksPerMultiprocessor(&per_cu, k_mega, 256, 0);
    if (per_cu > 2) per_cu = 2;
    if (per_cu < 1) per_cu = 1;
    grid = cus * per_cu;
  }
  void* args[] = {&P};
  hipError_t e = hipLaunchCooperativeKernel((void*)k_mega, dim3(grid), dim3(256), args, 0, stream);
  if (e != hipSuccess) fprintf(stderr, "cooperative launch failed: %s\n", hipGetErrorString(e));
#else
  const int grid = 512;
  k_phase<0><<<grid, 256, 0, stream>>>(P);
  k_phase<1><<<grid, 256, 0, stream>>>(P);
  k_phase<2><<<grid, 256, 0, stream>>>(P);
  k_phase<3><<<grid, 256, 0, stream>>>(P);
  k_phase<4><<<grid, 256, 0, stream>>>(P);
  k_phase<5><<<grid, 256, 0, stream>>>(P);
  k_phase<6><<<grid, 256, 0, stream>>>(P);
  k_phase<7><<<grid, 256, 0, stream>>>(P);
  k_phase<8><<<grid, 256, 0, stream>>>(P);
  k_phase<9><<<grid, 256, 0, stream>>>(P);
  k_phase<10><<<grid, 256, 0, stream>>>(P);
#endif
}
```

```cpp
#include <hip/hip_runtime.h>
#include <hip/hip_cooperative_groups.h>
#include <stdint.h>
#include <stdio.h>

#ifndef MEGA
#define MEGA 1
#endif
#ifndef NAIVE_GEMM
#define NAIVE_GEMM 0
#endif
#ifndef NAIVE_ATTN
#define NAIVE_ATTN 0
#endif

namespace cg = cooperative_groups;

#define DI __device__ __forceinline__
typedef unsigned short bf16_t;
using bf16x8 = __attribute__((ext_vector_type(8))) short;
using f32x16 = __attribute__((ext_vector_type(16))) float;
using f32x4  = __attribute__((ext_vector_type(4))) float;
using u32x4  = __attribute__((ext_vector_type(4))) unsigned;
using u32x2  = __attribute__((ext_vector_type(2))) unsigned;

#define MFMA32(a, b, c) __builtin_amdgcn_mfma_f32_32x32x16_bf16((a), (b), (c), 0, 0, 0)

constexpr int NTOK = 32768;
constexpr int DM = 1024;
constexpr float DN_ALPHA = 1.189207115002721f;
constexpr float LN_EPS = 1e-5f;
constexpr float LOG2E = 1.4426950408889634f;
constexpr float QNA_SCALE = 0.125f * LOG2E;
constexpr float QM_SCALE = 0.10206207261596577f * LOG2E;

constexpr size_t MBy = 1ull << 20;
constexpr size_t OFF_WINT = 0;
constexpr size_t OFF_WUQT = 5 * MBy;
constexpr size_t OFF_WUKVT = 6 * MBy;
constexpr size_t OFF_WOT = 7 * MBy;
constexpr size_t OFF_WQT = 9 * MBy;
constexpr size_t OFF_SUBK = 13 * MBy;
constexpr size_t OFF_ROPE = 14 * MBy;
constexpr size_t OFF_PLEWT = 15 * MBy;
constexpr size_t OFF_GATEWT = 16 * MBy;
constexpr size_t OFF_RQ = 18 * MBy;
constexpr size_t OFF_RKV = 18 * MBy + 256 * 1024;
constexpr size_t OFF_BAR = 19 * MBy;
constexpr size_t OFF_UBF = 20 * MBy;
constexpr size_t OFF_VBF = 52 * MBy;
constexpr size_t OFF_PB = 84 * MBy;
constexpr size_t OFF_H = 100 * MBy;
constexpr size_t OFF_QNA = 164 * MBy;
constexpr size_t OFF_KNA = 196 * MBy;
constexpr size_t OFF_VNAT = 228 * MBy;
constexpr size_t OFF_CQ = 260 * MBy;
constexpr size_t OFF_CKV = 284 * MBy;
constexpr size_t OFF_KR = 300 * MBy;
constexpr size_t OFF_QM = 304 * MBy;
constexpr size_t OFF_KM = 352 * MBy;
constexpr size_t OFF_VMT = 400 * MBy;
constexpr size_t OFF_MIX = 432 * MBy;
constexpr size_t OFF_QP = 164 * MBy;
constexpr size_t OFF_G = 292 * MBy;
constexpr size_t OFF_IDX = 356 * MBy;
constexpr size_t OFF_GW = 372 * MBy;

constexpr int SMEM_BYTES = 73728;

struct Params {
  const float *x, *p, *emb_g, *emb_b, *w_in, *qg, *kvg, *w_uq, *w_ukv, *rpb, *w_o, *ln1g, *ln1b, *w_q, *subk, *pu, *pv,
      *ple_w, *gate_w, *gate_b, *ln2g, *ln2b;
  float* out;
  char* ws;
};

DI unsigned short f2bf(float x) {
  unsigned u = __float_as_uint(x);
  u += 0x7fffu + ((u >> 16) & 1u);
  return (unsigned short)(u >> 16);
}
DI float bf2f(unsigned short b) { return __uint_as_float(((unsigned)b) << 16); }
DI unsigned pack2(float lo, float hi) { return (unsigned)f2bf(lo) | ((unsigned)f2bf(hi) << 16); }
DI float bflo(unsigned u) { return __uint_as_float(u << 16); }
DI float bfhi(unsigned u) { return __uint_as_float(u & 0xffff0000u); }
DI float wave_sum(float v) {
#pragma unroll
  for (int m = 32; m >= 1; m >>= 1) v += __shfl_xor(v, m);
  return v;
}
DI float fast_exp2(float x) { return __builtin_amdgcn_exp2f(x); }
DI int pi_swap23(int r) { return (r & ~12) | ((r & 4) << 1) | ((r & 8) >> 1); }

DI void transpose_cvt(const float* __restrict__ in, bf16_t* __restrict__ out, int K, int N, const float* __restrict__ g,
                      char* smem) {
  float* tile = (float*)smem;
  const int tk = K >> 5, tn = N >> 5;
  const int tx = threadIdx.x & 31, ty = threadIdx.x >> 5;
  for (int t = blockIdx.x; t < tk * tn; t += gridDim.x) {
    const int k0 = (t / tn) << 5, n0 = (t % tn) << 5;
    __syncthreads();
#pragma unroll
    for (int i = 0; i < 4; ++i) {
      const int k = k0 + ty + 8 * i;
      float v = in[(size_t)k * N + n0 + tx];
      if (g) v *= g[k];
      tile[(ty + 8 * i) * 33 + tx] = v;
    }
    __syncthreads();
#pragma unroll
    for (int i = 0; i < 4; ++i) {
      const int n = n0 + ty + 8 * i;
      out[(size_t)n * K + k0 + tx] = f2bf(tile[tx * 33 + ty + 8 * i]);
    }
  }
}

DI void straight_cvt(const float* __restrict__ in, bf16_t* __restrict__ out, size_t n) {
  const size_t n4 = n >> 2;
  for (size_t i = (size_t)blockIdx.x * 256 + threadIdx.x; i < n4; i += (size_t)gridDim.x * 256) {
    const f32x4 v = *(const f32x4*)(in + i * 4);
    u32x2 o;
    o[0] = pack2(v[0], v[1]);
    o[1] = pack2(v[2], v[3]);
    *(u32x2*)(out + i * 4) = o;
  }
}

DI void ln_rows16(float (&v)[16], const float* __restrict__ gam, const float* __restrict__ bet, int lane) {
  float s = 0.f;
#pragma unroll
  for (int i = 0; i < 16; ++i) s += v[i];
  const float mu = wave_sum(s) * (1.f / 1024.f);
  float q = 0.f;
#pragma unroll
  for (int i = 0; i < 16; ++i) {
    v[i] -= mu;
    q += v[i] * v[i];
  }
  const float rstd = rsqrtf(wave_sum(q) * (1.f / 1024.f) + LN_EPS);
#pragma unroll
  for (int g = 0; g < 4; ++g) {
    const f32x4 gg = *(const f32x4*)(gam + g * 256 + lane * 4);
    const f32x4 bb = *(const f32x4*)(bet + g * 256 + lane * 4);
#pragma unroll
    for (int c = 0; c < 4; ++c) v[g * 4 + c] = v[g * 4 + c] * rstd * gg[c] + bb[c];
  }
}

DI void phase0(const Params& P, char* smem) {
  char* ws = P.ws;
  transpose_cvt(P.w_in, (bf16_t*)(ws + OFF_WINT), 1024, 2208, nullptr, smem);
  transpose_cvt(P.w_uq, (bf16_t*)(ws + OFF_WUQT), 384, 768, P.qg, smem);
  transpose_cvt(P.w_ukv, (bf16_t*)(ws + OFF_WUKVT), 256, 1024, P.kvg, smem);
  transpose_cvt(P.w_o, (bf16_t*)(ws + OFF_WOT), 1024, 1024, nullptr, smem);
  transpose_cvt(P.w_q, (bf16_t*)(ws + OFF_WQT), 1024, 2048, nullptr, smem);
  transpose_cvt(P.ple_w, (bf16_t*)(ws + OFF_PLEWT), 256, 1024, nullptr, smem);
  transpose_cvt(P.gate_w, (bf16_t*)(ws + OFF_GATEWT), 1024, 1024, nullptr, smem);
  straight_cvt(P.subk, (bf16_t*)(ws + OFF_SUBK), 2 * 128 * 128);
  straight_cvt(P.pu, (bf16_t*)(ws + OFF_UBF), (size_t)16384 * 1024);
  straight_cvt(P.pv, (bf16_t*)(ws + OFF_VBF), (size_t)16384 * 1024);
  straight_cvt(P.p, (bf16_t*)(ws + OFF_PB), (size_t)NTOK * 256);
  float* rope = (float*)(ws + OFF_ROPE);
  for (int i = blockIdx.x * 256 + threadIdx.x; i < 2048 * 16; i += gridDim.x * 256) {
    const int s = i >> 4, j = i & 15;
    const float inv = powf(10000.f, -(float)(2 * (j & 7)) / 16.f);
    const float pos = (j < 8) ? (float)(s >> 6) : (float)(s & 63);
    const float ang = pos * inv;
    rope[s * 32 + j] = cosf(ang);
    rope[s * 32 + 16 + j] = sinf(ang);
  }
  const int lane = threadIdx.x & 63, w = threadIdx.x >> 6;
  bf16_t* h0 = (bf16_t*)(ws + OFF_H);
  for (int tok = blockIdx.x * 4 + w; tok < NTOK; tok += gridDim.x * 4) {
    float v[16];
#pragma unroll
    for (int g = 0; g < 4; ++g) {
      const f32x4 t = *(const f32x4*)(P.x + (size_t)tok * 1024 + g * 256 + lane * 4);
#pragma unroll
      for (int c = 0; c < 4; ++c) v[g * 4 + c] = t[c];
    }
    ln_rows16(v, P.emb_g, P.emb_b, lane);
#pragma unroll
    for (int g = 0; g < 4; ++g) {
      u32x2 o;
      o[0] = pack2(v[g * 4 + 0], v[g * 4 + 1]);
      o[1] = pack2(v[g * 4 + 2], v[g * 4 + 3]);
      *(u32x2*)(h0 + (size_t)tok * 1024 + g * 256 + lane * 4) = o;
    }
  }
}

DI void gemm_tile_main(const bf16_t* __restrict__ ag  , int lda, const bf16_t* __restrict__ Bt,
                       const size_t (&boff)[4], int nk, char* smem, f32x16 (&acc)[2][2]) {
  const int tid = threadIdx.x, lane = tid & 63, w = tid >> 6;
  const int r = lane & 31, hh = lane >> 5;
  const int wm = w >> 1, wn = w & 1;
  bf16_t* As = (bf16_t*)smem;
  bf16_t* Bs = As + 2 * 128 * 72;
  const int lrow = tid >> 3, lkc = (tid & 7) * 8;
#pragma unroll
  for (int i = 0; i < 2; ++i)
#pragma unroll
    for (int j = 0; j < 2; ++j)
#pragma unroll
      for (int e = 0; e < 16; ++e) acc[i][j][e] = 0.f;
  u32x4 pa[4], pb[4];
#pragma unroll
  for (int i = 0; i < 4; ++i) {
    pa[i] = *(const u32x4*)(ag + (size_t)(32 * i) * lda);
    pb[i] = *(const u32x4*)(Bt + boff[i]);
  }
#pragma unroll
  for (int i = 0; i < 4; ++i) {
    *(u32x4*)(As + (lrow + 32 * i) * 72 + lkc) = pa[i];
    *(u32x4*)(Bs + (lrow + 32 * i) * 72 + lkc) = pb[i];
  }
  __syncthreads();
  for (int kt = 0; kt < nk; ++kt) {
    const int cur = kt & 1;
    if (kt + 1 < nk) {
      const int k0 = (kt + 1) << 6;
#pragma unroll
      for (int i = 0; i < 4; ++i) {
        pa[i] = *(const u32x4*)(ag + (size_t)(32 * i) * lda + k0);
        pb[i] = *(const u32x4*)(Bt + boff[i] + k0);
      }
    }
    const bf16_t* as = As + cur * (128 * 72) + (wm * 64 + r) * 72 + hh * 8;
    const bf16_t* bs = Bs + cur * (128 * 72) + (wn * 64 + r) * 72 + hh * 8;
#pragma unroll
    for (int ks = 0; ks < 4; ++ks) {
      const bf16x8 a0 = *(const bf16x8*)(as + ks * 16);
      const bf16x8 a1 = *(const bf16x8*)(as + 32 * 72 + ks * 16);
      const bf16x8 b0 = *(const bf16x8*)(bs + ks * 16);
      const bf16x8 b1 = *(const bf16x8*)(bs + 32 * 72 + ks * 16);
      acc[0][0] = MFMA32(a0, b0, acc[0][0]);
      acc[0][1] = MFMA32(a0, b1, acc[0][1]);
      acc[1][0] = MFMA32(a1, b0, acc[1][0]);
      acc[1][1] = MFMA32(a1, b1, acc[1][1]);
    }
    if (kt + 1 < nk) {
      const int nx = cur ^ 1;
#pragma unroll
      for (int i = 0; i < 4; ++i) {
        *(u32x4*)(As + nx * (128 * 72) + (lrow + 32 * i) * 72 + lkc) = pa[i];
        *(u32x4*)(Bs + nx * (128 * 72) + (lrow + 32 * i) * 72 + lkc) = pb[i];
      }
    }
    __syncthreads();
  }
}

template <class Epi>
DI void gemm_phase(const bf16_t* __restrict__ A, int lda, const bf16_t* __restrict__ Bt, int ldb, int M, int N, int K,
                   char* smem, const Epi& epi) {
  const int tid = threadIdx.x, lane = tid & 63, w = tid >> 6;
  const int r = lane & 31, hh = lane >> 5;
  const int wm = w >> 1, wn = w & 1;
  const int nt = (N + 127) >> 7;
  const int ntiles = (M >> 7) * nt;
  const int nk = K >> 6;
  const int lrow = tid >> 3, lkc = (tid & 7) * 8;
  for (int tile = blockIdx.x; tile < ntiles; tile += gridDim.x) {
    const int tm = tile / nt, tn = tile - tm * nt;
    const int m0 = tm << 7, n0 = tn << 7;
    f32x16 acc[2][2];
    const bf16_t* ag = A + (size_t)(m0 + lrow) * lda + lkc;
    size_t boff[4];
#pragma unroll
    for (int i = 0; i < 4; ++i) {
      int n = n0 + lrow + 32 * i;
      n = n < N ? n : N - 1;
      boff[i] = (size_t)n * ldb + lkc;
    }
    gemm_tile_main(ag, lda, Bt, boff, nk, smem, acc);
#pragma unroll
    for (int mi = 0; mi < 2; ++mi)
#pragma unroll
      for (int ni = 0; ni < 2; ++ni) {
#pragma unroll
        for (int e = 0; e < 16; ++e) {
          const int row = m0 + wm * 64 + mi * 32 + (e & 3) + 8 * (e >> 2) + 4 * hh;
          const int col = n0 + wn * 64 + ni * 32 + r;
          epi(row, col, acc[mi][ni][e]);
        }
        asm volatile("" ::: "memory");
      }
  }
}

struct EpiInProj {
  bf16_t *qna, *kna, *vnat, *cq, *ckv;
  float* kr;
  DI void operator()(int row, int col, float v) const {
    if (col >= 2208) return;
    const int b = row >> 11, s = row & 2047;
    if (col < 1536) {
      const int sec = col >> 9, c = col & 511, h = c >> 6, d = c & 63;
      const size_t bh = (size_t)(b * 8 + h);
      if (sec == 0) qna[(bh * 2048 + s) * 64 + d] = f2bf(v * QNA_SCALE);
      else if (sec == 1) kna[(bh * 2048 + s) * 64 + d] = f2bf(v);
      else vnat[(bh * 64 + d) * 2048 + s] = f2bf(v);
    } else if (col < 1920) {
      cq[(size_t)row * 384 + (col - 1536)] = f2bf(v);
    } else if (col < 2176) {
      ckv[(size_t)row * 256 + (col - 1920)] = f2bf(v);
    } else {
      kr[(size_t)row * 32 + (col - 2176)] = v;
    }
  }
};
struct EpiUpQ {
  const float* rq;
  const float* rope;
  bf16_t* qm;
  DI void operator()(int row, int col, float v) const {
    v *= rq[row];
    const float pv = __shfl_xor(v, 1);
    const int hd = col / 96, d = col - hd * 96;
    const int b = row >> 11, s = row & 2047;
    float o = v;
    if (d >= 64) {
      const int i = (d - 64) >> 1;
      const float c = rope[s * 32 + i], sn = rope[s * 32 + 16 + i];
      o = (d & 1) ? (pv * sn + v * c) : (v * c - pv * sn);
    }
    qm[((size_t)(b * 8 + hd) * 2048 + s) * 96 + d] = f2bf(o * QM_SCALE);
  }
};
struct EpiUpKV {
  const float* rkv;
  bf16_t *km, *vmt;
  DI void operator()(int row, int col, float v) const {
    v *= rkv[row];
    const int hd = col >> 7, d = col & 127;
    const int b = row >> 11, s = row & 2047;
    const size_t bh = (size_t)(b * 8 + hd);
    if (d < 64) km[(bh * 2048 + s) * 96 + d] = f2bf(v);
    else vmt[(bh * 64 + (d - 64)) * 2048 + s] = f2bf(v);
  }
};
struct EpiWo {
  const bf16_t* h0;
  float* y1;
  DI void operator()(int row, int col, float v) const {
    const size_t i = (size_t)row * 1024 + col;
    y1[i] = DN_ALPHA * bf2f(h0[i]) + v;
  }
};
struct EpiPeerQ {
  bf16_t* qp;
  DI void operator()(int row, int col, float v) const { qp[(size_t)row * 2048 + col] = f2bf(v); }
};
struct EpiGate {
  const float* gb;
  bf16_t* G;
  DI void operator()(int row, int col, float v) const {
    G[(size_t)row * 1024 + col] = f2bf(1.f / (1.f + __expf(-(v + gb[col]))));
  }
};
struct EpiPle {
  const bf16_t *h1, *G;
  float* y2;
  DI void operator()(int row, int col, float v) const {
    const size_t i = (size_t)row * 1024 + col;
    y2[i] = DN_ALPHA * bf2f(h1[i]) + bf2f(G[i]) * v;
  }
};

DI void phase_stats(const Params& P) {
  char* ws = P.ws;
  const bf16_t* cq = (const bf16_t*)(ws + OFF_CQ);
  const bf16_t* ckv = (const bf16_t*)(ws + OFF_CKV);
  const float* kr = (const float*)(ws + OFF_KR);
  const float* rope = (const float*)(ws + OFF_ROPE);
  float* rq = (float*)(ws + OFF_RQ);
  float* rkv = (float*)(ws + OFF_RKV);
  bf16_t* km = (bf16_t*)(ws + OFF_KM);
  const int lane = threadIdx.x & 63, w = threadIdx.x >> 6;
  for (int tok = blockIdx.x * 4 + w; tok < NTOK; tok += gridDim.x * 4) {
    float s1 = 0.f, s2 = 0.f;
#pragma unroll
    for (int i = 0; i < 6; ++i) {
      const float v = bf2f(cq[(size_t)tok * 384 + i * 64 + lane]);
      s1 += v * v;
    }
#pragma unroll
    for (int i = 0; i < 4; ++i) {
      const float v = bf2f(ckv[(size_t)tok * 256 + i * 64 + lane]);
      s2 += v * v;
    }
    s1 = wave_sum(s1);
    s2 = wave_sum(s2);
    if (lane == 0) {
      rq[tok] = rsqrtf(s1 * (1.f / 384.f) + LN_EPS);
      rkv[tok] = rsqrtf(s2 * (1.f / 256.f) + LN_EPS);
    }
    if (lane < 16) {
      const int b = tok >> 11, s = tok & 2047;
      const float x1 = kr[(size_t)tok * 32 + 2 * lane], x2 = kr[(size_t)tok * 32 + 2 * lane + 1];
      const float c = rope[s * 32 + lane], sn = rope[s * 32 + 16 + lane];
      const unsigned o = pack2(x1 * c - x2 * sn, x1 * sn + x2 * c);
#pragma unroll
      for (int h = 0; h < 8; ++h) *(unsigned*)(km + ((size_t)(b * 8 + h) * 2048 + s) * 96 + 64 + 2 * lane) = o;
    }
  }
}

DI bf16x8 pack8(const f32x16& x, int base) {
  u32x4 p;
  p[0] = pack2(x[base + 0], x[base + 1]);
  p[1] = pack2(x[base + 2], x[base + 3]);
  p[2] = pack2(x[base + 4], x[base + 5]);
  p[3] = pack2(x[base + 6], x[base + 7]);
  return __builtin_bit_cast(bf16x8, p);
}

DI void softmax_step(f32x16 (&sacc)[2], float& m, float& l, f32x16 (&oacc)[2], bf16x8 (&pf)[4]) {
  float mx = sacc[0][0];
#pragma unroll
  for (int e = 1; e < 16; ++e) mx = fmaxf(mx, sacc[0][e]);
#pragma unroll
  for (int e = 0; e < 16; ++e) mx = fmaxf(mx, sacc[1][e]);
  mx = fmaxf(mx, __shfl_xor(mx, 32));
  const float mnew = fmaxf(m, mx);
  const float alpha = fast_exp2(m - mnew);
  m = mnew;
  float ps = 0.f;
#pragma unroll
  for (int t = 0; t < 2; ++t)
#pragma unroll
    for (int e = 0; e < 16; ++e) {
      const float p = fast_exp2(sacc[t][e] - mnew);
      sacc[t][e] = p;
      ps += p;
    }
  l = l * alpha + ps;
#pragma unroll
  for (int t = 0; t < 2; ++t)
#pragma unroll
    for (int e = 0; e < 16; ++e) oacc[t][e] *= alpha;
  pf[0] = pack8(sacc[0], 0);
  pf[1] = pack8(sacc[0], 8);
  pf[2] = pack8(sacc[1], 0);
  pf[3] = pack8(sacc[1], 8);
}

DI void store_o(const f32x16 (&oacc)[2], float l, bf16_t* dst  , int hh) {
  const float lt = l + __shfl_xor(l, 32);
  const float inv = 1.f / lt;
#pragma unroll
  for (int dt = 0; dt < 2; ++dt)
#pragma unroll
    for (int g = 0; g < 4; ++g) {
      u32x2 o;
      o[0] = pack2(oacc[dt][4 * g + 0] * inv, oacc[dt][4 * g + 1] * inv);
      o[1] = pack2(oacc[dt][4 * g + 2] * inv, oacc[dt][4 * g + 3] * inv);
      *(u32x2*)(dst + 32 * dt + 8 * g + 4 * hh) = o;
    }
}

DI void phase_attn(const Params& P, char* smem) {
  char* ws = P.ws;
  const bf16_t* QNA = (const bf16_t*)(ws + OFF_QNA);
  const bf16_t* KNA = (const bf16_t*)(ws + OFF_KNA);
  const bf16_t* VNAT = (const bf16_t*)(ws + OFF_VNAT);
  const bf16_t* QM = (const bf16_t*)(ws + OFF_QM);
  const bf16_t* KM = (const bf16_t*)(ws + OFF_KM);
  const bf16_t* VMT = (const bf16_t*)(ws + OFF_VMT);
  bf16_t* mix = (bf16_t*)(ws + OFF_MIX);
  const int tid = threadIdx.x, lane = tid & 63, w = tid >> 6;
  const int r = lane & 31, hh = lane >> 5;
  const int pr = pi_swap23(r);
  float* bl = (float*)(smem + 45056);
  __syncthreads();
  for (int i = tid; i < 8 * 465; i += 256) bl[i] = P.rpb[i] * LOG2E;
  __syncthreads();
  for (int item = blockIdx.x * 4 + w; item < 8192; item += gridDim.x * 4) {
    const int half = item & 1, h = (item >> 1) & 7, rr = (item >> 4) & 31, b = item >> 9;
    const size_t bh = (size_t)(b * 8 + h);
    int rs = rr - 4; rs = rs < 0 ? 0 : (rs > 24 ? 24 : rs);
    const int qc = 32 * half + r;
    int cs = qc - 8; cs = cs < 0 ? 0 : (cs > 48 ? 48 : cs);
    bf16x8 qf[4];
#pragma unroll
    for (int s = 0; s < 4; ++s) qf[s] = *(const bf16x8*)(QNA + (bh * 2048 + rr * 64 + qc) * 64 + 16 * s + 8 * hh);
    f32x16 oacc[2];
#pragma unroll
    for (int t = 0; t < 2; ++t)
#pragma unroll
      for (int e = 0; e < 16; ++e) oacc[t][e] = 0.f;
    float m = -1e30f, l = 0.f;
    for (int i = 0; i < 8; ++i) {
      const int key0 = (rs + i) * 64;
      f32x16 sacc[2];
#pragma unroll
      for (int t = 0; t < 2; ++t)
#pragma unroll
        for (int e = 0; e < 16; ++e) sacc[t][e] = 0.f;
#pragma unroll
      for (int kt = 0; kt < 2; ++kt)
#pragma unroll
        for (int s = 0; s < 4; ++s) {
          const bf16x8 kf = *(const bf16x8*)(KNA + (bh * 2048 + key0 + 32 * kt + pr) * 64 + 16 * s + 8 * hh);
          sacc[kt] = MFMA32(kf, qf[s], sacc[kt]);
        }
      const float* brow = bl + h * 465 + (rs + i - rr + 7) * 31;
#pragma unroll
      for (int kt = 0; kt < 2; ++kt)
#pragma unroll
        for (int e = 0; e < 16; ++e) {
          const int kc = 32 * kt + (e & 7) + 8 * hh + 16 * (e >> 3);
          const bool valid = (unsigned)(kc - cs) < 16u;
          int dj = kc - qc + 15;
          dj = dj < 0 ? 0 : (dj > 30 ? 30 : dj);
          const float bias = brow[dj];
          sacc[kt][e] = valid ? sacc[kt][e] + bias : -INFINITY;
        }
      bf16x8 pf[4];
      softmax_step(sacc, m, l, oacc, pf);
#pragma unroll
      for (int dt = 0; dt < 2; ++dt)
#pragma unroll
        for (int s = 0; s < 4; ++s) {
          const bf16x8 vf = *(const bf16x8*)(VNAT + (bh * 64 + 32 * dt + r) * 2048 + key0 + 16 * s + 8 * hh);
          oacc[dt] = MFMA32(vf, pf[s], oacc[dt]);
        }
    }
    store_o(oacc, l, mix + ((size_t)b * 2048 + rr * 64 + qc) * 1024 + h * 64, hh);
  }
  bf16_t* Ks = (bf16_t*)smem;
  bf16_t* Vs = (bf16_t*)(smem + 2 * 13312);
  for (int item = blockIdx.x; item < 2048; item += gridDim.x) {
    const int bh = item >> 4, qt = item & 15;
    const int b = bh >> 3, h = bh & 7;
    const int q0 = qt * 128 + w * 32;
    bf16x8 qf[6];
#pragma unroll
    for (int s = 0; s < 6; ++s) qf[s] = *(const bf16x8*)(QM + ((size_t)bh * 2048 + q0 + r) * 96 + 16 * s + 8 * hh);
    f32x16 oacc[2];
#pragma unroll
    for (int t = 0; t < 2; ++t)
#pragma unroll
      for (int e = 0; e < 16; ++e) oacc[t][e] = 0.f;
    float m = -1e30f, l = 0.f;
    const bf16_t* kg = KM + (size_t)bh * 2048 * 96;
    const bf16_t* vg = VMT + (size_t)bh * 64 * 2048;
    u32x4 pk[3], pv[2];
    int klds[3], vlds[2];
    size_t vgo[2];
#pragma unroll
    for (int i = 0; i < 3; ++i) {
      const int c = tid + 256 * i;
      klds[i] = (c / 12) * 104 + (c % 12) * 8;
    }
#pragma unroll
    for (int i = 0; i < 2; ++i) {
      const int c = tid + 256 * i;
      vlds[i] = (c >> 3) * 72 + (c & 7) * 8;
      vgo[i] = (size_t)(c >> 3) * 2048 + (c & 7) * 8;
    }
    __syncthreads();
#pragma unroll
    for (int i = 0; i < 3; ++i) pk[i] = *(const u32x4*)(kg + (size_t)(tid + 256 * i) * 8);
#pragma unroll
    for (int i = 0; i < 2; ++i) pv[i] = *(const u32x4*)(vg + vgo[i]);
#pragma unroll
    for (int i = 0; i < 3; ++i) *(u32x4*)(Ks + klds[i]) = pk[i];
#pragma unroll
    for (int i = 0; i < 2; ++i) *(u32x4*)(Vs + vlds[i]) = pv[i];
    __syncthreads();
    for (int j = 0; j < 32; ++j) {
      const int cur = j & 1;
      if (j + 1 < 32) {
        const bf16_t* kgn = kg + (size_t)(j + 1) * 64 * 96;
#pragma unroll
        for (int i = 0; i < 3; ++i) pk[i] = *(const u32x4*)(kgn + (size_t)(tid + 256 * i) * 8);
#pragma unroll
        for (int i = 0; i < 2; ++i) pv[i] = *(const u32x4*)(vg + vgo[i] + (j + 1) * 64);
      }
      const bf16_t* ks = Ks + cur * (64 * 104);
      const bf16_t* vs = Vs + cur * (64 * 72);
      f32x16 sacc[2];
#pragma unroll
      for (int t = 0; t < 2; ++t)
#pragma unroll
        for (int e = 0; e < 16; ++e) sacc[t][e] = 0.f;
#pragma unroll
      for (int kt = 0; kt < 2; ++kt)
#pragma unroll
        for (int s = 0; s < 6; ++s) {
          const bf16x8 kf = *(const bf16x8*)(ks + (32 * kt + pr) * 104 + 16 * s + 8 * hh);
          sacc[kt] = MFMA32(kf, qf[s], sacc[kt]);
        }
      bf16x8 pf[4];
      softmax_step(sacc, m, l, oacc, pf);
#pragma unroll
      for (int dt = 0; dt < 2; ++dt)
#pragma unroll
        for (int s = 0; s < 4; ++s) {
          const bf16x8 vf = *(const bf16x8*)(vs + (32 * dt + r) * 72 + 16 * s + 8 * hh);
          oacc[dt] = MFMA32(vf, pf[s], oacc[dt]);
        }
      if (j + 1 < 32) {
        const int nx = cur ^ 1;
#pragma unroll
        for (int i = 0; i < 3; ++i) *(u32x4*)(Ks + nx * (64 * 104) + klds[i]) = pk[i];
#pragma unroll
        for (int i = 0; i < 2; ++i) *(u32x4*)(Vs + nx * (64 * 72) + vlds[i]) = pv[i];
      }
      __syncthreads();
    }
    store_o(oacc, l, mix + ((size_t)b * 2048 + q0 + r) * 1024 + 512 + h * 64, hh);
  }
}

DI void phase_ln1(const Params& P) {
  const int lane = threadIdx.x & 63, w = threadIdx.x >> 6;
  bf16_t* h1 = (bf16_t*)(P.ws + OFF_H);
  for (int tok = blockIdx.x * 4 + w; tok < NTOK; tok += gridDim.x * 4) {
    float v[16];
#pragma unroll
    for (int g = 0; g < 4; ++g) {
      const f32x4 t = *(const f32x4*)(P.out + (size_t)tok * 1024 + g * 256 + lane * 4);
#pragma unroll
      for (int c = 0; c < 4; ++c) v[g * 4 + c] = t[c];
    }
    ln_rows16(v, P.ln1g, P.ln1b, lane);
#pragma unroll
    for (int g = 0; g < 4; ++g) {
      u32x2 o;
      o[0] = pack2(v[g * 4 + 0], v[g * 4 + 1]);
      o[1] = pack2(v[g * 4 + 2], v[g * 4 + 3]);
      *(u32x2*)(h1 + (size_t)tok * 1024 + g * 256 + lane * 4) = o;
    }
  }
}

#define CE_DESC(a, b) { const float _hi = fmaxf(a, b), _lo = fminf(a, b); a = _hi; b = _lo; }
DI void sort16_desc(float (&v)[16]) {
#pragma unroll
  for (int kk = 1; kk <= 4; ++kk)
#pragma unroll
    for (int jj = kk - 1; jj >= 0; --jj)
#pragma unroll
      for (int i = 0; i < 16; ++i) {
        const int k = 1 << kk, j = 1 << jj, l = i ^ j;
        if (l > i) {
          if ((i & k) == 0) CE_DESC(v[i], v[l]) else CE_DESC(v[l], v[i])
        }
      }
}
DI void merge16_desc(float (&a)[16], const float (&b)[16]) {
#pragma unroll
  for (int i = 0; i < 16; ++i) a[i] = fmaxf(a[i], b[15 - i]);
#pragma unroll
  for (int jj = 3; jj >= 0; --jj)
#pragma unroll
    for (int i = 0; i < 16; ++i) {
      const int j = 1 << jj, l = i ^ j;
      if (l > i) CE_DESC(a[i], a[l])
    }
}
DI float pack_code(float v, unsigned mask, unsigned code) { return __uint_as_float((__float_as_uint(v) & mask) | code); }

DI void phase_route(const Params& P, char* smem) {
  char* ws = P.ws;
  const bf16_t* h1 = (const bf16_t*)(ws + OFF_H);
  const bf16_t* WqT = (const bf16_t*)(ws + OFF_WQT);
  const bf16_t* subk = (const bf16_t*)(ws + OFF_SUBK);
  int* idx_out = (int*)(ws + OFF_IDX);
  float* g_out = (float*)(ws + OFF_GW);
  const int tid = threadIdx.x, lane = tid & 63, w = tid >> 6;
  const int r = lane & 31, hh = lane >> 5;
  const int wm = w >> 1, wn = w & 1;
  const int lrow = tid >> 3, lkc = (tid & 7) * 8;
  bf16_t* qb = (bf16_t*)smem;
  bf16_t* sk = (bf16_t*)(smem + 34816);
  float* lst = (float*)smem;
  for (int item = blockIdx.x; item < 2048; item += gridDim.x) {
    const int tm = item >> 3, h = item & 7;
    const int m0 = tm << 7;
    float L[2][16];
#pragma unroll
    for (int c = 0; c < 2; ++c) {
      f32x16 acc[2][2];
      const bf16_t* ag = h1 + (size_t)(m0 + lrow) * 1024 + lkc;
      size_t boff[4];
#pragma unroll
      for (int i = 0; i < 4; ++i) boff[i] = (size_t)(h * 256 + c * 128 + lrow + 32 * i) * 1024 + lkc;
      gemm_tile_main(ag, 1024, WqT, boff, 16, smem, acc);
      {
        bf16_t* qw = qb + (wm * 64 + 4 * hh) * 136 + wn * 64 + r;
#pragma unroll
        for (int mi = 0; mi < 2; ++mi)
#pragma unroll
          for (int ni = 0; ni < 2; ++ni)
#pragma unroll
            for (int e = 0; e < 16; ++e)
              qw[(mi * 32 + (e & 3) + 8 * (e >> 2)) * 136 + ni * 32] = f2bf(acc[mi][ni][e]);
      }
      {
        const bf16_t* sg = subk + (size_t)c * 16384 + tid * 8;
        bf16_t* sl = sk + (tid >> 4) * 136 + (tid & 15) * 8;
#pragma unroll
        for (int i = 0; i < 8; ++i) *(u32x4*)(sl + i * (16 * 136)) = *(const u32x4*)(sg + i * 2048);
      }
      __syncthreads();
      f32x16 sacc[4];
#pragma unroll
      for (int t = 0; t < 4; ++t)
#pragma unroll
        for (int e = 0; e < 16; ++e) sacc[t][e] = 0.f;
#pragma unroll 2
      for (int s = 0; s < 8; ++s) {
        const bf16x8 bq = *(const bf16x8*)(qb + (32 * w + r) * 136 + 16 * s + 8 * hh);
#pragma unroll
        for (int kt = 0; kt < 4; ++kt) {
          const bf16x8 ak = *(const bf16x8*)(sk + (32 * kt + r) * 136 + 16 * s + 8 * hh);
          sacc[kt] = MFMA32(ak, bq, sacc[kt]);
        }
      }
      __syncthreads();
      float T[4][16];
#pragma unroll
      for (int kt = 0; kt < 4; ++kt) {
#pragma unroll
        for (int e = 0; e < 16; ++e)
          T[kt][e] = pack_code(sacc[kt][e], 0xFFFFFF80u, (unsigned)(32 * kt + (e & 3) + 8 * (e >> 2)));
        sort16_desc(T[kt]);
      }
      merge16_desc(T[0], T[1]);
      merge16_desc(T[2], T[3]);
      merge16_desc(T[0], T[2]);
      {
        const unsigned hb = (unsigned)hh << 2;
#pragma unroll
        for (int i = 0; i < 16; ++i) T[0][i] = __uint_as_float(__float_as_uint(T[0][i]) | hb);
      }
      float Pn[16];
#pragma unroll
      for (int i = 0; i < 16; ++i) Pn[i] = __shfl_xor(T[0][i], 32);
      merge16_desc(T[0], Pn);
#pragma unroll
      for (int i = 0; i < 16; ++i) L[c][i] = T[0][i];
    }
    float A0[16], B1[16], C2[16], D3[16];
#pragma unroll
    for (int j = 0; j < 16; ++j) A0[j] = pack_code(L[0][0] + L[1][j], 0xFFFFFF00u, (unsigned)j);
#pragma unroll
    for (int j = 0; j < 16; ++j) B1[j] = (j < 8) ? pack_code(L[0][1] + L[1][j], 0xFFFFFF00u, (unsigned)(16 + j)) : -INFINITY;
    {
      int n = 0;
#pragma unroll
      for (int i = 2; i <= 4; ++i)
#pragma unroll
        for (int j = 0; j < 16 / (i + 1); ++j) { C2[n] = pack_code(L[0][i] + L[1][j], 0xFFFFFF00u, (unsigned)(16 * i + j)); ++n; }
#pragma unroll
      for (int q = 12; q < 16; ++q) C2[q] = -INFINITY;
      n = 0;
#pragma unroll
      for (int i = 5; i <= 15; ++i)
#pragma unroll
        for (int j = 0; j < 16 / (i + 1); ++j) { D3[n] = pack_code(L[0][i] + L[1][j], 0xFFFFFF00u, (unsigned)(16 * i + j)); ++n; }
      D3[14] = -INFINITY; D3[15] = -INFINITY;
    }
    sort16_desc(C2);
    sort16_desc(D3);
    merge16_desc(A0, B1);
    merge16_desc(C2, D3);
    merge16_desc(A0, C2);
#pragma unroll
    for (int i = 0; i < 16; ++i) {
      lst[i * 256 + tid] = L[0][i];
      lst[(16 + i) * 256 + tid] = L[1][i];
    }
    float cv[16];
    int eid[16];
#pragma unroll
    for (int k = 0; k < 16; ++k) {
      const unsigned code = __float_as_uint(A0[k]) & 255u;
      const float v1 = lst[(code >> 4) * 256 + tid];
      const float v2 = lst[(16 + (code & 15u)) * 256 + tid];
      cv[k] = v1 + v2;
      eid[k] = (int)((__float_as_uint(v1) & 127u) * 128u + (__float_as_uint(v2) & 127u));
    }
    float mx = cv[0];
#pragma unroll
    for (int k = 1; k < 16; ++k) mx = fmaxf(mx, cv[k]);
    float sum = 0.f;
#pragma unroll
    for (int k = 0; k < 16; ++k) { cv[k] = __expf(cv[k] - mx); sum += cv[k]; }
    const float inv = 1.f / sum;
    const size_t o = (size_t)(m0 + 32 * w + r) * 128 + h * 16;
    if (hh == 0) {
#pragma unroll
      for (int q = 0; q < 4; ++q) {
        u32x4 t;
#pragma unroll
        for (int c = 0; c < 4; ++c) t[c] = (unsigned)eid[4 * q + c];
        *(u32x4*)(idx_out + o + 4 * q) = t;
      }
    } else {
#pragma unroll
      for (int q = 0; q < 4; ++q) {
        f32x4 t;
#pragma unroll
        for (int c = 0; c < 4; ++c) t[c] = cv[4 * q + c] * inv;
        *(f32x4*)(g_out + o + 4 * q) = t;
      }
    }
    __syncthreads();
  }
}

DI void phase_gather(const Params& P) {
  char* ws = P.ws;
  const bf16_t* h1 = (const bf16_t*)(ws + OFF_H);
  const bf16_t* U = (const bf16_t*)(ws + OFF_UBF);
  const bf16_t* V = (const bf16_t*)(ws + OFF_VBF);
  const int* idxb = (const int*)(ws + OFF_IDX);
  const float* gwb = (const float*)(ws + OFF_GW);
  const int lane = threadIdx.x & 63, w = threadIdx.x >> 6;
  for (int tok = blockIdx.x * 4 + w; tok < NTOK; tok += gridDim.x * 4) {
    float xv[16];
    {
      const u32x4 a = *(const u32x4*)(h1 + (size_t)tok * 1024 + 8 * lane);
      const u32x4 b = *(const u32x4*)(h1 + (size_t)tok * 1024 + 512 + 8 * lane);
#pragma unroll
      for (int j = 0; j < 4; ++j) {
        xv[2 * j] = bflo(a[j]); xv[2 * j + 1] = bfhi(a[j]);
        xv[8 + 2 * j] = bflo(b[j]); xv[8 + 2 * j + 1] = bfhi(b[j]);
      }
    }
    const int id0 = idxb[(size_t)tok * 128 + lane], id1 = idxb[(size_t)tok * 128 + 64 + lane];
    const float g0 = gwb[(size_t)tok * 128 + lane], g1 = gwb[(size_t)tok * 128 + 64 + lane];
    float act0 = 0.f, act1 = 0.f;
    for (int e = 0; e < 128; ++e) {
      const int id = __shfl(e < 64 ? id0 : id1, e & 63);
      const u32x4 a = *(const u32x4*)(U + (size_t)id * 1024 + 8 * lane);
      const u32x4 b = *(const u32x4*)(U + (size_t)id * 1024 + 512 + 8 * lane);
      float d = 0.f;
#pragma unroll
      for (int j = 0; j < 4; ++j) {
        d += xv[2 * j] * bflo(a[j]) + xv[2 * j + 1] * bfhi(a[j]);
        d += xv[8 + 2 * j] * bflo(b[j]) + xv[8 + 2 * j + 1] * bfhi(b[j]);
      }
      d = wave_sum(d);
      if (e < 64) { if (lane == e) act0 = d; }
      else { if (lane == e - 64) act1 = d; }
    }
    act0 = g0 * 0.5f * act0 * (1.f + erff(act0 * 0.70710678118654752f));
    act1 = g1 * 0.5f * act1 * (1.f + erff(act1 * 0.70710678118654752f));
    float acc[16];
#pragma unroll
    for (int i = 0; i < 16; ++i) acc[i] = 0.f;
    for (int e = 0; e < 128; ++e) {
      const int id = __shfl(e < 64 ? id0 : id1, e & 63);
      const float a_e = __shfl(e < 64 ? act0 : act1, e & 63);
      const u32x4 a = *(const u32x4*)(V + (size_t)id * 1024 + 8 * lane);
      const u32x4 b = *(const u32x4*)(V + (size_t)id * 1024 + 512 + 8 * lane);
#pragma unroll
      for (int j = 0; j < 4; ++j) {
        acc[2 * j] += a_e * bflo(a[j]); acc[2 * j + 1] += a_e * bfhi(a[j]);
        acc[8 + 2 * j] += a_e * bflo(b[j]); acc[8 + 2 * j + 1] += a_e * bfhi(b[j]);
      }
    }
    float* orow = P.out + (size_t)tok * 1024;
    float y[16];
#pragma unroll
    for (int hlf = 0; hlf < 2; ++hlf)
#pragma unroll
      for (int q = 0; q < 2; ++q) {
        const f32x4 t = *(const f32x4*)(orow + hlf * 512 + 8 * lane + 4 * q);
#pragma unroll
        for (int c = 0; c < 4; ++c) y[hlf * 8 + q * 4 + c] = t[c] + acc[hlf * 8 + q * 4 + c];
      }
    float s = 0.f;
#pragma unroll
    for (int i = 0; i < 16; ++i) s += y[i];
    const float mu = wave_sum(s) * (1.f / 1024.f);
    float qq = 0.f;
#pragma unroll
    for (int i = 0; i < 16; ++i) { y[i] -= mu; qq += y[i] * y[i]; }
    const float rstd = rsqrtf(wave_sum(qq) * (1.f / 1024.f) + LN_EPS);
#pragma unroll
    for (int hlf = 0; hlf < 2; ++hlf)
#pragma unroll
      for (int q = 0; q < 2; ++q) {
        const int off = hlf * 512 + 8 * lane + 4 * q;
        const f32x4 gg = *(const f32x4*)(P.ln2g + off);
        const f32x4 bb = *(const f32x4*)(P.ln2b + off);
        f32x4 o;
#pragma unroll
        for (int c = 0; c < 4; ++c) o[c] = y[hlf * 8 + q * 4 + c] * rstd * gg[c] + bb[c];
        *(f32x4*)(orow + off) = o;
      }
  }
}


#define XB_TMO      128
#define XB_XCNT(j)  (256  + 64 * (j))
#define XB_XSUB(j)  (1280 + 64 * (j))
#define XB_XGEN(j)  (2304 + 64 * (j))
#define XB_TOP      3328
#define XB_TOPGEN   3392
#define XCD_BAR_WORDS 3456
#define XB_SPIN_CAP (1u << 22)
#define LAS __attribute__((address_space(3)))
DI unsigned xb_ld(unsigned* p) { return __hip_atomic_load(p, __ATOMIC_RELAXED, __HIP_MEMORY_SCOPE_AGENT); }
DI unsigned xb_add(unsigned* p, unsigned v) { return __hip_atomic_fetch_add(p, v, __ATOMIC_RELAXED, __HIP_MEMORY_SCOPE_AGENT); }
DI unsigned xb_xcc_id() { return (unsigned)__builtin_amdgcn_s_getreg((3 << 11) | 20) & 0xFu; }
#define XB_SPIN(cond, bar) do { unsigned _sp = 0; while (cond) { __builtin_amdgcn_s_sleep(1); \
    if ((++_sp & 255u) == 0u) { if (xb_ld(&(bar)[XB_TMO])) break; if (_sp > XB_SPIN_CAP) { atomicAdd(&(bar)[XB_TMO], 1u); break; } } } } while (0)
struct XcdBarrier { unsigned* bar; unsigned x; volatile LAS unsigned* st; };
DI XcdBarrier xcd_barrier_post(unsigned* bar, volatile LAS unsigned* st) {
  XcdBarrier b; b.bar = bar; b.x = xb_xcc_id(); b.st = st;
  if (threadIdx.x == 0) (void)xb_add(&bar[XB_XCNT(b.x)], 1u);
  return b;
}
DI void xcd_barrier_complete(unsigned* bar, unsigned x, unsigned& nloc, unsigned& nx) {
  const unsigned G = gridDim.x * gridDim.y * gridDim.z;
  unsigned sum, cnt, mine, sp = 0u;
  for (;;) {
    sum = 0u; cnt = 0u; mine = 0u;
#pragma unroll
    for (unsigned j = 0; j < 16; ++j) { const unsigned c = xb_ld(&bar[XB_XCNT(j)]); sum += c; cnt += (c > 0u) ? 1u : 0u; mine = (j == x) ? c : mine; }
    if (sum == G) break;
    __builtin_amdgcn_s_sleep(1);
    if ((++sp & 255u) == 0u) { if (xb_ld(&bar[XB_TMO])) break; if (sp > XB_SPIN_CAP) { atomicAdd(&bar[XB_TMO], 1u); break; } }
  }
  nloc = mine > 0u ? mine : 1u; nx = cnt > 0u ? cnt : 1u;
}
DI void xcd_barrier(const XcdBarrier& b) {
  asm volatile("s_waitcnt vmcnt(0)" ::: "memory");
  __syncthreads();
  if (threadIdx.x == 0) {
    unsigned* bar = b.bar;
    __builtin_amdgcn_s_waitcnt(0);
    unsigned nloc = b.st[0], nx = b.st[1];
    if (nloc == 0u) { xcd_barrier_complete(bar, b.x, nloc, nx); b.st[0] = nloc; b.st[1] = nx; }
    const unsigned old = xb_add(&bar[XB_XSUB(b.x)], 1u);
    const unsigned gen = old / nloc;
    if (old + 1u == (gen + 1u) * nloc) {
      __builtin_amdgcn_fence(__ATOMIC_RELEASE, "agent");
      asm volatile("s_waitcnt vmcnt(0)" ::: "memory");
      const unsigned og = xb_add(&bar[XB_TOP], 1u);
      const unsigned tg = og / nx;
      if (og + 1u == (tg + 1u) * nx) xb_add(&bar[XB_TOPGEN], 1u);
      else XB_SPIN(xb_ld(&bar[XB_TOPGEN]) == tg, bar);
      __builtin_amdgcn_fence(__ATOMIC_ACQUIRE, "agent");
      xb_add(&bar[XB_XGEN(b.x)], 1u);
      asm volatile("s_waitcnt vmcnt(0)" ::: "memory");
    } else {
      XB_SPIN(xb_ld(&bar[XB_XGEN(b.x)]) == gen, bar);
      __builtin_amdgcn_fence(__ATOMIC_ACQUIRE, "agent");
      asm volatile("s_waitcnt vmcnt(0)" ::: "memory");
    }
  }
  __syncthreads();
}

template <int PH>
DI void run_phase(const Params& P, char* smem) {
  char* ws = P.ws;
  if constexpr (PH == 0) {
    phase0(P, smem);
  } else if constexpr (PH == 1) {
    EpiInProj e{(bf16_t*)(ws + OFF_QNA), (bf16_t*)(ws + OFF_KNA), (bf16_t*)(ws + OFF_VNAT), (bf16_t*)(ws + OFF_CQ),
                (bf16_t*)(ws + OFF_CKV), (float*)(ws + OFF_KR)};
    gemm_phase((const bf16_t*)(ws + OFF_H), 1024, (const bf16_t*)(ws + OFF_WINT), 1024, NTOK, 2208, 1024, smem, e);
  } else if constexpr (PH == 2) {
    phase_stats(P);
  } else if constexpr (PH == 3) {
    EpiUpQ eq{(const float*)(ws + OFF_RQ), (const float*)(ws + OFF_ROPE), (bf16_t*)(ws + OFF_QM)};
    gemm_phase((const bf16_t*)(ws + OFF_CQ), 384, (const bf16_t*)(ws + OFF_WUQT), 384, NTOK, 768, 384, smem, eq);
    EpiUpKV ek{(const float*)(ws + OFF_RKV), (bf16_t*)(ws + OFF_KM), (bf16_t*)(ws + OFF_VMT)};
    gemm_phase((const bf16_t*)(ws + OFF_CKV), 256, (const bf16_t*)(ws + OFF_WUKVT), 256, NTOK, 1024, 256, smem, ek);
  } else if constexpr (PH == 4) {
    phase_attn(P, smem);
  } else if constexpr (PH == 5) {
    EpiWo e{(const bf16_t*)(ws + OFF_H), P.out};
    gemm_phase((const bf16_t*)(ws + OFF_MIX), 1024, (const bf16_t*)(ws + OFF_WOT), 1024, NTOK, 1024, 1024, smem, e);
  } else if constexpr (PH == 6) {
    phase_ln1(P);
  } else if constexpr (PH == 7) {
    EpiGate eg{P.gate_b, (bf16_t*)(ws + OFF_G)};
    gemm_phase((const bf16_t*)(ws + OFF_H), 1024, (const bf16_t*)(ws + OFF_GATEWT), 1024, NTOK, 1024, 1024, smem, eg);
    phase_route(P, smem);
  } else if constexpr (PH == 8) {
    EpiPle e{(const bf16_t*)(ws + OFF_H), (const bf16_t*)(ws + OFF_G), P.out};
    gemm_phase((const bf16_t*)(ws + OFF_PB), 256, (const bf16_t*)(ws + OFF_PLEWT), 256, NTOK, 1024, 256, smem, e);
  } else if constexpr (PH == 9) {
    phase_gather(P);
  }
}

constexpr int NPHASE = 10;

template <int PH>
__global__ void __launch_bounds__(256, 2) k_phase(Params P) {
  __shared__ __attribute__((aligned(16))) char smem[SMEM_BYTES];
  run_phase<PH>(P, smem);
}

#ifndef REP_PHASE
#define REP_PHASE -1
#endif
#ifndef USE_CG
#define USE_CG 0
#endif
#if USE_CG
#define GSYNC() grid.sync()
#else
#define GSYNC() xcd_barrier(xb)
#endif
#define RUNP(k) do { if (REP_PHASE == (k)) { run_phase<k>(P, smem); GSYNC(); } run_phase<k>(P, smem); } while (0)

__global__ void __launch_bounds__(256, 2) k_mega(Params P) {
  __shared__ __attribute__((aligned(16))) char smem[SMEM_BYTES + 16];
  cg::grid_group grid = cg::this_grid();
  if (P.ws == nullptr) grid.sync();
  volatile LAS unsigned* st = (volatile LAS unsigned*)(smem + SMEM_BYTES);
  if (threadIdx.x < 4) st[threadIdx.x] = 0u;
  __syncthreads();
  XcdBarrier xb = xcd_barrier_post((unsigned*)(P.ws + OFF_BAR), st);
  RUNP(0); GSYNC();
  RUNP(1); GSYNC();
  RUNP(2); GSYNC();
  RUNP(3); GSYNC();
  RUNP(4); GSYNC();
  RUNP(5); GSYNC();
  RUNP(6); GSYNC();
  RUNP(7); GSYNC();
  RUNP(8); GSYNC();
  run_phase<9>(P, smem);
}

extern "C" void kernel_launch(void* const* d_in, const int* in_sizes, int n_in, void* d_out, int out_size, void* d_ws,
                              size_t ws_size, hipStream_t stream) {
  (void)in_sizes; (void)n_in; (void)out_size; (void)ws_size;
  Params P{};
  const float** pp = (const float**)&P;
  for (int i = 0; i < 22; ++i) pp[i] = (const float*)d_in[i];
  P.out = (float*)d_out;
  P.ws = (char*)d_ws;
#if MEGA
  static int grid = 0;
  if (!grid) {
    int dev = 0, cus = 0, per_cu = 0;
    hipGetDevice(&dev);
    hipDeviceGetAttribute(&cus, hipDeviceAttributeMultiprocessorCount, dev);
    hipOccupancyMaxActiveBlocksPerMultiprocessor(&per_cu, k_mega, 256, 0);
    if (per_cu > 2) per_cu = 2;
    if (per_cu < 1) per_cu = 1;
    grid = cus * per_cu;
  }
  void* args[] = {&P};
  hipMemsetAsync((char*)d_ws + OFF_BAR, 0, XCD_BAR_WORDS * 4, stream);
  hipError_t e = hipLaunchCooperativeKernel((void*)k_mega, dim3(grid), dim3(256), args, 0, stream);
  if (e != hipSuccess) fprintf(stderr, "cooperative launch failed: %s\n", hipGetErrorString(e));
#else
  const int grid = 512;
  k_phase<0><<<grid, 256, 0, stream>>>(P);
  k_phase<1><<<grid, 256, 0, stream>>>(P);
  k_phase<2><<<grid, 256, 0, stream>>>(P);
  k_phase<3><<<grid, 256, 0, stream>>>(P);
  k_phase<4><<<grid, 256, 0, stream>>>(P);
  k_phase<5><<<grid, 256, 0, stream>>>(P);
  k_phase<6><<<grid, 256, 0, stream>>>(P);
  k_phase<7><<<grid, 256, 0, stream>>>(P);
  k_phase<8><<<grid, 256, 0, stream>>>(P);
  k_phase<9><<<grid, 256, 0, stream>>>(P);
#endif
}
```

```cpp
#include <hip/hip_runtime.h>
#include <hip/hip_cooperative_groups.h>
#include <stdint.h>
#include <stdio.h>

#ifndef MEGA
#define MEGA 1
#endif
#ifndef NAIVE_GEMM
#define NAIVE_GEMM 0
#endif
#ifndef NAIVE_ATTN
#define NAIVE_ATTN 0
#endif

namespace cg = cooperative_groups;

#define DI __device__ __forceinline__
typedef unsigned short bf16_t;
using bf16x8 = __attribute__((ext_vector_type(8))) short;
using f32x16 = __attribute__((ext_vector_type(16))) float;
using f32x4  = __attribute__((ext_vector_type(4))) float;
using u32x4  = __attribute__((ext_vector_type(4))) unsigned;
using u32x2  = __attribute__((ext_vector_type(2))) unsigned;

#define MFMA32(a, b, c) __builtin_amdgcn_mfma_f32_32x32x16_bf16((a), (b), (c), 0, 0, 0)

constexpr int NTOK = 32768;
constexpr int DM = 1024;
constexpr float DN_ALPHA = 1.189207115002721f;
constexpr float LN_EPS = 1e-5f;
constexpr float LOG2E = 1.4426950408889634f;
constexpr float QNA_SCALE = 0.125f * LOG2E;
constexpr float QM_SCALE = 0.10206207261596577f * LOG2E;

constexpr size_t MBy = 1ull << 20;
constexpr size_t OFF_WINT = 0;
constexpr size_t OFF_WUQT = 5 * MBy;
constexpr size_t OFF_WUKVT = 6 * MBy;
constexpr size_t OFF_WOT = 7 * MBy;
constexpr size_t OFF_WQT = 9 * MBy;
constexpr size_t OFF_SUBK = 13 * MBy;
constexpr size_t OFF_ROPE = 14 * MBy;
constexpr size_t OFF_PLEWT = 15 * MBy;
constexpr size_t OFF_GATEWT = 16 * MBy;
constexpr size_t OFF_RQ = 18 * MBy;
constexpr size_t OFF_RKV = 18 * MBy + 256 * 1024;
constexpr size_t OFF_BAR = 19 * MBy;
constexpr size_t OFF_QUEUE = 19 * MBy + 16 * 1024;
constexpr size_t BAR_MEMSET_BYTES = 32 * 1024;
constexpr size_t OFF_SU = 19 * MBy + 64 * 1024;
constexpr size_t OFF_SV = 19 * MBy + 128 * 1024;
constexpr size_t SLICE_BYTES = 16384 * 128;
constexpr size_t OFF_UBF = 20 * MBy;
constexpr size_t OFF_VBF = 52 * MBy;
constexpr size_t OFF_PB = 84 * MBy;
constexpr size_t OFF_H = 100 * MBy;
constexpr size_t OFF_QNA = 164 * MBy;
constexpr size_t OFF_KNA = 196 * MBy;
constexpr size_t OFF_VNAT = 228 * MBy;
constexpr size_t OFF_CQ = 260 * MBy;
constexpr size_t OFF_CKV = 284 * MBy;
constexpr size_t OFF_KR = 300 * MBy;
constexpr size_t OFF_QM = 304 * MBy;
constexpr size_t OFF_KM = 352 * MBy;
constexpr size_t OFF_VMT = 400 * MBy;
constexpr size_t OFF_MIX = 432 * MBy;
constexpr size_t OFF_QP = 164 * MBy;
constexpr size_t OFF_G = 292 * MBy;
constexpr size_t OFF_IDX = 356 * MBy;
constexpr size_t OFF_GW = 372 * MBy;
constexpr size_t OFF_PA = 164 * MBy;
constexpr size_t OFF_ACT = 292 * MBy;

constexpr int SMEM_BYTES = 73728;

struct Params {
  const float *x, *p, *emb_g, *emb_b, *w_in, *qg, *kvg, *w_uq, *w_ukv, *rpb, *w_o, *ln1g, *ln1b, *w_q, *subk, *pu, *pv,
      *ple_w, *gate_w, *gate_b, *ln2g, *ln2b;
  float* out;
  char* ws;
};

DI unsigned short f2bf(float x) {
  unsigned u = __float_as_uint(x);
  u += 0x7fffu + ((u >> 16) & 1u);
  return (unsigned short)(u >> 16);
}
DI float bf2f(unsigned short b) { return __uint_as_float(((unsigned)b) << 16); }
DI unsigned pack2(float lo, float hi) { return (unsigned)f2bf(lo) | ((unsigned)f2bf(hi) << 16); }
DI float bflo(unsigned u) { return __uint_as_float(u << 16); }
DI float bfhi(unsigned u) { return __uint_as_float(u & 0xffff0000u); }
DI float wave_sum(float v) {
#pragma unroll
  for (int m = 32; m >= 1; m >>= 1) v += __shfl_xor(v, m);
  return v;
}
DI float fast_exp2(float x) { return __builtin_amdgcn_exp2f(x); }
DI int pi_swap23(int r) { return (r & ~12) | ((r & 4) << 1) | ((r & 8) >> 1); }

DI void transpose_cvt(const float* __restrict__ in, bf16_t* __restrict__ out, int K, int N, const float* __restrict__ g,
                      char* smem) {
  float* tile = (float*)smem;
  const int tk = K >> 5, tn = N >> 5;
  const int tx = threadIdx.x & 31, ty = threadIdx.x >> 5;
  for (int t = blockIdx.x; t < tk * tn; t += gridDim.x) {
    const int k0 = (t / tn) << 5, n0 = (t % tn) << 5;
    __syncthreads();
#pragma unroll
    for (int i = 0; i < 4; ++i) {
      const int k = k0 + ty + 8 * i;
      float v = in[(size_t)k * N + n0 + tx];
      if (g) v *= g[k];
      tile[(ty + 8 * i) * 33 + tx] = v;
    }
    __syncthreads();
#pragma unroll
    for (int i = 0; i < 4; ++i) {
      const int n = n0 + ty + 8 * i;
      out[(size_t)n * K + k0 + tx] = f2bf(tile[tx * 33 + ty + 8 * i]);
    }
  }
}

DI void straight_cvt(const float* __restrict__ in, bf16_t* __restrict__ out, size_t n) {
  const size_t n4 = n >> 2;
  for (size_t i = (size_t)blockIdx.x * 256 + threadIdx.x; i < n4; i += (size_t)gridDim.x * 256) {
    const f32x4 v = *(const f32x4*)(in + i * 4);
    u32x2 o;
    o[0] = pack2(v[0], v[1]);
    o[1] = pack2(v[2], v[3]);
    *(u32x2*)(out + i * 4) = o;
  }
}

DI void ln_rows16(float (&v)[16], const float* __restrict__ gam, const float* __restrict__ bet, int lane) {
  float s = 0.f;
#pragma unroll
  for (int i = 0; i < 16; ++i) s += v[i];
  const float mu = wave_sum(s) * (1.f / 1024.f);
  float q = 0.f;
#pragma unroll
  for (int i = 0; i < 16; ++i) {
    v[i] -= mu;
    q += v[i] * v[i];
  }
  const float rstd = rsqrtf(wave_sum(q) * (1.f / 1024.f) + LN_EPS);
#pragma unroll
  for (int g = 0; g < 4; ++g) {
    const f32x4 gg = *(const f32x4*)(gam + g * 256 + lane * 4);
    const f32x4 bb = *(const f32x4*)(bet + g * 256 + lane * 4);
#pragma unroll
    for (int c = 0; c < 4; ++c) v[g * 4 + c] = v[g * 4 + c] * rstd * gg[c] + bb[c];
  }
}

DI float wave_max(float v) {
#pragma unroll
  for (int m = 32; m >= 1; m >>= 1) v = fmaxf(v, __shfl_xor(v, m));
  return v;
}
DI void cvt_table_fp8(const float* __restrict__ in, unsigned char* __restrict__ out8, float* __restrict__ inv_scale) {
  const int lane = threadIdx.x & 63, w = threadIdx.x >> 6;
  for (int e = blockIdx.x * 4 + w; e < 16384; e += gridDim.x * 4) {
    f32x4 v[4];
    float mx = 0.f;
#pragma unroll
    for (int g = 0; g < 4; ++g) {
      v[g] = *(const f32x4*)(in + (size_t)e * 1024 + g * 256 + lane * 4);
#pragma unroll
      for (int c = 0; c < 4; ++c) mx = fmaxf(mx, fabsf(v[g][c]));
    }
    mx = fmaxf(wave_max(mx), 1e-30f);
    const float sc = 440.f / mx;
#pragma unroll
    for (int g = 0; g < 4; ++g) {
      int p = 0;
      p = __builtin_amdgcn_cvt_pk_fp8_f32(v[g][0] * sc, v[g][1] * sc, p, false);
      p = __builtin_amdgcn_cvt_pk_fp8_f32(v[g][2] * sc, v[g][3] * sc, p, true);
      const int j = 2 * g + (lane >> 5), c = (lane & 31) * 4;
      *(int*)(out8 + (size_t)j * SLICE_BYTES + (size_t)e * 128 + c) = p;
    }
    if (lane == 0) inv_scale[e] = mx * (1.f / 440.f);
  }
}

DI void phase0(const Params& P, char* smem) {
  char* ws = P.ws;
  transpose_cvt(P.w_in, (bf16_t*)(ws + OFF_WINT), 1024, 2208, nullptr, smem);
  transpose_cvt(P.w_uq, (bf16_t*)(ws + OFF_WUQT), 384, 768, P.qg, smem);
  transpose_cvt(P.w_ukv, (bf16_t*)(ws + OFF_WUKVT), 256, 1024, P.kvg, smem);
  transpose_cvt(P.w_o, (bf16_t*)(ws + OFF_WOT), 1024, 1024, nullptr, smem);
  transpose_cvt(P.w_q, (bf16_t*)(ws + OFF_WQT), 1024, 2048, nullptr, smem);
  transpose_cvt(P.ple_w, (bf16_t*)(ws + OFF_PLEWT), 256, 1024, nullptr, smem);
  transpose_cvt(P.gate_w, (bf16_t*)(ws + OFF_GATEWT), 1024, 1024, nullptr, smem);
  straight_cvt(P.subk, (bf16_t*)(ws + OFF_SUBK), 2 * 128 * 128);
  cvt_table_fp8(P.pu, (unsigned char*)(ws + OFF_UBF), (float*)(ws + OFF_SU));
  cvt_table_fp8(P.pv, (unsigned char*)(ws + OFF_VBF), (float*)(ws + OFF_SV));
  straight_cvt(P.p, (bf16_t*)(ws + OFF_PB), (size_t)NTOK * 256);
  float* rope = (float*)(ws + OFF_ROPE);
  for (int i = blockIdx.x * 256 + threadIdx.x; i < 2048 * 16; i += gridDim.x * 256) {
    const int s = i >> 4, j = i & 15;
    const float inv = powf(10000.f, -(float)(2 * (j & 7)) / 16.f);
    const float pos = (j < 8) ? (float)(s >> 6) : (float)(s & 63);
    const float ang = pos * inv;
    rope[s * 32 + j] = cosf(ang);
    rope[s * 32 + 16 + j] = sinf(ang);
  }
  const int lane = threadIdx.x & 63, w = threadIdx.x >> 6;
  bf16_t* h0 = (bf16_t*)(ws + OFF_H);
  for (int tok = blockIdx.x * 4 + w; tok < NTOK; tok += gridDim.x * 4) {
    float v[16];
#pragma unroll
    for (int g = 0; g < 4; ++g) {
      const f32x4 t = *(const f32x4*)(P.x + (size_t)tok * 1024 + g * 256 + lane * 4);
#pragma unroll
      for (int c = 0; c < 4; ++c) v[g * 4 + c] = t[c];
    }
    ln_rows16(v, P.emb_g, P.emb_b, lane);
#pragma unroll
    for (int g = 0; g < 4; ++g) {
      u32x2 o;
      o[0] = pack2(v[g * 4 + 0], v[g * 4 + 1]);
      o[1] = pack2(v[g * 4 + 2], v[g * 4 + 3]);
      *(u32x2*)(h0 + (size_t)tok * 1024 + g * 256 + lane * 4) = o;
    }
  }
}

DI void gemm_tile_main(const bf16_t* __restrict__ ag  , int lda, const bf16_t* __restrict__ Bt,
                       const size_t (&boff)[4], int nk, char* smem, f32x16 (&acc)[2][2]) {
  const int tid = threadIdx.x, lane = tid & 63, w = tid >> 6;
  const int r = lane & 31, hh = lane >> 5;
  const int wm = w >> 1, wn = w & 1;
  bf16_t* As = (bf16_t*)smem;
  bf16_t* Bs = As + 2 * 128 * 72;
  const int lrow = tid >> 3, lkc = (tid & 7) * 8;
#pragma unroll
  for (int i = 0; i < 2; ++i)
#pragma unroll
    for (int j = 0; j < 2; ++j)
#pragma unroll
      for (int e = 0; e < 16; ++e) acc[i][j][e] = 0.f;
  u32x4 pa[4], pb[4];
#pragma unroll
  for (int i = 0; i < 4; ++i) {
    pa[i] = *(const u32x4*)(ag + (size_t)(32 * i) * lda);
    pb[i] = *(const u32x4*)(Bt + boff[i]);
  }
#pragma unroll
  for (int i = 0; i < 4; ++i) {
    *(u32x4*)(As + (lrow + 32 * i) * 72 + lkc) = pa[i];
    *(u32x4*)(Bs + (lrow + 32 * i) * 72 + lkc) = pb[i];
  }
  __syncthreads();
  for (int kt = 0; kt < nk; ++kt) {
    const int cur = kt & 1;
    if (kt + 1 < nk) {
      const int k0 = (kt + 1) << 6;
#pragma unroll
      for (int i = 0; i < 4; ++i) {
        pa[i] = *(const u32x4*)(ag + (size_t)(32 * i) * lda + k0);
        pb[i] = *(const u32x4*)(Bt + boff[i] + k0);
      }
    }
    const bf16_t* as = As + cur * (128 * 72) + (wm * 64 + r) * 72 + hh * 8;
    const bf16_t* bs = Bs + cur * (128 * 72) + (wn * 64 + r) * 72 + hh * 8;
#pragma unroll
    for (int ks = 0; ks < 4; ++ks) {
      const bf16x8 a0 = *(const bf16x8*)(as + ks * 16);
      const bf16x8 a1 = *(const bf16x8*)(as + 32 * 72 + ks * 16);
      const bf16x8 b0 = *(const bf16x8*)(bs + ks * 16);
      const bf16x8 b1 = *(const bf16x8*)(bs + 32 * 72 + ks * 16);
      acc[0][0] = MFMA32(a0, b0, acc[0][0]);
      acc[0][1] = MFMA32(a0, b1, acc[0][1]);
      acc[1][0] = MFMA32(a1, b0, acc[1][0]);
      acc[1][1] = MFMA32(a1, b1, acc[1][1]);
    }
    if (kt + 1 < nk) {
      const int nx = cur ^ 1;
#pragma unroll
      for (int i = 0; i < 4; ++i) {
        *(u32x4*)(As + nx * (128 * 72) + (lrow + 32 * i) * 72 + lkc) = pa[i];
        *(u32x4*)(Bs + nx * (128 * 72) + (lrow + 32 * i) * 72 + lkc) = pb[i];
      }
    }
    __syncthreads();
  }
}

template <class Epi>
DI void gemm_phase(const bf16_t* __restrict__ A, int lda, const bf16_t* __restrict__ Bt, int ldb, int M, int N, int K,
                   char* smem, const Epi& epi) {
  const int tid = threadIdx.x, lane = tid & 63, w = tid >> 6;
  const int r = lane & 31, hh = lane >> 5;
  const int wm = w >> 1, wn = w & 1;
  const int nt = (N + 127) >> 7;
  const int ntiles = (M >> 7) * nt;
  const int nk = K >> 6;
  const int lrow = tid >> 3, lkc = (tid & 7) * 8;
  for (int tile = blockIdx.x; tile < ntiles; tile += gridDim.x) {
    const int tm = tile / nt, tn = tile - tm * nt;
    const int m0 = tm << 7, n0 = tn << 7;
    f32x16 acc[2][2];
    const bf16_t* ag = A + (size_t)(m0 + lrow) * lda + lkc;
    size_t boff[4];
#pragma unroll
    for (int i = 0; i < 4; ++i) {
      int n = n0 + lrow + 32 * i;
      n = n < N ? n : N - 1;
      boff[i] = (size_t)n * ldb + lkc;
    }
    gemm_tile_main(ag, lda, Bt, boff, nk, smem, acc);
#pragma unroll
    for (int mi = 0; mi < 2; ++mi)
#pragma unroll
      for (int ni = 0; ni < 2; ++ni) {
#pragma unroll
        for (int e = 0; e < 16; ++e) {
          const int row = m0 + wm * 64 + mi * 32 + (e & 3) + 8 * (e >> 2) + 4 * hh;
          const int col = n0 + wn * 64 + ni * 32 + r;
          epi(row, col, acc[mi][ni][e]);
        }
        asm volatile("" ::: "memory");
      }
  }
}

struct EpiInProj {
  bf16_t *qna, *kna, *vnat, *cq, *ckv;
  float* kr;
  DI void operator()(int row, int col, float v) const {
    if (col >= 2208) return;
    const int b = row >> 11, s = row & 2047;
    if (col < 1536) {
      const int sec = col >> 9, c = col & 511, h = c >> 6, d = c & 63;
      const size_t bh = (size_t)(b * 8 + h);
      if (sec == 0) qna[(bh * 2048 + s) * 64 + d] = f2bf(v * QNA_SCALE);
      else if (sec == 1) kna[(bh * 2048 + s) * 64 + d] = f2bf(v);
      else vnat[(bh * 64 + d) * 2048 + s] = f2bf(v);
    } else if (col < 1920) {
      cq[(size_t)row * 384 + (col - 1536)] = f2bf(v);
    } else if (col < 2176) {
      ckv[(size_t)row * 256 + (col - 1920)] = f2bf(v);
    } else {
      kr[(size_t)row * 32 + (col - 2176)] = v;
    }
  }
};
struct EpiUpQ {
  const float* rq;
  const float* rope;
  bf16_t* qm;
  DI void operator()(int row, int col, float v) const {
    v *= rq[row];
    const float pv = __shfl_xor(v, 1);
    const int hd = col / 96, d = col - hd * 96;
    const int b = row >> 11, s = row & 2047;
    float o = v;
    if (d >= 64) {
      const int i = (d - 64) >> 1;
      const float c = rope[s * 32 + i], sn = rope[s * 32 + 16 + i];
      o = (d & 1) ? (pv * sn + v * c) : (v * c - pv * sn);
    }
    qm[((size_t)(b * 8 + hd) * 2048 + s) * 96 + d] = f2bf(o * QM_SCALE);
  }
};
struct EpiUpKV {
  const float* rkv;
  bf16_t *km, *vmt;
  DI void operator()(int row, int col, float v) const {
    v *= rkv[row];
    const int hd = col >> 7, d = col & 127;
    const int b = row >> 11, s = row & 2047;
    const size_t bh = (size_t)(b * 8 + hd);
    if (d < 64) km[(bh * 2048 + s) * 96 + d] = f2bf(v);
    else vmt[(bh * 64 + (d - 64)) * 2048 + s] = f2bf(v);
  }
};
struct EpiWo {
  const bf16_t* h0;
  float* y1;
  DI void operator()(int row, int col, float v) const {
    const size_t i = (size_t)row * 1024 + col;
    y1[i] = DN_ALPHA * bf2f(h0[i]) + v;
  }
};
struct EpiPeerQ {
  bf16_t* qp;
  DI void operator()(int row, int col, float v) const { qp[(size_t)row * 2048 + col] = f2bf(v); }
};
struct EpiGate {
  const float* gb;
  bf16_t* G;
  DI void operator()(int row, int col, float v) const {
    G[(size_t)row * 1024 + col] = f2bf(1.f / (1.f + __expf(-(v + gb[col]))));
  }
};
struct EpiPle {
  const bf16_t *h1, *G;
  float* y2;
  DI void operator()(int row, int col, float v) const {
    const size_t i = (size_t)row * 1024 + col;
    y2[i] = DN_ALPHA * bf2f(h1[i]) + bf2f(G[i]) * v;
  }
};

DI void phase_stats(const Params& P) {
  char* ws = P.ws;
  const bf16_t* cq = (const bf16_t*)(ws + OFF_CQ);
  const bf16_t* ckv = (const bf16_t*)(ws + OFF_CKV);
  const float* kr = (const float*)(ws + OFF_KR);
  const float* rope = (const float*)(ws + OFF_ROPE);
  float* rq = (float*)(ws + OFF_RQ);
  float* rkv = (float*)(ws + OFF_RKV);
  bf16_t* km = (bf16_t*)(ws + OFF_KM);
  const int lane = threadIdx.x & 63, w = threadIdx.x >> 6;
  for (int tok = blockIdx.x * 4 + w; tok < NTOK; tok += gridDim.x * 4) {
    float s1 = 0.f, s2 = 0.f;
#pragma unroll
    for (int i = 0; i < 6; ++i) {
      const float v = bf2f(cq[(size_t)tok * 384 + i * 64 + lane]);
      s1 += v * v;
    }
#pragma unroll
    for (int i = 0; i < 4; ++i) {
      const float v = bf2f(ckv[(size_t)tok * 256 + i * 64 + lane]);
      s2 += v * v;
    }
    s1 = wave_sum(s1);
    s2 = wave_sum(s2);
    if (lane == 0) {
      rq[tok] = rsqrtf(s1 * (1.f / 384.f) + LN_EPS);
      rkv[tok] = rsqrtf(s2 * (1.f / 256.f) + LN_EPS);
    }
    if (lane < 16) {
      const int b = tok >> 11, s = tok & 2047;
      const float x1 = kr[(size_t)tok * 32 + 2 * lane], x2 = kr[(size_t)tok * 32 + 2 * lane + 1];
      const float c = rope[s * 32 + lane], sn = rope[s * 32 + 16 + lane];
      const unsigned o = pack2(x1 * c - x2 * sn, x1 * sn + x2 * c);
#pragma unroll
      for (int h = 0; h < 8; ++h) *(unsigned*)(km + ((size_t)(b * 8 + h) * 2048 + s) * 96 + 64 + 2 * lane) = o;
    }
  }
}

DI bf16x8 pack8(const f32x16& x, int base) {
  u32x4 p;
  p[0] = pack2(x[base + 0], x[base + 1]);
  p[1] = pack2(x[base + 2], x[base + 3]);
  p[2] = pack2(x[base + 4], x[base + 5]);
  p[3] = pack2(x[base + 6], x[base + 7]);
  return __builtin_bit_cast(bf16x8, p);
}

DI void softmax_step(f32x16 (&sacc)[2], float& m, float& l, f32x16 (&oacc)[2], bf16x8 (&pf)[4]) {
  float mx = sacc[0][0];
#pragma unroll
  for (int e = 1; e < 16; ++e) mx = fmaxf(mx, sacc[0][e]);
#pragma unroll
  for (int e = 0; e < 16; ++e) mx = fmaxf(mx, sacc[1][e]);
  mx = fmaxf(mx, __shfl_xor(mx, 32));
  const float mnew = fmaxf(m, mx);
  const float alpha = fast_exp2(m - mnew);
  m = mnew;
  float ps = 0.f;
#pragma unroll
  for (int t = 0; t < 2; ++t)
#pragma unroll
    for (int e = 0; e < 16; ++e) {
      const float p = fast_exp2(sacc[t][e] - mnew);
      sacc[t][e] = p;
      ps += p;
    }
  l = l * alpha + ps;
#pragma unroll
  for (int t = 0; t < 2; ++t)
#pragma unroll
    for (int e = 0; e < 16; ++e) oacc[t][e] *= alpha;
  pf[0] = pack8(sacc[0], 0);
  pf[1] = pack8(sacc[0], 8);
  pf[2] = pack8(sacc[1], 0);
  pf[3] = pack8(sacc[1], 8);
}

DI void store_o(const f32x16 (&oacc)[2], float l, bf16_t* dst  , int hh) {
  const float lt = l + __shfl_xor(l, 32);
  const float inv = 1.f / lt;
#pragma unroll
  for (int dt = 0; dt < 2; ++dt)
#pragma unroll
    for (int g = 0; g < 4; ++g) {
      u32x2 o;
      o[0] = pack2(oacc[dt][4 * g + 0] * inv, oacc[dt][4 * g + 1] * inv);
      o[1] = pack2(oacc[dt][4 * g + 2] * inv, oacc[dt][4 * g + 3] * inv);
      *(u32x2*)(dst + 32 * dt + 8 * g + 4 * hh) = o;
    }
}

DI void phase_attn(const Params& P, char* smem) {
  char* ws = P.ws;
  const bf16_t* QNA = (const bf16_t*)(ws + OFF_QNA);
  const bf16_t* KNA = (const bf16_t*)(ws + OFF_KNA);
  const bf16_t* VNAT = (const bf16_t*)(ws + OFF_VNAT);
  const bf16_t* QM = (const bf16_t*)(ws + OFF_QM);
  const bf16_t* KM = (const bf16_t*)(ws + OFF_KM);
  const bf16_t* VMT = (const bf16_t*)(ws + OFF_VMT);
  bf16_t* mix = (bf16_t*)(ws + OFF_MIX);
  const int tid = threadIdx.x, lane = tid & 63, w = tid >> 6;
  const int r = lane & 31, hh = lane >> 5;
  const int pr = pi_swap23(r);
  float* bl = (float*)(smem + 45056);
  __syncthreads();
  for (int i = tid; i < 8 * 465; i += 256) bl[i] = P.rpb[i] * LOG2E;
  __syncthreads();
  for (int item = blockIdx.x * 4 + w; item < 8192; item += gridDim.x * 4) {
    const int half = item & 1, h = (item >> 1) & 7, rr = (item >> 4) & 31, b = item >> 9;
    const size_t bh = (size_t)(b * 8 + h);
    int rs = rr - 4; rs = rs < 0 ? 0 : (rs > 24 ? 24 : rs);
    const int qc = 32 * half + r;
    int cs = qc - 8; cs = cs < 0 ? 0 : (cs > 48 ? 48 : cs);
    bf16x8 qf[4];
#pragma unroll
    for (int s = 0; s < 4; ++s) qf[s] = *(const bf16x8*)(QNA + (bh * 2048 + rr * 64 + qc) * 64 + 16 * s + 8 * hh);
    f32x16 oacc[2];
#pragma unroll
    for (int t = 0; t < 2; ++t)
#pragma unroll
      for (int e = 0; e < 16; ++e) oacc[t][e] = 0.f;
    float m = -1e30f, l = 0.f;
    for (int i = 0; i < 8; ++i) {
      const int key0 = (rs + i) * 64;
      f32x16 sacc[2];
#pragma unroll
      for (int t = 0; t < 2; ++t)
#pragma unroll
        for (int e = 0; e < 16; ++e) sacc[t][e] = 0.f;
#pragma unroll
      for (int kt = 0; kt < 2; ++kt)
#pragma unroll
        for (int s = 0; s < 4; ++s) {
          const bf16x8 kf = *(const bf16x8*)(KNA + (bh * 2048 + key0 + 32 * kt + pr) * 64 + 16 * s + 8 * hh);
          sacc[kt] = MFMA32(kf, qf[s], sacc[kt]);
        }
      const float* brow = bl + h * 465 + (rs + i - rr + 7) * 31;
#pragma unroll
      for (int kt = 0; kt < 2; ++kt)
#pragma unroll
        for (int e = 0; e < 16; ++e) {
          const int kc = 32 * kt + (e & 7) + 8 * hh + 16 * (e >> 3);
          const bool valid = (unsigned)(kc - cs) < 16u;
          int dj = kc - qc + 15;
          dj = dj < 0 ? 0 : (dj > 30 ? 30 : dj);
          const float bias = brow[dj];
          sacc[kt][e] = valid ? sacc[kt][e] + bias : -INFINITY;
        }
      bf16x8 pf[4];
      softmax_step(sacc, m, l, oacc, pf);
#pragma unroll
      for (int dt = 0; dt < 2; ++dt)
#pragma unroll
        for (int s = 0; s < 4; ++s) {
          const bf16x8 vf = *(const bf16x8*)(VNAT + (bh * 64 + 32 * dt + r) * 2048 + key0 + 16 * s + 8 * hh);
          oacc[dt] = MFMA32(vf, pf[s], oacc[dt]);
        }
    }
    store_o(oacc, l, mix + ((size_t)b * 2048 + rr * 64 + qc) * 1024 + h * 64, hh);
  }
  bf16_t* Ks = (bf16_t*)smem;
  bf16_t* Vs = (bf16_t*)(smem + 2 * 13312);
  for (int item = blockIdx.x; item < 2048; item += gridDim.x) {
    const int bh = item >> 4, qt = item & 15;
    const int b = bh >> 3, h = bh & 7;
    const int q0 = qt * 128 + w * 32;
    bf16x8 qf[6];
#pragma unroll
    for (int s = 0; s < 6; ++s) qf[s] = *(const bf16x8*)(QM + ((size_t)bh * 2048 + q0 + r) * 96 + 16 * s + 8 * hh);
    f32x16 oacc[2];
#pragma unroll
    for (int t = 0; t < 2; ++t)
#pragma unroll
      for (int e = 0; e < 16; ++e) oacc[t][e] = 0.f;
    float m = -1e30f, l = 0.f;
    const bf16_t* kg = KM + (size_t)bh * 2048 * 96;
    const bf16_t* vg = VMT + (size_t)bh * 64 * 2048;
    u32x4 pk[3], pv[2];
    int klds[3], vlds[2];
    size_t vgo[2];
#pragma unroll
    for (int i = 0; i < 3; ++i) {
      const int c = tid + 256 * i;
      klds[i] = (c / 12) * 104 + (c % 12) * 8;
    }
#pragma unroll
    for (int i = 0; i < 2; ++i) {
      const int c = tid + 256 * i;
      vlds[i] = (c >> 3) * 72 + (c & 7) * 8;
      vgo[i] = (size_t)(c >> 3) * 2048 + (c & 7) * 8;
    }
    __syncthreads();
#pragma unroll
    for (int i = 0; i < 3; ++i) pk[i] = *(const u32x4*)(kg + (size_t)(tid + 256 * i) * 8);
#pragma unroll
    for (int i = 0; i < 2; ++i) pv[i] = *(const u32x4*)(vg + vgo[i]);
#pragma unroll
    for (int i = 0; i < 3; ++i) *(u32x4*)(Ks + klds[i]) = pk[i];
#pragma unroll
    for (int i = 0; i < 2; ++i) *(u32x4*)(Vs + vlds[i]) = pv[i];
    __syncthreads();
    for (int j = 0; j < 32; ++j) {
      const int cur = j & 1;
      if (j + 1 < 32) {
        const bf16_t* kgn = kg + (size_t)(j + 1) * 64 * 96;
#pragma unroll
        for (int i = 0; i < 3; ++i) pk[i] = *(const u32x4*)(kgn + (size_t)(tid + 256 * i) * 8);
#pragma unroll
        for (int i = 0; i < 2; ++i) pv[i] = *(const u32x4*)(vg + vgo[i] + (j + 1) * 64);
      }
      const bf16_t* ks = Ks + cur * (64 * 104);
      const bf16_t* vs = Vs + cur * (64 * 72);
      f32x16 sacc[2];
#pragma unroll
      for (int t = 0; t < 2; ++t)
#pragma unroll
        for (int e = 0; e < 16; ++e) sacc[t][e] = 0.f;
#pragma unroll
      for (int kt = 0; kt < 2; ++kt)
#pragma unroll
        for (int s = 0; s < 6; ++s) {
          const bf16x8 kf = *(const bf16x8*)(ks + (32 * kt + pr) * 104 + 16 * s + 8 * hh);
          sacc[kt] = MFMA32(kf, qf[s], sacc[kt]);
        }
      bf16x8 pf[4];
      softmax_step(sacc, m, l, oacc, pf);
#pragma unroll
      for (int dt = 0; dt < 2; ++dt)
#pragma unroll
        for (int s = 0; s < 4; ++s) {
          const bf16x8 vf = *(const bf16x8*)(vs + (32 * dt + r) * 72 + 16 * s + 8 * hh);
          oacc[dt] = MFMA32(vf, pf[s], oacc[dt]);
        }
      if (j + 1 < 32) {
        const int nx = cur ^ 1;
#pragma unroll
        for (int i = 0; i < 3; ++i) *(u32x4*)(Ks + nx * (64 * 104) + klds[i]) = pk[i];
#pragma unroll
        for (int i = 0; i < 2; ++i) *(u32x4*)(Vs + nx * (64 * 72) + vlds[i]) = pv[i];
      }
      __syncthreads();
    }
    store_o(oacc, l, mix + ((size_t)b * 2048 + q0 + r) * 1024 + 512 + h * 64, hh);
  }
}

DI void phase_ln1(const Params& P) {
  const int lane = threadIdx.x & 63, w = threadIdx.x >> 6;
  bf16_t* h1 = (bf16_t*)(P.ws + OFF_H);
  for (int tok = blockIdx.x * 4 + w; tok < NTOK; tok += gridDim.x * 4) {
    float v[16];
#pragma unroll
    for (int g = 0; g < 4; ++g) {
      const f32x4 t = *(const f32x4*)(P.out + (size_t)tok * 1024 + g * 256 + lane * 4);
#pragma unroll
      for (int c = 0; c < 4; ++c) v[g * 4 + c] = t[c];
    }
    ln_rows16(v, P.ln1g, P.ln1b, lane);
#pragma unroll
    for (int g = 0; g < 4; ++g) {
      u32x2 o;
      o[0] = pack2(v[g * 4 + 0], v[g * 4 + 1]);
      o[1] = pack2(v[g * 4 + 2], v[g * 4 + 3]);
      *(u32x2*)(h1 + (size_t)tok * 1024 + g * 256 + lane * 4) = o;
    }
  }
}

#define CE_DESC(a, b) { const float _hi = fmaxf(a, b), _lo = fminf(a, b); a = _hi; b = _lo; }
DI void sort16_desc(float (&v)[16]) {
#pragma unroll
  for (int kk = 1; kk <= 4; ++kk)
#pragma unroll
    for (int jj = kk - 1; jj >= 0; --jj)
#pragma unroll
      for (int i = 0; i < 16; ++i) {
        const int k = 1 << kk, j = 1 << jj, l = i ^ j;
        if (l > i) {
          if ((i & k) == 0) CE_DESC(v[i], v[l]) else CE_DESC(v[l], v[i])
        }
      }
}
DI void merge16_desc(float (&a)[16], const float (&b)[16]) {
#pragma unroll
  for (int i = 0; i < 16; ++i) a[i] = fmaxf(a[i], b[15 - i]);
#pragma unroll
  for (int jj = 3; jj >= 0; --jj)
#pragma unroll
    for (int i = 0; i < 16; ++i) {
      const int j = 1 << jj, l = i ^ j;
      if (l > i) CE_DESC(a[i], a[l])
    }
}
DI float pack_code(float v, unsigned mask, unsigned code) { return __uint_as_float((__float_as_uint(v) & mask) | code); }

DI void phase_route(const Params& P, char* smem) {
  char* ws = P.ws;
  const bf16_t* h1 = (const bf16_t*)(ws + OFF_H);
  const bf16_t* WqT = (const bf16_t*)(ws + OFF_WQT);
  const bf16_t* subk = (const bf16_t*)(ws + OFF_SUBK);
  int* idx_out = (int*)(ws + OFF_IDX);
  float* g_out = (float*)(ws + OFF_GW);
  const int tid = threadIdx.x, lane = tid & 63, w = tid >> 6;
  const int r = lane & 31, hh = lane >> 5;
  const int wm = w >> 1, wn = w & 1;
  const int lrow = tid >> 3, lkc = (tid & 7) * 8;
  bf16_t* qb = (bf16_t*)smem;
  bf16_t* sk = (bf16_t*)(smem + 34816);
  float* lst = (float*)smem;
  for (int item = blockIdx.x; item < 2048; item += gridDim.x) {
    const int tm = item >> 3, h = item & 7;
    const int m0 = tm << 7;
    float L[2][16];
#pragma unroll
    for (int c = 0; c < 2; ++c) {
      f32x16 acc[2][2];
      const bf16_t* ag = h1 + (size_t)(m0 + lrow) * 1024 + lkc;
      size_t boff[4];
#pragma unroll
      for (int i = 0; i < 4; ++i) boff[i] = (size_t)(h * 256 + c * 128 + lrow + 32 * i) * 1024 + lkc;
      gemm_tile_main(ag, 1024, WqT, boff, 16, smem, acc);
      {
        bf16_t* qw = qb + (wm * 64 + 4 * hh) * 136 + wn * 64 + r;
#pragma unroll
        for (int mi = 0; mi < 2; ++mi)
#pragma unroll
          for (int ni = 0; ni < 2; ++ni)
#pragma unroll
            for (int e = 0; e < 16; ++e)
              qw[(mi * 32 + (e & 3) + 8 * (e >> 2)) * 136 + ni * 32] = f2bf(acc[mi][ni][e]);
      }
      {
        const bf16_t* sg = subk + (size_t)c * 16384 + tid * 8;
        bf16_t* sl = sk + (tid >> 4) * 136 + (tid & 15) * 8;
#pragma unroll
        for (int i = 0; i < 8; ++i) *(u32x4*)(sl + i * (16 * 136)) = *(const u32x4*)(sg + i * 2048);
      }
      __syncthreads();
      f32x16 sacc[4];
#pragma unroll
      for (int t = 0; t < 4; ++t)
#pragma unroll
        for (int e = 0; e < 16; ++e) sacc[t][e] = 0.f;
#pragma unroll 2
      for (int s = 0; s < 8; ++s) {
        const bf16x8 bq = *(const bf16x8*)(qb + (32 * w + r) * 136 + 16 * s + 8 * hh);
#pragma unroll
        for (int kt = 0; kt < 4; ++kt) {
          const bf16x8 ak = *(const bf16x8*)(sk + (32 * kt + r) * 136 + 16 * s + 8 * hh);
          sacc[kt] = MFMA32(ak, bq, sacc[kt]);
        }
      }
      __syncthreads();
      float T[4][16];
#pragma unroll
      for (int kt = 0; kt < 4; ++kt) {
#pragma unroll
        for (int e = 0; e < 16; ++e)
          T[kt][e] = pack_code(sacc[kt][e], 0xFFFFFF80u, (unsigned)(32 * kt + (e & 3) + 8 * (e >> 2)));
        sort16_desc(T[kt]);
      }
      merge16_desc(T[0], T[1]);
      merge16_desc(T[2], T[3]);
      merge16_desc(T[0], T[2]);
      {
        const unsigned hb = (unsigned)hh << 2;
#pragma unroll
        for (int i = 0; i < 16; ++i) T[0][i] = __uint_as_float(__float_as_uint(T[0][i]) | hb);
      }
      float Pn[16];
#pragma unroll
      for (int i = 0; i < 16; ++i) Pn[i] = __shfl_xor(T[0][i], 32);
      merge16_desc(T[0], Pn);
#pragma unroll
      for (int i = 0; i < 16; ++i) L[c][i] = T[0][i];
    }
    float A0[16], B1[16], C2[16], D3[16];
#pragma unroll
    for (int j = 0; j < 16; ++j) A0[j] = pack_code(L[0][0] + L[1][j], 0xFFFFFF00u, (unsigned)j);
#pragma unroll
    for (int j = 0; j < 16; ++j) B1[j] = (j < 8) ? pack_code(L[0][1] + L[1][j], 0xFFFFFF00u, (unsigned)(16 + j)) : -INFINITY;
    {
      int n = 0;
#pragma unroll
      for (int i = 2; i <= 4; ++i)
#pragma unroll
        for (int j = 0; j < 16 / (i + 1); ++j) { C2[n] = pack_code(L[0][i] + L[1][j], 0xFFFFFF00u, (unsigned)(16 * i + j)); ++n; }
#pragma unroll
      for (int q = 12; q < 16; ++q) C2[q] = -INFINITY;
      n = 0;
#pragma unroll
      for (int i = 5; i <= 15; ++i)
#pragma unroll
        for (int j = 0; j < 16 / (i + 1); ++j) { D3[n] = pack_code(L[0][i] + L[1][j], 0xFFFFFF00u, (unsigned)(16 * i + j)); ++n; }
      D3[14] = -INFINITY; D3[15] = -INFINITY;
    }
    sort16_desc(C2);
    sort16_desc(D3);
    merge16_desc(A0, B1);
    merge16_desc(C2, D3);
    merge16_desc(A0, C2);
#pragma unroll
    for (int i = 0; i < 16; ++i) {
      lst[i * 256 + tid] = L[0][i];
      lst[(16 + i) * 256 + tid] = L[1][i];
    }
    float cv[16];
    int eid[16];
#pragma unroll
    for (int k = 0; k < 16; ++k) {
      const unsigned code = __float_as_uint(A0[k]) & 255u;
      const float v1 = lst[(code >> 4) * 256 + tid];
      const float v2 = lst[(16 + (code & 15u)) * 256 + tid];
      cv[k] = v1 + v2;
      eid[k] = (int)((__float_as_uint(v1) & 127u) * 128u + (__float_as_uint(v2) & 127u));
    }
    float mx = cv[0];
#pragma unroll
    for (int k = 1; k < 16; ++k) mx = fmaxf(mx, cv[k]);
    float sum = 0.f;
#pragma unroll
    for (int k = 0; k < 16; ++k) { cv[k] = __expf(cv[k] - mx); sum += cv[k]; }
    const float inv = 1.f / sum;
    const size_t o = (size_t)(m0 + 32 * w + r) * 128 + h * 16;
    if (hh == 0) {
#pragma unroll
      for (int q = 0; q < 4; ++q) {
        u32x4 t;
#pragma unroll
        for (int c = 0; c < 4; ++c) t[c] = (unsigned)eid[4 * q + c];
        *(u32x4*)(idx_out + o + 4 * q) = t;
      }
    } else {
#pragma unroll
      for (int q = 0; q < 4; ++q) {
        f32x4 t;
#pragma unroll
        for (int c = 0; c < 4; ++c) t[c] = cv[4 * q + c] * inv;
        *(f32x4*)(g_out + o + 4 * q) = t;
      }
    }
    __syncthreads();
  }
}

typedef float f32x2 __attribute__((ext_vector_type(2)));
constexpr unsigned PEER_CHUNK_TOK = 8;
constexpr unsigned PEER_NCHUNK = NTOK / PEER_CHUNK_TOK;

DI void peer_taskA(const Params& P, int j, int tok, int lane) {
  char* ws = P.ws;
  const int eg = lane >> 3, ch = lane & 7;
  const int* ip = (const int*)(ws + OFF_IDX) + (size_t)tok * 128 + eg;
  const unsigned char* U8 = (const unsigned char*)(ws + OFF_UBF) + (size_t)j * SLICE_BYTES + ch * 16;
  int id[16];
#pragma unroll
  for (int i = 0; i < 16; ++i) id[i] = ip[8 * i];
  const bf16_t* xp = (const bf16_t*)(ws + OFF_H) + (size_t)tok * 1024 + j * 128 + ch * 16;
  const u32x4 xa = *(const u32x4*)xp, xb = *(const u32x4*)(xp + 8);
  f32x2 x2[8];
#pragma unroll
  for (int k = 0; k < 4; ++k) {
    x2[k][0] = bflo(xa[k]); x2[k][1] = bfhi(xa[k]);
    x2[4 + k][0] = bflo(xb[k]); x2[4 + k][1] = bfhi(xb[k]);
  }
  u32x4 uv[16];
#pragma unroll
  for (int i = 0; i < 16; ++i) uv[i] = *(const u32x4*)(U8 + (size_t)id[i] * 128);
  float keep0 = 0.f, keep1 = 0.f;
#pragma unroll
  for (int i = 0; i < 16; ++i) {
    f32x2 a = {0.f, 0.f};
#pragma unroll
    for (int k = 0; k < 4; ++k) {
      const f32x2 lo = __builtin_amdgcn_cvt_pk_f32_fp8((int)uv[i][k], false);
      const f32x2 hi = __builtin_amdgcn_cvt_pk_f32_fp8((int)uv[i][k], true);
      a += lo * x2[2 * k];
      a += hi * x2[2 * k + 1];
    }
    float sm = a[0] + a[1];
    sm += __shfl_xor(sm, 1);
    sm += __shfl_xor(sm, 2);
    sm += __shfl_xor(sm, 4);
    if (i < 8) { if (ch == i) keep0 = sm; }
    else { if (ch == i - 8) keep1 = sm; }
  }
  float* pa = (float*)(ws + OFF_PA) + ((size_t)j * NTOK + tok) * 128 + 8 * ch + eg;
  pa[0] = keep0;
  pa[64] = keep1;
}

DI void peer_taskB(const Params& P, int j, int tok, int lane) {
  char* ws = P.ws;
  const int eg = lane >> 3, ch = lane & 7;
  const int* ip = (const int*)(ws + OFF_IDX) + (size_t)tok * 128 + eg;
  const float* ap = (const float*)(ws + OFF_ACT) + (size_t)tok * 128 + eg;
  const unsigned char* V8 = (const unsigned char*)(ws + OFF_VBF) + (size_t)j * SLICE_BYTES + ch * 16;
  int id[16];
  float av[16];
#pragma unroll
  for (int i = 0; i < 16; ++i) { id[i] = ip[8 * i]; av[i] = ap[8 * i]; }
  u32x4 vv[16];
#pragma unroll
  for (int i = 0; i < 16; ++i) vv[i] = *(const u32x4*)(V8 + (size_t)id[i] * 128);
  f32x2 acc[8];
#pragma unroll
  for (int m = 0; m < 8; ++m) { acc[m][0] = 0.f; acc[m][1] = 0.f; }
#pragma unroll
  for (int i = 0; i < 16; ++i) {
    const f32x2 aa = {av[i], av[i]};
#pragma unroll
    for (int k = 0; k < 4; ++k) {
      acc[2 * k] += __builtin_amdgcn_cvt_pk_f32_fp8((int)vv[i][k], false) * aa;
      acc[2 * k + 1] += __builtin_amdgcn_cvt_pk_f32_fp8((int)vv[i][k], true) * aa;
    }
  }
  const bool b3 = (lane & 8) != 0, b4 = (lane & 16) != 0, b5 = (lane & 32) != 0;
  f32x2 r1[4], r2[2], r3;
#pragma unroll
  for (int m = 0; m < 4; ++m)
#pragma unroll
    for (int c = 0; c < 2; ++c) {
      const float snd = b3 ? acc[m][c] : acc[m + 4][c];
      const float kp = b3 ? acc[m + 4][c] : acc[m][c];
      r1[m][c] = kp + __shfl_xor(snd, 8);
    }
#pragma unroll
  for (int m = 0; m < 2; ++m)
#pragma unroll
    for (int c = 0; c < 2; ++c) {
      const float snd = b4 ? r1[m][c] : r1[m + 2][c];
      const float kp = b4 ? r1[m + 2][c] : r1[m][c];
      r2[m][c] = kp + __shfl_xor(snd, 16);
    }
#pragma unroll
  for (int c = 0; c < 2; ++c) {
    const float snd = b5 ? r2[0][c] : r2[1][c];
    const float kp = b5 ? r2[1][c] : r2[0][c];
    r3[c] = kp + __shfl_xor(snd, 32);
  }
  const int mstar = (b3 ? 4 : 0) + (b4 ? 2 : 0) + (b5 ? 1 : 0);
  float* op = P.out + (size_t)tok * 1024 + j * 128 + ch * 16 + 2 * mstar;
  f32x2 o = *(const f32x2*)op;
  o += r3;
  *(f32x2*)op = o;
}

template <int PASS>
DI void phase_peer_pass(const Params& P, unsigned xcc) {
  const int lane = threadIdx.x & 63;
  unsigned* qc = (unsigned*)(P.ws + OFF_QUEUE) + PASS * 8 * 64;
  for (unsigned qq = 0; qq < 8; ++qq) {
    const int j = (int)((xcc + qq) & 7u);
    unsigned* ctr = qc + j * 64;
    unsigned pend = 0;
    if (lane == 0) pend = __hip_atomic_fetch_add(ctr, 1u, __ATOMIC_RELAXED, __HIP_MEMORY_SCOPE_AGENT);
    for (;;) {
      const unsigned c = (unsigned)__builtin_amdgcn_readfirstlane((int)pend);
      if (c >= PEER_NCHUNK) break;
      if (lane == 0) pend = __hip_atomic_fetch_add(ctr, 1u, __ATOMIC_RELAXED, __HIP_MEMORY_SCOPE_AGENT);
      for (unsigned t = 0; t < PEER_CHUNK_TOK; ++t) {
        const int tok = (int)(c * PEER_CHUNK_TOK + t);
        if (PASS == 0) peer_taskA(P, j, tok, lane);
        else peer_taskB(P, j, tok, lane);
      }
    }
  }
}

DI void phase_peer_act(const Params& P) {
  char* ws = P.ws;
  const float* pa = (const float*)(ws + OFF_PA);
  const int* idx = (const int*)(ws + OFF_IDX);
  const float* gw = (const float*)(ws + OFF_GW);
  const float* isu = (const float*)(ws + OFF_SU);
  const float* isv = (const float*)(ws + OFF_SV);
  float* act = (float*)(ws + OFF_ACT);
  for (size_t i = (size_t)blockIdx.x * 256 + threadIdx.x; i < (size_t)NTOK * 128; i += (size_t)gridDim.x * 256) {
    float sm = 0.f;
#pragma unroll
    for (int j = 0; j < 8; ++j) sm += pa[(size_t)j * NTOK * 128 + i];
    const int id = idx[i];
    const float hp = sm * isu[id];
    act[i] = gw[i] * 0.5f * hp * (1.f + erff(hp * 0.70710678118654752f)) * isv[id];
  }
}

DI void phase_ln2(const Params& P) {
  const int lane = threadIdx.x & 63, w = threadIdx.x >> 6;
  for (int tok = blockIdx.x * 4 + w; tok < NTOK; tok += gridDim.x * 4) {
    float v[16];
    float* orow = P.out + (size_t)tok * 1024;
#pragma unroll
    for (int g = 0; g < 4; ++g) {
      const f32x4 t = *(const f32x4*)(orow + g * 256 + lane * 4);
#pragma unroll
      for (int c = 0; c < 4; ++c) v[g * 4 + c] = t[c];
    }
    ln_rows16(v, P.ln2g, P.ln2b, lane);
#pragma unroll
    for (int g = 0; g < 4; ++g) {
      f32x4 o;
#pragma unroll
      for (int c = 0; c < 4; ++c) o[c] = v[g * 4 + c];
      *(f32x4*)(orow + g * 256 + lane * 4) = o;
    }
  }
}

#define XB_TMO      128
#define XB_XCNT(j)  (256  + 64 * (j))
#define XB_XSUB(j)  (1280 + 64 * (j))
#define XB_XGEN(j)  (2304 + 64 * (j))
#define XB_TOP      3328
#define XB_TOPGEN   3392
#define XCD_BAR_WORDS 3456
#define XB_SPIN_CAP (1u << 22)
#define LAS __attribute__((address_space(3)))
DI unsigned xb_ld(unsigned* p) { return __hip_atomic_load(p, __ATOMIC_RELAXED, __HIP_MEMORY_SCOPE_AGENT); }
DI unsigned xb_add(unsigned* p, unsigned v) { return __hip_atomic_fetch_add(p, v, __ATOMIC_RELAXED, __HIP_MEMORY_SCOPE_AGENT); }
DI unsigned xb_xcc_id() { return (unsigned)__builtin_amdgcn_s_getreg((3 << 11) | 20) & 0xFu; }
#define XB_SPIN(cond, bar) do { unsigned _sp = 0; while (cond) { __builtin_amdgcn_s_sleep(1); \
    if ((++_sp & 255u) == 0u) { if (xb_ld(&(bar)[XB_TMO])) break; if (_sp > XB_SPIN_CAP) { atomicAdd(&(bar)[XB_TMO], 1u); break; } } } } while (0)
struct XcdBarrier { unsigned* bar; unsigned x; volatile LAS unsigned* st; };
DI XcdBarrier xcd_barrier_post(unsigned* bar, volatile LAS unsigned* st) {
  XcdBarrier b; b.bar = bar; b.x = xb_xcc_id(); b.st = st;
  if (threadIdx.x == 0) (void)xb_add(&bar[XB_XCNT(b.x)], 1u);
  return b;
}
DI void xcd_barrier_complete(unsigned* bar, unsigned x, unsigned& nloc, unsigned& nx) {
  const unsigned G = gridDim.x * gridDim.y * gridDim.z;
  unsigned sum, cnt, mine, sp = 0u;
  for (;;) {
    sum = 0u; cnt = 0u; mine = 0u;
#pragma unroll
    for (unsigned j = 0; j < 16; ++j) { const unsigned c = xb_ld(&bar[XB_XCNT(j)]); sum += c; cnt += (c > 0u) ? 1u : 0u; mine = (j == x) ? c : mine; }
    if (sum == G) break;
    __builtin_amdgcn_s_sleep(1);
    if ((++sp & 255u) == 0u) { if (xb_ld(&bar[XB_TMO])) break; if (sp > XB_SPIN_CAP) { atomicAdd(&bar[XB_TMO], 1u); break; } }
  }
  nloc = mine > 0u ? mine : 1u; nx = cnt > 0u ? cnt : 1u;
}
DI void xcd_barrier(const XcdBarrier& b) {
  asm volatile("s_waitcnt vmcnt(0)" ::: "memory");
  __syncthreads();
  if (threadIdx.x == 0) {
    unsigned* bar = b.bar;
    __builtin_amdgcn_s_waitcnt(0);
    unsigned nloc = b.st[0], nx = b.st[1];
    if (nloc == 0u) { xcd_barrier_complete(bar, b.x, nloc, nx); b.st[0] = nloc; b.st[1] = nx; }
    const unsigned old = xb_add(&bar[XB_XSUB(b.x)], 1u);
    const unsigned gen = old / nloc;
    if (old + 1u == (gen + 1u) * nloc) {
      __builtin_amdgcn_fence(__ATOMIC_RELEASE, "agent");
      asm volatile("s_waitcnt vmcnt(0)" ::: "memory");
      const unsigned og = xb_add(&bar[XB_TOP], 1u);
      const unsigned tg = og / nx;
      if (og + 1u == (tg + 1u) * nx) xb_add(&bar[XB_TOPGEN], 1u);
      else XB_SPIN(xb_ld(&bar[XB_TOPGEN]) == tg, bar);
      __builtin_amdgcn_fence(__ATOMIC_ACQUIRE, "agent");
      xb_add(&bar[XB_XGEN(b.x)], 1u);
      asm volatile("s_waitcnt vmcnt(0)" ::: "memory");
    } else {
      XB_SPIN(xb_ld(&bar[XB_XGEN(b.x)]) == gen, bar);
      __builtin_amdgcn_fence(__ATOMIC_ACQUIRE, "agent");
      asm volatile("s_waitcnt vmcnt(0)" ::: "memory");
    }
  }
  __syncthreads();
}

template <int PH>
DI void run_phase(const Params& P, char* smem, unsigned xcc) {
  char* ws = P.ws;
  if constexpr (PH == 0) {
    phase0(P, smem);
  } else if constexpr (PH == 1) {
    EpiInProj e{(bf16_t*)(ws + OFF_QNA), (bf16_t*)(ws + OFF_KNA), (bf16_t*)(ws + OFF_VNAT), (bf16_t*)(ws + OFF_CQ),
                (bf16_t*)(ws + OFF_CKV), (float*)(ws + OFF_KR)};
    gemm_phase((const bf16_t*)(ws + OFF_H), 1024, (const bf16_t*)(ws + OFF_WINT), 1024, NTOK, 2208, 1024, smem, e);
  } else if constexpr (PH == 2) {
    phase_stats(P);
  } else if constexpr (PH == 3) {
    EpiUpQ eq{(const float*)(ws + OFF_RQ), (const float*)(ws + OFF_ROPE), (bf16_t*)(ws + OFF_QM)};
    gemm_phase((const bf16_t*)(ws + OFF_CQ), 384, (const bf16_t*)(ws + OFF_WUQT), 384, NTOK, 768, 384, smem, eq);
    EpiUpKV ek{(const float*)(ws + OFF_RKV), (bf16_t*)(ws + OFF_KM), (bf16_t*)(ws + OFF_VMT)};
    gemm_phase((const bf16_t*)(ws + OFF_CKV), 256, (const bf16_t*)(ws + OFF_WUKVT), 256, NTOK, 1024, 256, smem, ek);
  } else if constexpr (PH == 4) {
    phase_attn(P, smem);
  } else if constexpr (PH == 5) {
    EpiWo e{(const bf16_t*)(ws + OFF_H), P.out};
    gemm_phase((const bf16_t*)(ws + OFF_MIX), 1024, (const bf16_t*)(ws + OFF_WOT), 1024, NTOK, 1024, 1024, smem, e);
  } else if constexpr (PH == 6) {
    phase_ln1(P);
  } else if constexpr (PH == 7) {
    EpiGate eg{P.gate_b, (bf16_t*)(ws + OFF_G)};
    gemm_phase((const bf16_t*)(ws + OFF_H), 1024, (const bf16_t*)(ws + OFF_GATEWT), 1024, NTOK, 1024, 1024, smem, eg);
    phase_route(P, smem);
  } else if constexpr (PH == 8) {
    EpiPle e{(const bf16_t*)(ws + OFF_H), (const bf16_t*)(ws + OFF_G), P.out};
    gemm_phase((const bf16_t*)(ws + OFF_PB), 256, (const bf16_t*)(ws + OFF_PLEWT), 256, NTOK, 1024, 256, smem, e);
    phase_peer_pass<0>(P, xcc);
  } else if constexpr (PH == 9) {
    phase_peer_act(P);
  } else if constexpr (PH == 10) {
    phase_peer_pass<1>(P, xcc);
  } else if constexpr (PH == 11) {
    phase_ln2(P);
  }
}

constexpr int NPHASE = 12;

template <int PH>
__global__ void __launch_bounds__(256, 2) k_phase(Params P) {
  __shared__ __attribute__((aligned(16))) char smem[SMEM_BYTES];
  run_phase<PH>(P, smem, xb_xcc_id());
}

#ifndef REP_PHASE
#define REP_PHASE -1
#endif
#ifndef USE_CG
#define USE_CG 0
#endif
#if USE_CG
#define GSYNC() grid.sync()
#else
#define GSYNC() xcd_barrier(xb)
#endif
#define RUNP(k) do { if (REP_PHASE == (k)) { run_phase<k>(P, smem, xb.x); GSYNC(); } run_phase<k>(P, smem, xb.x); } while (0)

__global__ void __launch_bounds__(256, 2) k_mega(Params P) {
  __shared__ __attribute__((aligned(16))) char smem[SMEM_BYTES + 16];
  cg::grid_group grid = cg::this_grid();
  if (P.ws == nullptr) grid.sync();
  volatile LAS unsigned* st = (volatile LAS unsigned*)(smem + SMEM_BYTES);
  if (threadIdx.x < 4) st[threadIdx.x] = 0u;
  __syncthreads();
  XcdBarrier xb = xcd_barrier_post((unsigned*)(P.ws + OFF_BAR), st);
  RUNP(0); GSYNC();
  RUNP(1); GSYNC();
  RUNP(2); GSYNC();
  RUNP(3); GSYNC();
  RUNP(4); GSYNC();
  RUNP(5); GSYNC();
  RUNP(6); GSYNC();
  RUNP(7); GSYNC();
  RUNP(8); GSYNC();
  RUNP(9); GSYNC();
  run_phase<10>(P, smem, xb.x); GSYNC();
  run_phase<11>(P, smem, xb.x);
}

extern "C" void kernel_launch(void* const* d_in, const int* in_sizes, int n_in, void* d_out, int out_size, void* d_ws,
                              size_t ws_size, hipStream_t stream) {
  (void)in_sizes; (void)n_in; (void)out_size; (void)ws_size;
  Params P{};
  const float** pp = (const float**)&P;
  for (int i = 0; i < 22; ++i) pp[i] = (const float*)d_in[i];
  P.out = (float*)d_out;
  P.ws = (char*)d_ws;
#if MEGA
  static int grid = 0;
  if (!grid) {
    int dev = 0, cus = 0, per_cu = 0;
    hipGetDevice(&dev);
    hipDeviceGetAttribute(&cus, hipDeviceAttributeMultiprocessorCount, dev);
    hipOccupancyMaxActiveBlocksPerMultiprocessor(&per_cu, k_mega, 256, 0);
    if (per_cu > 2) per_cu = 2;
    if (per_cu < 1) per_cu = 1;
    grid = cus * per_cu;
  }
  void* args[] = {&P};
  hipMemsetAsync((char*)d_ws + OFF_BAR, 0, BAR_MEMSET_BYTES, stream);
  hipError_t e = hipLaunchCooperativeKernel((void*)k_mega, dim3(grid), dim3(256), args, 0, stream);
  if (e != hipSuccess) fprintf(stderr, "cooperative launch failed: %s\n", hipGetErrorString(e));
#else
  const int grid = 512;
  hipMemsetAsync((char*)d_ws + OFF_BAR, 0, BAR_MEMSET_BYTES, stream);
  k_phase<0><<<grid, 256, 0, stream>>>(P);
  k_phase<1><<<grid, 256, 0, stream>>>(P);
  k_phase<2><<<grid, 256, 0, stream>>>(P);
  k_phase<3><<<grid, 256, 0, stream>>>(P);
  k_phase<4><<<grid, 256, 0, stream>>>(P);
  k_phase<5><<<grid, 256, 0, stream>>>(P);
  k_phase<6><<<grid, 256, 0, stream>>>(P);
  k_phase<7><<<grid, 256, 0, stream>>>(P);
  k_phase<8><<<grid, 256, 0, stream>>>(P);
  k_phase<9><<<grid, 256, 0, stream>>>(P);
  k_phase<10><<<grid, 256, 0, stream>>>(P);
  k_phase<11><<<grid, 256, 0, stream>>>(P);
#endif
}
```

```cpp
#include <hip/hip_runtime.h>
#include <hip/hip_cooperative_groups.h>
#include <stdint.h>
#include <stdio.h>

#ifndef MEGA
#define MEGA 1
#endif

namespace cg = cooperative_groups;

#define DI __device__ __forceinline__
typedef unsigned short bf16_t;
using bf16x8 = __attribute__((ext_vector_type(8))) short;
using f32x16 = __attribute__((ext_vector_type(16))) float;
using f32x4  = __attribute__((ext_vector_type(4))) float;
using u32x4  = __attribute__((ext_vector_type(4))) unsigned;
using u32x2  = __attribute__((ext_vector_type(2))) unsigned;
typedef float f32x2 __attribute__((ext_vector_type(2)));

#define MFMA32(a, b, c) __builtin_amdgcn_mfma_f32_32x32x16_bf16((a), (b), (c), 0, 0, 0)

constexpr int NT = 512;
constexpr int NW = 8;
constexpr int NTOK = 32768;
constexpr float DN_ALPHA = 1.189207115002721f;
constexpr float LN_EPS = 1e-5f;
constexpr float LOG2E = 1.4426950408889634f;
constexpr float QNA_SCALE = 0.125f * LOG2E;
constexpr float QM_SCALE = 0.10206207261596577f * LOG2E;

constexpr size_t MBy = 1ull << 20;
constexpr size_t OFF_WINA = 0;
constexpr size_t OFF_WINV = 4 * MBy;
constexpr size_t OFF_WUQT = 5 * MBy;
constexpr size_t OFF_WUKT = 6 * MBy;
constexpr size_t OFF_WUVT = 6 * MBy + 512 * 1024;
constexpr size_t OFF_WOT = 16 * MBy;
constexpr size_t OFF_WQT = 9 * MBy;
constexpr size_t OFF_SUBK = 13 * MBy;
constexpr size_t OFF_ROPE = 14 * MBy;
constexpr size_t OFF_PLEWT = 15 * MBy;
constexpr size_t OFF_GATEWT = 7 * MBy;
constexpr size_t OFF_RQ = 18 * MBy;
constexpr size_t OFF_RKV = 18 * MBy + 256 * 1024;
constexpr size_t OFF_BAR = 19 * MBy;
constexpr size_t OFF_QUEUE = 19 * MBy + 16 * 1024;
constexpr size_t BAR_MEMSET_BYTES = 32 * 1024;
constexpr size_t OFF_SU = 19 * MBy + 64 * 1024;
constexpr size_t OFF_SV = 19 * MBy + 128 * 1024;
constexpr size_t SLICE_BYTES = 16384 * 128;
constexpr size_t OFF_UBF = 20 * MBy;
constexpr size_t OFF_VBF = 52 * MBy;
constexpr size_t OFF_PB = 84 * MBy;
constexpr size_t OFF_H = 100 * MBy;
constexpr size_t OFF_QNA = 164 * MBy;
constexpr size_t OFF_KNA = 196 * MBy;
constexpr size_t OFF_VNAT = 228 * MBy;
constexpr size_t OFF_CQ = 260 * MBy;
constexpr size_t OFF_CKV = 284 * MBy;
constexpr size_t OFF_KR = 300 * MBy;
constexpr size_t OFF_QM = 304 * MBy;
constexpr size_t OFF_KM = 352 * MBy;
constexpr size_t OFF_VMT = 400 * MBy;
constexpr size_t OFF_MIX = 432 * MBy;
constexpr size_t OFF_QP = 164 * MBy;
constexpr size_t OFF_G = 292 * MBy;
constexpr size_t OFF_IDX = 356 * MBy;
constexpr size_t OFF_GW = 372 * MBy;
constexpr size_t OFF_PA = 164 * MBy;
constexpr size_t OFF_ACT = 388 * MBy;
constexpr size_t OFF_PP = 404 * MBy;
constexpr size_t OFF_Y1 = 164 * MBy;
constexpr size_t OFF_FFN = 164 * MBy;

constexpr int SMEM_BYTES = 131072;

struct Params {
  const float *x, *p, *emb_g, *emb_b, *w_in, *qg, *kvg, *w_uq, *w_ukv, *rpb, *w_o, *ln1g, *ln1b, *w_q, *subk, *pu, *pv,
      *ple_w, *gate_w, *gate_b, *ln2g, *ln2b;
  float* out;
  char* ws;
};

DI int otid() { int t = (int)threadIdx.x; asm volatile("" : "+v"(t)); return t; }
DI unsigned short f2bf(float x) {
  unsigned u = __float_as_uint(x);
  u += 0x7fffu + ((u >> 16) & 1u);
  return (unsigned short)(u >> 16);
}
DI float bf2f(unsigned short b) { return __uint_as_float(((unsigned)b) << 16); }
DI unsigned pack2(float lo, float hi) { return (unsigned)f2bf(lo) | ((unsigned)f2bf(hi) << 16); }
DI float bflo(unsigned u) { return __uint_as_float(u << 16); }
DI float bfhi(unsigned u) { return __uint_as_float(u & 0xffff0000u); }
DI float wave_sum(float v) {
#pragma unroll
  for (int m = 32; m >= 1; m >>= 1) v += __shfl_xor(v, m);
  return v;
}
DI float wave_max(float v) {
#pragma unroll
  for (int m = 32; m >= 1; m >>= 1) v = fmaxf(v, __shfl_xor(v, m));
  return v;
}
DI float fast_exp2(float x) { return __builtin_amdgcn_exp2f(x); }
DI int pi_swap23(int r) { return (r & ~12) | ((r & 4) << 1) | ((r & 8) >> 1); }

DI void transpose_cvt(const float* __restrict__ in, int ldn, int col0, int ncols, bf16_t* __restrict__ out, int K,
                      const float* __restrict__ g, char* smem, int bid, int nblk) {
  float* tile = (float*)smem;
  const int tk = K >> 6, tn = (ncols + 63) >> 6;
  const int tid = otid();
  const int lr = tid >> 3, lc = (tid & 7) * 8;
  auto ld = [&](int t, f32x4& v0, f32x4& v1) {
    v0 = f32x4{0.f, 0.f, 0.f, 0.f}; v1 = f32x4{0.f, 0.f, 0.f, 0.f};
    if (t < tk * tn) {
      const int k0 = (t / tn) << 6, n0 = (t % tn) << 6;
      if (n0 + lc + 8 <= ncols) {
        const float* src = in + (size_t)(k0 + lr) * ldn + col0 + n0 + lc;
        v0 = *(const f32x4*)src;
        v1 = *(const f32x4*)(src + 4);
      }
      if (g) { const float gg = g[k0 + lr]; v0 *= gg; v1 *= gg; }
    }
  };
  f32x4 v0, v1;
  ld(bid, v0, v1);
  for (int t = bid; t < tk * tn; t += nblk) {
    const int k0 = (t / tn) << 6, n0 = (t % tn) << 6;
    f32x4 w0, w1;
    ld(t + nblk, w0, w1);
    __syncthreads();
#pragma unroll
    for (int j = 0; j < 4; ++j) { tile[lr * 65 + lc + j] = v0[j]; tile[lr * 65 + lc + 4 + j] = v1[j]; }
    __syncthreads();
    if (n0 + lr < ncols) {
      u32x4 o;
#pragma unroll
      for (int j = 0; j < 4; ++j) o[j] = pack2(tile[(lc + 2 * j) * 65 + lr], tile[(lc + 2 * j + 1) * 65 + lr]);
      *(u32x4*)(out + (size_t)(n0 + lr) * K + k0 + lc) = o;
    }
    v0 = w0; v1 = w1;
  }
}

DI void straight_cvt(const float* __restrict__ in, bf16_t* __restrict__ out, size_t n, int bid, int nblk) {
  const size_t n4 = n >> 2;
  for (size_t i = (size_t)bid * NT + otid(); i < n4; i += (size_t)nblk * NT) {
    const f32x4 v = *(const f32x4*)(in + i * 4);
    u32x2 o;
    o[0] = pack2(v[0], v[1]);
    o[1] = pack2(v[2], v[3]);
    *(u32x2*)(out + i * 4) = o;
  }
}

DI void ln_rows16(float (&v)[16], const float* __restrict__ gam, const float* __restrict__ bet, int lane) {
  float s = 0.f;
#pragma unroll
  for (int i = 0; i < 16; ++i) s += v[i];
  const float mu = wave_sum(s) * (1.f / 1024.f);
  float q = 0.f;
#pragma unroll
  for (int i = 0; i < 16; ++i) {
    v[i] -= mu;
    q += v[i] * v[i];
  }
  const float rstd = rsqrtf(wave_sum(q) * (1.f / 1024.f) + LN_EPS);
#pragma unroll
  for (int g = 0; g < 4; ++g) {
    const f32x4 gg = *(const f32x4*)(gam + g * 256 + lane * 4);
    const f32x4 bb = *(const f32x4*)(bet + g * 256 + lane * 4);
#pragma unroll
    for (int c = 0; c < 4; ++c) v[g * 4 + c] = v[g * 4 + c] * rstd * gg[c] + bb[c];
  }
}

DI void cvt_table_fp8(const float* __restrict__ in, unsigned char* __restrict__ out8, float* __restrict__ inv_scale, int bid, int nblk) {
  const int lane = otid() & 63, w = otid() >> 6;
  for (int e = bid * NW + w; e < 16384; e += nblk * NW) {
    f32x4 v[4];
    float mx = 0.f;
#pragma unroll
    for (int g = 0; g < 4; ++g) {
      v[g] = *(const f32x4*)(in + (size_t)e * 1024 + g * 256 + lane * 4);
#pragma unroll
      for (int c = 0; c < 4; ++c) mx = fmaxf(mx, fabsf(v[g][c]));
    }
    mx = fmaxf(wave_max(mx), 1e-30f);
    const float sc = 440.f / mx;
#pragma unroll
    for (int g = 0; g < 4; ++g) {
      int p = 0;
      p = __builtin_amdgcn_cvt_pk_fp8_f32(v[g][0] * sc, v[g][1] * sc, p, false);
      p = __builtin_amdgcn_cvt_pk_fp8_f32(v[g][2] * sc, v[g][3] * sc, p, true);
      const int j = 2 * g + (lane >> 5), c = (lane & 31) * 4;
      *(int*)(out8 + (size_t)j * SLICE_BYTES + (size_t)e * 128 + c) = p;
    }
    if (lane == 0) inv_scale[e] = mx * (1.f / 440.f);
  }
}

#ifndef P0_TB
#define P0_TB 32
#endif
DI void phase0(const Params& P, char* smem) {
  char* ws = P.ws;
  const int ntb = ((int)gridDim.x > 2 * P0_TB) ? P0_TB : 0;
  if (ntb == 0 || (int)blockIdx.x < ntb) {
    const int bid = (int)blockIdx.x, nb = ntb ? ntb : (int)gridDim.x;
    bf16_t* wina = (bf16_t*)(ws + OFF_WINA);
    transpose_cvt(P.w_in, 2208, 0, 1024, wina, 1024, nullptr, smem, bid, nb);
    transpose_cvt(P.w_in, 2208, 1536, 672, wina + (size_t)1024 * 1024, 1024, nullptr, smem, bid, nb);
    for (int i = bid * NT + otid(); i < 96 * 1024 / 2; i += nb * NT)
      ((unsigned*)(wina + (size_t)1696 * 1024))[i] = 0u;
    transpose_cvt(P.w_in, 2208, 1024, 512, (bf16_t*)(ws + OFF_WINV), 1024, nullptr, smem, bid, nb);
    transpose_cvt(P.w_uq, 768, 0, 768, (bf16_t*)(ws + OFF_WUQT), 384, P.qg, smem, bid, nb);
    for (int h = 0; h < 8; ++h) {
      transpose_cvt(P.w_ukv, 1024, h * 128, 64, (bf16_t*)(ws + OFF_WUKT) + (size_t)h * 64 * 256, 256, P.kvg, smem, bid, nb);
      transpose_cvt(P.w_ukv, 1024, h * 128 + 64, 64, (bf16_t*)(ws + OFF_WUVT) + (size_t)h * 64 * 256, 256, P.kvg, smem, bid, nb);
    }
    transpose_cvt(P.w_o, 1024, 0, 1024, (bf16_t*)(ws + OFF_WOT), 1024, nullptr, smem, bid, nb);
    transpose_cvt(P.w_q, 2048, 0, 2048, (bf16_t*)(ws + OFF_WQT), 1024, nullptr, smem, bid, nb);
    transpose_cvt(P.ple_w, 1024, 0, 1024, (bf16_t*)(ws + OFF_PLEWT), 256, nullptr, smem, bid, nb);
    transpose_cvt(P.gate_w, 1024, 0, 1024, (bf16_t*)(ws + OFF_GATEWT), 1024, nullptr, smem, bid, nb);
    straight_cvt(P.subk, (bf16_t*)(ws + OFF_SUBK), 2 * 128 * 128, bid, nb);
    float* rope = (float*)(ws + OFF_ROPE);
    for (int i = bid * NT + otid(); i < 2048 * 16; i += nb * NT) {
      const int s = i >> 4, j = i & 15;
      const float inv = powf(10000.f, -(float)(2 * (j & 7)) / 16.f);
      const float pos = (j < 8) ? (float)(s >> 6) : (float)(s & 63);
      const float ang = pos * inv;
      rope[s * 32 + j] = cosf(ang);
      rope[s * 32 + 16 + j] = sinf(ang);
    }
  }
  if (ntb == 0 || (int)blockIdx.x >= ntb) {
    const int bid = (int)blockIdx.x - ntb, nb = (int)gridDim.x - ntb;
    cvt_table_fp8(P.pu, (unsigned char*)(ws + OFF_UBF), (float*)(ws + OFF_SU), bid, nb);
    cvt_table_fp8(P.pv, (unsigned char*)(ws + OFF_VBF), (float*)(ws + OFF_SV), bid, nb);
    straight_cvt(P.p, (bf16_t*)(ws + OFF_PB), (size_t)NTOK * 256, bid, nb);
    const int lane = otid() & 63, w = otid() >> 6;
    bf16_t* h0 = (bf16_t*)(ws + OFF_H);
    for (int tok = bid * NW + w; tok < NTOK; tok += nb * NW) {
      float v[16];
#pragma unroll
      for (int g = 0; g < 4; ++g) {
        const f32x4 t = *(const f32x4*)(P.x + (size_t)tok * 1024 + g * 256 + lane * 4);
#pragma unroll
        for (int c = 0; c < 4; ++c) v[g * 4 + c] = t[c];
      }
      ln_rows16(v, P.emb_g, P.emb_b, lane);
#pragma unroll
      for (int g = 0; g < 4; ++g) {
        u32x2 o;
        o[0] = pack2(v[g * 4 + 0], v[g * 4 + 1]);
        o[1] = pack2(v[g * 4 + 2], v[g * 4 + 3]);
        *(u32x2*)(h0 + (size_t)tok * 1024 + g * 256 + lane * 4) = o;
      }
    }
  }
}

namespace pg8 {
#define PG8_LAS __attribute__((address_space(3)))
typedef unsigned short bf16_t;
typedef short bf16x8 __attribute__((ext_vector_type(8)));
typedef float f32x4 __attribute__((ext_vector_type(4)));
typedef unsigned u32x4 __attribute__((ext_vector_type(4)));
constexpr int BM = 256, BK = 64, HALF = 128, HTB = HALF * BK * 2  , STAGE_BYTES = 8 * HTB, NXCD = 8, WGM = 8;

__host__ __device__ __forceinline__ int lds_byte(int r, int c) { const int st = (r >> 4) * 2 + (c >> 5), rr = r & 15, cc = c & 31, ob = rr * 64 + cc * 2; return st * 1024 + (ob ^ (((ob >> 9) & 1) << 5)); }
__host__ __device__ __forceinline__ void stage_rc(int b, int& R, int& C) { const int st = b / 1024, sb = b % 1024, swz = sb ^ (((sb >> 9) & 1) << 5); R = (st >> 1) * 16 + swz / 64; C = (st & 1) * 32 + (swz % 64) / 2; }
__host__ __device__ __forceinline__ int perm32(int rho) { const int n = rho >> 4, i = rho & 15; return 8 * (i >> 2) + 4 * n + (i & 3); }
struct Unit { int pm, pn; };
struct Gemm { const bf16_t* A; const bf16_t* Bt; int M, N, K; };
struct StaticOrder {
    int nM, nN, nwg, G, c;
    __host__ __device__ void init(int M, int N, int G_, int c_) { nM = M / BM; nN = N / BM; nwg = nM * nN; G = G_; c = c_; }
    __host__ __device__ bool next(int i, Unit& u) const {
        const long L = (long)i * G + c; if (L >= nwg) return false;
        int wgid = (int)L; { const int q = nwg / NXCD, r = nwg % NXCD, xcd = wgid % NXCD, off = wgid / NXCD; wgid = (xcd < r ? xcd * (q + 1) : r * (q + 1) + (xcd - r) * q) + off; }
        const int nig = WGM * nN, gid = wgid / nig, fm = gid * WGM, gsz = (nM - fm) < WGM ? (nM - fm) : WGM;
        u.pm = fm + ((wgid % nig) % gsz); u.pn = (wgid % nig) / gsz; return true;
    }
    __device__ __forceinline__ void a_ready(const Unit&) const {}
    __device__ __forceinline__ void done(const Unit&) const {}
};
__device__ __forceinline__ unsigned cvt_pk_bf16(float lo, float hi) { unsigned r; asm volatile("v_cvt_pk_bf16_f32 %0, %1, %2" : "=v"(r) : "v"(lo), "v"(hi)); return r; }
template <class Epi, class Sched, bool STAMP = false>
__device__ __forceinline__ void gemm_phase(PG8_LAS unsigned char* lds, const Gemm g, const Sched& S, const Epi& E, unsigned long long* stamps) {
    const int tid = otid(), wid = __builtin_amdgcn_readfirstlane(tid >> 6), lane = tid & 63, wr = wid >> 2, wc = wid & 3, fr = lane & 15, fq = lane >> 4;
    const int K = g.K, nt = K / BK;
    int ts_lo = 0, ts_hi = 0, nts = 0; const unsigned long long rt_entry = STAMP ? (unsigned long long)wall_clock64() : 0ull;
#define PG8_STAMP() do { if (STAMP && wid == 0 && nts < 64) { const unsigned long long _c = (unsigned long long)clock64(); \
        ts_lo = (lane == nts) ? (int)(unsigned)_c : ts_lo; ts_hi = (lane == nts) ? (int)(unsigned)(_c >> 32) : ts_hi; ++nts; } } while (0)
    PG8_STAMP();
    unsigned voffA[2], voffB[2];
#pragma unroll
    for (int i = 0; i < 2; ++i) { int R, C; stage_rc(tid * 16 + i * 8192, R, C); const int Rb = Epi::PERM ? ((R & ~31) + perm32(R & 31)) : R;
        voffA[i] = (unsigned)(R * K + C) * 2u; voffB[i] = (unsigned)(Rb * K + C) * 2u; }
    const size_t kstep = (size_t)(BK * 2);
    const size_t hstep = (size_t)HALF * K * 2;
    const size_t tstep = 2 * hstep;
    const unsigned ldsw = (unsigned)wid * 1024u;
    const int aoff = lds_byte(wr * 64 + fr, fq * 8), boff = lds_byte(wc * 32 + fr, fq * 8);
#define PG8_SA(b, h) (((b) * 2 + (h)) * HTB)
#define PG8_SB(b, h) ((4 + (b) * 2 + (h)) * HTB)
#define PG8_STAGE(bufoff, gbase, voff) do { _Pragma("unroll") for (int _i = 0; _i < 2; ++_i) \
        __builtin_amdgcn_global_load_lds((const unsigned*)((const char*)(gbase) + (voff)[_i]), (PG8_LAS unsigned*)(lds + (bufoff) + ldsw + _i * 8192), 16, 0, 0); } while (0)
#define PG8_LDA(dst, b, h) do { _Pragma("unroll") for (int m = 0; m < 4; ++m) _Pragma("unroll") for (int k = 0; k < 2; ++k) dst[m][k] = *(const PG8_LAS bf16x8*)(lds + PG8_SA(b, h) + aoff + m * 2048 + k * 1024); } while (0)
#define PG8_LDB(dst, b, h) do { _Pragma("unroll") for (int n = 0; n < 2; ++n) _Pragma("unroll") for (int k = 0; k < 2; ++k) dst[n][k] = *(const PG8_LAS bf16x8*)(lds + PG8_SB(b, h) + boff + n * 2048 + k * 1024); } while (0)
#define PG8_MMA(ai, bj, At, Bt) do { __builtin_amdgcn_s_setprio(1); _Pragma("unroll") for (int m = 0; m < 4; ++m) _Pragma("unroll") for (int n = 0; n < 2; ++n) _Pragma("unroll") for (int k = 0; k < 2; ++k) \
        acc[ai][bj][m][n] = __builtin_amdgcn_mfma_f32_16x16x32_bf16(Bt[n][k], At[m][k], acc[ai][bj][m][n], 0, 0, 0); __builtin_amdgcn_s_setprio(0); } while (0)
#define PG8_WAIT_V(n) asm volatile("s_waitcnt vmcnt(" #n ")" ::: "memory")
#define PG8_WAIT_L(n) asm volatile("s_waitcnt lgkmcnt(" #n ")" ::: "memory")
#define PG8_BAR __builtin_amdgcn_s_barrier()
#define PG8_SCHED __builtin_amdgcn_sched_barrier(0)
    Unit cur, nxt; int ui = 0;
    if (!S.next(0, cur)) return;
    f32x4 acc[2][2][4][2];
#pragma unroll
    for (int a = 0; a < 2; ++a)
#pragma unroll
        for (int b = 0; b < 2; ++b)
#pragma unroll
            for (int m = 0; m < 4; ++m)
#pragma unroll
                for (int n = 0; n < 2; ++n) acc[a][b][m][n] = (f32x4){0.f, 0.f, 0.f, 0.f};
    bf16x8 At[4][2], B0[2][2], B1[2][2];
    const char* cA = (const char*)g.A + (size_t)cur.pm * tstep; const char* cB = (const char*)g.Bt + (size_t)cur.pn * tstep;
    S.a_ready(cur);
    PG8_STAGE(PG8_SB(0, 0), cB, voffB); PG8_STAGE(PG8_SA(0, 0), cA, voffA); PG8_STAGE(PG8_SB(0, 1), cB + hstep, voffB); PG8_STAGE(PG8_SA(0, 1), cA + hstep, voffA);
    if (wr == 1) PG8_BAR;
    PG8_WAIT_V(4); PG8_BAR;
    PG8_STAGE(PG8_SB(1, 0), cB + kstep, voffB); PG8_STAGE(PG8_SA(1, 0), cA + kstep, voffA); PG8_STAGE(PG8_SB(1, 1), cB + hstep + kstep, voffB);
    PG8_WAIT_V(6); PG8_BAR;
    PG8_STAMP();
    for (;;) {
        const bool has_next = S.next(ui + 1, nxt);
        const char* nA = has_next ? (const char*)g.A + (size_t)nxt.pm * tstep : cA; const char* nB = has_next ? (const char*)g.Bt + (size_t)nxt.pn * tstep : cB;
#pragma unroll 1
        for (int t = 0; t < nt; t += 2) {
            const bool last = (t == nt - 2);
            const char* a1 = cA + (size_t)(t + 1) * kstep;
            const char* a2 = last ? nA : cA + (size_t)(t + 2) * kstep; const char* b2 = last ? nB : cB + (size_t)(t + 2) * kstep;
            const char* a3 = a2 + kstep; const char* b3 = b2 + kstep;
            if (last && has_next) S.a_ready(nxt);
            PG8_LDB(B0, 0, 0); PG8_SCHED; PG8_LDA(At, 0, 0); PG8_STAGE(PG8_SA(1, 1), a1 + hstep, voffA);
            PG8_WAIT_L(8); PG8_BAR; PG8_WAIT_L(0); PG8_MMA(0, 0, At, B0); PG8_BAR; PG8_SCHED;
            PG8_LDB(B1, 0, 1); PG8_STAGE(PG8_SB(0, 0), b2, voffB);
            PG8_BAR; PG8_WAIT_L(0); PG8_MMA(0, 1, At, B1); PG8_BAR;
            PG8_LDA(At, 0, 1); PG8_STAGE(PG8_SA(0, 0), a2, voffA);
            PG8_BAR; PG8_WAIT_L(0); PG8_MMA(1, 0, At, B0); PG8_BAR; PG8_SCHED;
            PG8_STAGE(PG8_SB(0, 1), b2 + hstep, voffB);
            PG8_WAIT_V(6); PG8_BAR; PG8_MMA(1, 1, At, B1); PG8_BAR;
            PG8_LDB(B0, 1, 0); PG8_SCHED; PG8_LDA(At, 1, 0); PG8_STAGE(PG8_SA(0, 1), a2 + hstep, voffA);
            PG8_WAIT_L(8); PG8_BAR; PG8_WAIT_L(0); PG8_MMA(0, 0, At, B0); PG8_BAR; PG8_SCHED;
            PG8_LDB(B1, 1, 1); PG8_STAGE(PG8_SB(1, 0), b3, voffB);
            PG8_BAR; PG8_WAIT_L(0); PG8_MMA(0, 1, At, B1); PG8_BAR;
            PG8_LDA(At, 1, 1); PG8_STAGE(PG8_SA(1, 0), a3, voffA);
            PG8_BAR; PG8_WAIT_L(0); PG8_MMA(1, 0, At, B0); PG8_BAR; PG8_SCHED;
            PG8_STAGE(PG8_SB(1, 1), b3 + hstep, voffB);
            PG8_WAIT_V(6); PG8_BAR; PG8_MMA(1, 1, At, B1); PG8_BAR;
        }
        PG8_STAMP();
        if constexpr (!Epi::AFTER_DRAIN) { E(acc, cur, wr, wc, fr, fq); S.done(cur); }
        PG8_STAMP();
        if (!has_next) break;
#pragma unroll
        for (int a = 0; a < 2; ++a)
#pragma unroll
            for (int b = 0; b < 2; ++b)
#pragma unroll
                for (int m = 0; m < 4; ++m)
#pragma unroll
                    for (int n = 0; n < 2; ++n) acc[a][b][m][n] = (f32x4){0.f, 0.f, 0.f, 0.f};
        cur = nxt; cA = nA; cB = nB; ++ui;
    }
    PG8_WAIT_V(0);
    if (wr == 0) PG8_BAR;
    PG8_BAR;
    if constexpr (Epi::AFTER_DRAIN) { E.fused(acc, cur, wr, wc, fr, fq, lds, wid, lane); S.done(cur); }
    PG8_STAMP();
    if (STAMP && wid == 0) { stamps[lane] = lane < nts ? (((unsigned long long)(unsigned)ts_hi << 32) | (unsigned)ts_lo) : 0ull;
        if (lane == 62) stamps[62] = rt_entry; if (lane == 63) stamps[63] = (unsigned long long)wall_clock64(); }
#undef PG8_STAMP
#undef PG8_SA
#undef PG8_SB
#undef PG8_STAGE
#undef PG8_LDA
#undef PG8_LDB
#undef PG8_MMA
#undef PG8_WAIT_V
#undef PG8_WAIT_L
#undef PG8_BAR
#undef PG8_SCHED
}
}
using pg8::Unit;
using pg8::cvt_pk_bf16;
DI unsigned cvt_pk_bf16_t(float lo, float hi) { unsigned r; asm volatile("s_nop 1\n\tv_cvt_pk_bf16_f32 %0, %1, %2" : "=v"(r) : "v"(lo), "v"(hi)); return r; }
DI u32x4 pack8_t(const f32x4& a, const f32x4& b) {
  u32x4 o;
  o[0] = cvt_pk_bf16_t(a[0], a[1]);
  o[1] = cvt_pk_bf16_t(a[2], a[3]);
  o[2] = cvt_pk_bf16_t(b[0], b[1]);
  o[3] = cvt_pk_bf16_t(b[2], b[3]);
  return o;
}
#define LAS __attribute__((address_space(3)))

DI u32x4 pack8(const f32x4& a, const f32x4& b) {
  u32x4 o;
  o[0] = cvt_pk_bf16(a[0], a[1]);
  o[1] = cvt_pk_bf16(a[2], a[3]);
  o[2] = cvt_pk_bf16(b[0], b[1]);
  o[3] = cvt_pk_bf16(b[2], b[3]);
  return o;
}

#define EPI_HEAD static constexpr bool PERM = true, AFTER_DRAIN = false;
#define EPI_ARGS const f32x4 (&acc)[2][2][4][2], const Unit& u, int wr, int wc, int fr, int fq
#define EPI_FOR_BJ _Pragma("unroll") for (int bj = 0; bj < 2; ++bj)
#define EPI_FOR_ROWS _Pragma("unroll") for (int ai = 0; ai < 2; ++ai) _Pragma("unroll") for (int m = 0; m < 4; ++m)
#define EPI_ROW (u.pm * 256 + ai * 128 + wr * 64 + m * 16 + fr)
#define EPI_C0 (u.pn * 256 + bj * 128 + wc * 32 + 8 * fq)

#define EPI_RO (ai * 128 + m * 16)
struct EpiInMain {
  EPI_HEAD
  bf16_t *qna, *kna, *cq, *ckv;
  float* kr;
  DI void operator()(EPI_ARGS) const {
    const int rowb = u.pm * 256 + wr * 64 + fr, bb = rowb >> 11, s0 = rowb & 2047;
    EPI_FOR_BJ {
      const int c0 = EPI_C0;
      if (c0 < 1024) {
        const float sc = c0 < 512 ? QNA_SCALE : 1.f;
        const int cc = c0 & 511, h = cc >> 6, d = cc & 63;
        bf16_t* base = (c0 < 512 ? qna : kna) + ((size_t)(bb * 8 + h) * 2048 + s0) * 64 + d;
        EPI_FOR_ROWS { *(u32x4*)(base + EPI_RO * 64) = pack8(acc[ai][bj][m][0] * sc, acc[ai][bj][m][1] * sc); }
      } else if (c0 < 1408) {
        bf16_t* base = cq + (size_t)rowb * 384 + (c0 - 1024);
        EPI_FOR_ROWS { *(u32x4*)(base + EPI_RO * 384) = pack8(acc[ai][bj][m][0], acc[ai][bj][m][1]); }
      } else if (c0 < 1664) {
        bf16_t* base = ckv + (size_t)rowb * 256 + (c0 - 1408);
        EPI_FOR_ROWS { *(u32x4*)(base + EPI_RO * 256) = pack8(acc[ai][bj][m][0], acc[ai][bj][m][1]); }
      } else if (c0 < 1696) {
        float* base = kr + (size_t)rowb * 32 + (c0 - 1664);
        EPI_FOR_ROWS {
          *(f32x4*)(base + EPI_RO * 32) = acc[ai][bj][m][0];
          *(f32x4*)(base + EPI_RO * 32 + 4) = acc[ai][bj][m][1];
        }
      }
    }
  }
};
struct EpiVT {
  EPI_HEAD
  bf16_t* out;
  int rowblocked;
  DI void operator()(EPI_ARGS) const {
    const int rowb = u.pm * 256 + wr * 64 + fr;
    EPI_FOR_BJ {
      const int c0 = EPI_C0, b = c0 >> 11, s = c0 & 2047;
      if (rowblocked) {
        EPI_FOR_ROWS {
          const int row = rowb + EPI_RO, hh_ = row >> 6, dv = row & 63;
          *(u32x4*)(out + (((size_t)(b * 8 + hh_) * 32 + (s >> 6)) * 64 + dv) * 64 + (s & 63)) = pack8(acc[ai][bj][m][0], acc[ai][bj][m][1]);
        }
      } else {
        bf16_t* base = out + ((size_t)(b * 512 + rowb)) * 2048 + s;
        EPI_FOR_ROWS { *(u32x4*)(base + EPI_RO * 2048) = pack8(acc[ai][bj][m][0], acc[ai][bj][m][1]); }
      }
    }
  }
};
struct EpiUpQ {
  EPI_HEAD
  bf16_t* qm;
  DI void operator()(EPI_ARGS) const {
    const int rowb = u.pm * 256 + wr * 64 + fr, bb = rowb >> 11, s0 = rowb & 2047;
    EPI_FOR_BJ {
      const int c0 = EPI_C0, hd = c0 / 96, d0 = c0 - hd * 96;
      bf16_t* base = qm + ((size_t)(bb * 8 + hd) * 2048 + s0) * 96 + d0;
      EPI_FOR_ROWS { *(u32x4*)(base + EPI_RO * 96) = pack8(acc[ai][bj][m][0] * QM_SCALE, acc[ai][bj][m][1] * QM_SCALE); }
    }
  }
};
struct EpiUpK {
  EPI_HEAD
  bf16_t* km;
  DI void operator()(EPI_ARGS) const {
    const int rowb = u.pm * 256 + wr * 64 + fr, bb = rowb >> 11, s0 = rowb & 2047;
    EPI_FOR_BJ {
      const int c0 = EPI_C0, hd = c0 >> 6, d = c0 & 63;
      bf16_t* base = km + ((size_t)(bb * 8 + hd) * 2048 + s0) * 96 + d;
      EPI_FOR_ROWS { *(u32x4*)(base + EPI_RO * 96) = pack8(acc[ai][bj][m][0], acc[ai][bj][m][1]); }
    }
  }
};
struct EpiWo {
  EPI_HEAD
  bf16_t* y1;
  DI void operator()(EPI_ARGS) const {
    const int rowb = u.pm * 256 + wr * 64 + fr;
    EPI_FOR_BJ {
      bf16_t* yb = y1 + (size_t)rowb * 1024 + EPI_C0;
      EPI_FOR_ROWS { *(u32x4*)(yb + EPI_RO * 1024) = pack8(acc[ai][bj][m][0], acc[ai][bj][m][1]); }
    }
  }
};
struct EpiGateQ {
  EPI_HEAD
  const float LAS* gbl;
  bf16_t* G;
  bf16_t* qp;
  DI void operator()(EPI_ARGS) const {
    const int rowb = u.pm * 256 + wr * 64 + fr;
    if (u.pn < 4) {
      EPI_FOR_BJ {
        const int c0 = EPI_C0;
        const f32x4 b0 = *(const f32x4 LAS*)(gbl + c0), b1 = *(const f32x4 LAS*)(gbl + c0 + 4);
        bf16_t* base = G + (size_t)rowb * 1024 + c0;
        EPI_FOR_ROWS {
          f32x4 a = acc[ai][bj][m][0] + b0, c = acc[ai][bj][m][1] + b1;
#pragma unroll
          for (int q = 0; q < 4; ++q) {
            a[q] = __builtin_amdgcn_rcpf(1.f + fast_exp2(-LOG2E * a[q]));
            c[q] = __builtin_amdgcn_rcpf(1.f + fast_exp2(-LOG2E * c[q]));
          }
          *(u32x4*)(base + EPI_RO * 1024) = pack8_t(a, c);
        }
      }
    } else {
      EPI_FOR_BJ {
        bf16_t* base = qp + (size_t)rowb * 2048 + (EPI_C0 - 1024);
        EPI_FOR_ROWS { *(u32x4*)(base + EPI_RO * 2048) = pack8(acc[ai][bj][m][0], acc[ai][bj][m][1]); }
      }
    }
  }
};
struct EpiPle {
  EPI_HEAD
  bf16_t* pp;
  DI void operator()(EPI_ARGS) const {
    const int rowb = u.pm * 256 + wr * 64 + fr;
    EPI_FOR_BJ {
      bf16_t* base = pp + (size_t)rowb * 1024 + EPI_C0;
      EPI_FOR_ROWS { *(u32x4*)(base + EPI_RO * 1024) = pack8(acc[ai][bj][m][0], acc[ai][bj][m][1]); }
    }
  }
};

struct OneUnit {
  pg8::Unit u; bool ok;
  DI bool next(int i, pg8::Unit& o) const { if (i == 0 && ok) { o = u; return true; } return false; }
  DI void a_ready(const pg8::Unit&) const {}
  DI void done(const pg8::Unit&) const {}
};
template <class Epi>
DI void run_gemm(const bf16_t* A, const bf16_t* Bt, int M, int N, int K, char* smem, const Epi& e) {
  pg8::Gemm g{A, Bt, M, N, K};
  pg8::StaticOrder S;
  S.init(M, N, (int)gridDim.x, (int)blockIdx.x);
#ifdef ONE_UNIT_PER_CALL
  for (int i = 0;; ++i) {
    OneUnit o;
    o.ok = S.next(i, o.u);
    if (!o.ok) break;
    pg8::gemm_phase<Epi, OneUnit, false>((LAS unsigned char*)smem, g, o, e, nullptr);
  }
#else
  pg8::gemm_phase<Epi, pg8::StaticOrder, false>((LAS unsigned char*)smem, g, S, e, nullptr);
#endif
}

DI void phase_stats(const Params& P) {
  char* ws = P.ws;
  bf16_t* cq = (bf16_t*)(ws + OFF_CQ);
  bf16_t* ckv = (bf16_t*)(ws + OFF_CKV);
  const float* kr = (const float*)(ws + OFF_KR);
  const float* rope = (const float*)(ws + OFF_ROPE);
  bf16_t* km = (bf16_t*)(ws + OFF_KM);
  const int lane = otid() & 63, w = otid() >> 6;
  const int stride = gridDim.x * NW;
  for (int tok0 = blockIdx.x * NW + w; tok0 < NTOK; tok0 += 4 * stride) {
    unsigned qv[4][3], kv[4][2];
    float x1[4], x2[4], cs[4], sn[4];
#pragma unroll
    for (int u = 0; u < 4; ++u) {
      const int tok = tok0 + u * stride;
      if (tok < NTOK) {
        const unsigned* q32 = (const unsigned*)(cq + (size_t)tok * 384);
        const unsigned* k32 = (const unsigned*)(ckv + (size_t)tok * 256);
#pragma unroll
        for (int i = 0; i < 3; ++i) qv[u][i] = q32[i * 64 + lane];
#pragma unroll
        for (int i = 0; i < 2; ++i) kv[u][i] = k32[i * 64 + lane];
        if (lane < 16) {
          const int s = tok & 2047;
          x1[u] = kr[(size_t)tok * 32 + 2 * lane]; x2[u] = kr[(size_t)tok * 32 + 2 * lane + 1];
          cs[u] = rope[s * 32 + lane]; sn[u] = rope[s * 32 + 16 + lane];
        }
      }
    }
#pragma unroll
    for (int u = 0; u < 4; ++u) {
      const int tok = tok0 + u * stride;
      if (tok < NTOK) {
        unsigned* q32 = (unsigned*)(cq + (size_t)tok * 384);
        unsigned* k32 = (unsigned*)(ckv + (size_t)tok * 256);
        float s1 = 0.f, s2 = 0.f;
#pragma unroll
        for (int i = 0; i < 3; ++i) { const float a = bflo(qv[u][i]), b = bfhi(qv[u][i]); s1 += a * a + b * b; }
#pragma unroll
        for (int i = 0; i < 2; ++i) { const float a = bflo(kv[u][i]), b = bfhi(kv[u][i]); s2 += a * a + b * b; }
        const float r1 = rsqrtf(wave_sum(s1) * (1.f / 384.f) + LN_EPS);
        const float r2 = rsqrtf(wave_sum(s2) * (1.f / 256.f) + LN_EPS);
#pragma unroll
        for (int i = 0; i < 3; ++i) q32[i * 64 + lane] = cvt_pk_bf16(bflo(qv[u][i]) * r1, bfhi(qv[u][i]) * r1);
#pragma unroll
        for (int i = 0; i < 2; ++i) k32[i * 64 + lane] = cvt_pk_bf16(bflo(kv[u][i]) * r2, bfhi(kv[u][i]) * r2);
        if (lane < 16) {
          const int b = tok >> 11, s = tok & 2047;
          const unsigned o = cvt_pk_bf16(x1[u] * cs[u] - x2[u] * sn[u], x1[u] * sn[u] + x2[u] * cs[u]);
#pragma unroll
          for (int h = 0; h < 8; ++h) *(unsigned*)(km + ((size_t)(b * 8 + h) * 2048 + s) * 96 + 64 + 2 * lane) = o;
        }
      }
    }
  }
}

DI bf16x8 pack8s(const f32x16& x, int base) {
  u32x4 p;
  asm volatile("s_nop 1\n\tv_cvt_pk_bf16_f32 %0, %4, %5\n\tv_cvt_pk_bf16_f32 %1, %6, %7\n\tv_cvt_pk_bf16_f32 %2, %8, %9\n\tv_cvt_pk_bf16_f32 %3, %10, %11"
               : "=&v"(p[0]), "=&v"(p[1]), "=&v"(p[2]), "=&v"(p[3])
               : "v"(x[base + 0]), "v"(x[base + 1]), "v"(x[base + 2]), "v"(x[base + 3]), "v"(x[base + 4]), "v"(x[base + 5]), "v"(x[base + 6]), "v"(x[base + 7]));
  return __builtin_bit_cast(bf16x8, p);
}

DI void softmax_step(f32x16 (&sacc)[2], float& m, float& l, f32x16 (&oacc)[2], bf16x8 (&pf)[4], bool first) {
  float mx = sacc[0][0];
#pragma unroll
  for (int e = 1; e < 16; ++e) mx = fmaxf(mx, sacc[0][e]);
#pragma unroll
  for (int e = 0; e < 16; ++e) mx = fmaxf(mx, sacc[1][e]);
  mx = fmaxf(mx, __shfl_xor(mx, 32));
  if (first || __builtin_amdgcn_ballot_w64(mx > 8.f) != 0ull) {
    const float d = first ? mx : fmaxf(mx, 0.f);
    const float alpha = first ? 0.f : fast_exp2(-d);
    m += d;
    l *= alpha;
#pragma unroll
    for (int t = 0; t < 2; ++t)
#pragma unroll
      for (int e = 0; e < 16; ++e) { oacc[t][e] *= alpha; sacc[t][e] -= d; }
  }
  f32x2 ps2 = {0.f, 0.f};
#pragma unroll
  for (int t = 0; t < 2; ++t)
#pragma unroll
    for (int e = 0; e < 16; e += 2) {
      f32x2 pp;
      pp[0] = fast_exp2(sacc[t][e]);
      pp[1] = fast_exp2(sacc[t][e + 1]);
      sacc[t][e] = pp[0];
      sacc[t][e + 1] = pp[1];
      ps2 += pp;
    }
  l += ps2[0] + ps2[1];
  pf[0] = pack8s(sacc[0], 0);
  pf[1] = pack8s(sacc[0], 8);
  pf[2] = pack8s(sacc[1], 0);
  pf[3] = pack8s(sacc[1], 8);
}

DI void store_o(const f32x16 (&oacc)[2], float l, bf16_t* dst  , int hh) {
  const float lt = l + __shfl_xor(l, 32);
  const float inv = 1.f / lt;
#pragma unroll
  for (int dt = 0; dt < 2; ++dt)
#pragma unroll
    for (int g = 0; g < 4; ++g) {
      u32x2 o;
      o[0] = cvt_pk_bf16(oacc[dt][4 * g + 0] * inv, oacc[dt][4 * g + 1] * inv);
      o[1] = cvt_pk_bf16(oacc[dt][4 * g + 2] * inv, oacc[dt][4 * g + 3] * inv);
      *(u32x2*)(dst + 32 * dt + 8 * g + 4 * hh) = o;
    }
}

#ifndef NA_U
#define NA_U 2
#endif
template <int SEL>
DI void phase_attn(const Params& P, char* smem) {
  char* ws = P.ws;
  const bf16_t* QNA = (const bf16_t*)(ws + OFF_QNA);
  const bf16_t* KNA = (const bf16_t*)(ws + OFF_KNA);
  const bf16_t* VNAT = (const bf16_t*)(ws + OFF_VNAT);
  const bf16_t* QM = (const bf16_t*)(ws + OFF_QM);
  const bf16_t* KM = (const bf16_t*)(ws + OFF_KM);
  const bf16_t* VMT = (const bf16_t*)(ws + OFF_VMT);
  bf16_t* mix = (bf16_t*)(ws + OFF_MIX);
  const int tid = otid(), lane = tid & 63, w = tid >> 6;
  const int r = lane & 31, hh = lane >> 5;
  const int pr = pi_swap23(r);
  float* bl = (float*)(smem + 45056);
  __syncthreads();
  for (int i = tid; i < 8 * 465; i += NT) bl[i] = P.rpb[i] * LOG2E;
  __syncthreads();
  const int vb = (gridDim.x == 256) ? (int)(((blockIdx.x & 7) << 5) | (blockIdx.x >> 3)) : (int)blockIdx.x;
  if (SEL & 1)
  for (int item = vb * NW + w; item < 16384 / NA_U; item += gridDim.x * NW) {
    const int sub = item % (4 / NA_U), it2 = item / (4 / NA_U);
    const int h = it2 & 7, rr = (it2 >> 3) & 31, b = it2 >> 8;
    const int c = lane & 15, g = lane >> 4;
    const size_t bh = (size_t)(b * 8 + h);
    int rs = rr - 4; rs = rs < 0 ? 0 : (rs > 24 ? 24 : rs);
    const int krow = 8 * (c >> 2) + (c & 3);
    int kb[NA_U], qc[NA_U], cs[NA_U];
    bf16x8 q0[NA_U], q1[NA_U];
    const bf16_t* kp[NA_U];
    const bf16_t* vp[NA_U];
    const bf16_t* vq[NA_U];
    f32x4 oacc[NA_U][4];
    float m[NA_U], l[NA_U];
    bf16x8 kf[NA_U][4], vn[NA_U][4];
#pragma unroll
    for (int u = 0; u < NA_U; ++u) {
      const int qg = sub * NA_U + u;
      kb[u] = (qg == 0) ? 0 : (qg == 1) ? 8 : (qg == 2) ? 24 : 32;
      qc[u] = 16 * qg + c;
      int t = qc[u] - 8; cs[u] = t < 0 ? 0 : (t > 48 ? 48 : t);
      const bf16_t* qp = QNA + (bh * 2048 + rr * 64 + qc[u]) * 64 + 8 * g;
      q0[u] = *(const bf16x8*)qp; q1[u] = *(const bf16x8*)(qp + 32);
      kp[u] = KNA + (bh * 2048 + rs * 64 + kb[u] + krow) * 64 + 8 * g;
      vp[u] = VNAT + ((bh * 32 + rs) * 64 + c) * 64 + kb[u] + 8 * g;
#pragma unroll
      for (int t4 = 0; t4 < 4; ++t4) { oacc[u][t4][0] = 0.f; oacc[u][t4][1] = 0.f; oacc[u][t4][2] = 0.f; oacc[u][t4][3] = 0.f; }
      m[u] = -1e30f; l[u] = 0.f;
#pragma unroll
      for (int t2 = 0; t2 < 2; ++t2)
#pragma unroll
        for (int s2 = 0; s2 < 2; ++s2) kf[u][t2 * 2 + s2] = *(const bf16x8*)(kp[u] + (4 * t2) * 64 + 32 * s2);
      vq[u] = vp[u] + 2048;
      vn[u][0] = *(const bf16x8*)(vp[u]); vn[u][1] = *(const bf16x8*)(vp[u] + 1024);
      vn[u][2] = *(const bf16x8*)(vq[u]); vn[u][3] = *(const bf16x8*)(vq[u] + 1024);
    }
    for (int i = 0; i < 8; ++i) {
      const float* brow = bl + h * 465 + (rs + i - rr + 7) * 31;
#pragma unroll
      for (int u = 0; u < NA_U; ++u) {
        f32x4 sc[2];
#pragma unroll
        for (int t2 = 0; t2 < 2; ++t2) {
          sc[t2][0] = 0.f; sc[t2][1] = 0.f; sc[t2][2] = 0.f; sc[t2][3] = 0.f;
          sc[t2] = __builtin_amdgcn_mfma_f32_16x16x32_bf16(kf[u][t2 * 2], q0[u], sc[t2], 0, 0, 0);
          sc[t2] = __builtin_amdgcn_mfma_f32_16x16x32_bf16(kf[u][t2 * 2 + 1], q1[u], sc[t2], 0, 0, 0);
        }
        if (i < 7) {
          kp[u] += 4096;
#pragma unroll
          for (int t2 = 0; t2 < 2; ++t2)
#pragma unroll
            for (int s2 = 0; s2 < 2; ++s2) kf[u][t2 * 2 + s2] = *(const bf16x8*)(kp[u] + (4 * t2) * 64 + 32 * s2);
        }
        float mx = -INFINITY;
#pragma unroll
        for (int t2 = 0; t2 < 2; ++t2)
#pragma unroll
          for (int e = 0; e < 4; ++e) {
            const int kc = kb[u] + 8 * g + 4 * t2 + e;
            const float pen = ((unsigned)(kc - cs[u]) < 16u) ? 0.f : -INFINITY;
            int dj = kc - qc[u] + 15;
            dj = dj < 0 ? 0 : (dj > 30 ? 30 : dj);
            sc[t2][e] = (sc[t2][e] + brow[dj]) + pen;
            mx = fmaxf(mx, sc[t2][e]);
          }
        mx = fmaxf(mx, __shfl_xor(mx, 16));
        mx = fmaxf(mx, __shfl_xor(mx, 32));
        const float mnew = fmaxf(m[u], mx);
        const float alpha = fast_exp2(m[u] - mnew);
        m[u] = mnew;
#pragma unroll
        for (int t4 = 0; t4 < 4; ++t4) oacc[u][t4] *= alpha;
        float ps = 0.f;
#pragma unroll
        for (int t2 = 0; t2 < 2; ++t2)
#pragma unroll
          for (int e = 0; e < 4; ++e) { sc[t2][e] = fast_exp2(sc[t2][e] - mnew); ps += sc[t2][e]; }
        l[u] = l[u] * alpha + ps;
        u32x4 pu;
        asm volatile("s_nop 1\n\tv_cvt_pk_bf16_f32 %0, %4, %5\n\tv_cvt_pk_bf16_f32 %1, %6, %7\n\tv_cvt_pk_bf16_f32 %2, %8, %9\n\tv_cvt_pk_bf16_f32 %3, %10, %11"
                     : "=&v"(pu[0]), "=&v"(pu[1]), "=&v"(pu[2]), "=&v"(pu[3])
                     : "v"(sc[0][0]), "v"(sc[0][1]), "v"(sc[0][2]), "v"(sc[0][3]), "v"(sc[1][0]), "v"(sc[1][1]), "v"(sc[1][2]), "v"(sc[1][3]));
        const bf16x8 pfr = __builtin_bit_cast(bf16x8, pu);
#pragma unroll
        for (int dvt = 0; dvt < 4; ++dvt) oacc[u][dvt] = __builtin_amdgcn_mfma_f32_16x16x32_bf16(vn[u][dvt], pfr, oacc[u][dvt], 0, 0, 0);
        if (i < 7) {
          vp[u] += 4096; vq[u] += 4096;
          vn[u][0] = *(const bf16x8*)(vp[u]); vn[u][1] = *(const bf16x8*)(vp[u] + 1024);
          vn[u][2] = *(const bf16x8*)(vq[u]); vn[u][3] = *(const bf16x8*)(vq[u] + 1024);
        }
      }
    }
#pragma unroll
    for (int u = 0; u < NA_U; ++u) {
      float lt = l[u] + __shfl_xor(l[u], 16);
      lt += __shfl_xor(lt, 32);
      const float inv = 1.f / lt;
      bf16_t* dst = mix + ((size_t)b * 2048 + rr * 64 + qc[u]) * 1024 + h * 64 + 4 * g;
#pragma unroll
      for (int dvt = 0; dvt < 4; ++dvt) {
        u32x2 o;
        o[0] = cvt_pk_bf16(oacc[u][dvt][0] * inv, oacc[u][dvt][1] * inv);
        o[1] = cvt_pk_bf16(oacc[u][dvt][2] * inv, oacc[u][dvt][3] * inv);
        *(u32x2*)(dst + 16 * dvt) = o;
      }
    }
  }
  bf16_t* Ks = (bf16_t*)smem;
  bf16_t* Vs = (bf16_t*)(smem + 2 * 13312);
  if (SEL & 2)
  for (int it = blockIdx.x; it < 1024; it += gridDim.x) {
    const int item = (gridDim.x == 256) ? (((it & 7) << 7) | (it >> 3)) : it;
    const int bh = item >> 3, qt = item & 7;
    const int b = bh >> 3, h = bh & 7;
    const int q0 = qt * 256 + w * 32;
    bf16x8 qf[6];
#pragma unroll
    for (int s = 0; s < 6; ++s) qf[s] = *(const bf16x8*)(QM + ((size_t)bh * 2048 + q0 + r) * 96 + 16 * s + 8 * hh);
    {
      const float* rp = (const float*)(ws + OFF_ROPE) + (q0 + r) * 32 + 4 * hh;
#pragma unroll
      for (int s = 4; s < 6; ++s) {
        const f32x4 cs = *(const f32x4*)(rp + 8 * (s - 4)), sn = *(const f32x4*)(rp + 16 + 8 * (s - 4));
        const u32x4 qu = __builtin_bit_cast(u32x4, qf[s]);
        u32x4 o;
#pragma unroll
        for (int p = 0; p < 4; ++p) {
          const float x1 = bflo(qu[p]), x2 = bfhi(qu[p]);
          o[p] = cvt_pk_bf16(x1 * cs[p] - x2 * sn[p], x1 * sn[p] + x2 * cs[p]);
        }
        qf[s] = __builtin_bit_cast(bf16x8, o);
      }
    }
    f32x16 oacc[2];
#pragma unroll
    for (int t = 0; t < 2; ++t)
#pragma unroll
      for (int e = 0; e < 16; ++e) oacc[t][e] = 0.f;
    float m = 0.f, l = 0.f;
    const bf16_t* kg = KM + (size_t)bh * 2048 * 96;
    const bf16_t* vg = VMT + (size_t)bh * 64 * 2048;
    const bool k2 = tid < 256;
    const int klds0 = (tid / 12) * 104 + (tid % 12) * 8;
    const int klds1 = ((tid + 512) / 12) * 104 + ((tid + 512) % 12) * 8;
    const int vlds = (tid >> 3) * 72 + (tid & 7) * 8;
    const size_t vgo = (size_t)(tid >> 3) * 2048 + (tid & 7) * 8;
    u32x4 ak0, ak1 = {0u, 0u, 0u, 0u}, av, bk0, bk1 = {0u, 0u, 0u, 0u}, bv;
#define MLA_LOAD(K0, K1, V, tile) do { const bf16_t* kgn_ = kg + (size_t)(tile) * 64 * 96; \
      K0 = *(const u32x4*)(kgn_ + (size_t)tid * 8); if (k2) K1 = *(const u32x4*)(kgn_ + (size_t)(tid + 512) * 8); \
      V = *(const u32x4*)(vg + vgo + (tile) * 64); } while (0)
#define MLA_WRITE(K0, K1, V, buf) do { *(u32x4*)(Ks + (buf) * (64 * 104) + klds0) = K0; if (k2) *(u32x4*)(Ks + (buf) * (64 * 104) + klds1) = K1; \
      *(u32x4*)(Vs + (buf) * (64 * 72) + vlds) = V; } while (0)
#define MLA_COMPUTE(buf, FIRST) do { \
      const bf16_t* ks = Ks + (buf) * (64 * 104); const bf16_t* vs = Vs + (buf) * (64 * 72); \
      f32x16 sacc[2]; \
      _Pragma("unroll") for (int t = 0; t < 2; ++t) _Pragma("unroll") for (int e = 0; e < 16; ++e) sacc[t][e] = -m; \
      _Pragma("unroll") for (int kt = 0; kt < 2; ++kt) _Pragma("unroll") for (int s = 0; s < 6; ++s) { \
          const bf16x8 kf = *(const bf16x8*)(ks + (32 * kt + pr) * 104 + 16 * s + 8 * hh); sacc[kt] = MFMA32(kf, qf[s], sacc[kt]); } \
      bf16x8 pf[4]; softmax_step(sacc, m, l, oacc, pf, (FIRST)); \
      _Pragma("unroll") for (int dt = 0; dt < 2; ++dt) _Pragma("unroll") for (int s = 0; s < 4; ++s) { \
          const bf16x8 vf = *(const bf16x8*)(vs + (32 * dt + r) * 72 + 16 * s + 8 * hh); oacc[dt] = MFMA32(vf, pf[s], oacc[dt]); } } while (0)
    __syncthreads();
    MLA_LOAD(ak0, ak1, av, 0);
    MLA_LOAD(bk0, bk1, bv, 1);
    MLA_WRITE(ak0, ak1, av, 0);
    __syncthreads();
    for (int j = 0; j < 32; j += 2) {
      if (j + 2 < 32) MLA_LOAD(ak0, ak1, av, j + 2);
      MLA_COMPUTE(0, j == 0);
      __builtin_amdgcn_sched_barrier(0);
      MLA_WRITE(bk0, bk1, bv, 1);
      __syncthreads();
      if (j + 3 < 32) MLA_LOAD(bk0, bk1, bv, j + 3);
      MLA_COMPUTE(1, false);
      __builtin_amdgcn_sched_barrier(0);
      if (j + 2 < 32) MLA_WRITE(ak0, ak1, av, 0);
      __syncthreads();
    }
#undef MLA_LOAD
#undef MLA_WRITE
#undef MLA_COMPUTE
    store_o(oacc, l, mix + ((size_t)b * 2048 + q0 + r) * 1024 + 512 + h * 64, hh);
  }
}

DI void phase_ln1(const Params& P) {
  const int lane = otid() & 63, w = otid() >> 6;
  bf16_t* h1 = (bf16_t*)(P.ws + OFF_H);
  for (int tok = blockIdx.x * NW + w; tok < NTOK; tok += gridDim.x * NW) {
    float v[16];
#pragma unroll
    for (int g = 0; g < 4; ++g) {
      const u32x2 t = *(const u32x2*)((const bf16_t*)(P.ws + OFF_Y1) + (size_t)tok * 1024 + g * 256 + lane * 4);
      const u32x2 hv = *(const u32x2*)(h1 + (size_t)tok * 1024 + g * 256 + lane * 4);
      v[g * 4 + 0] = DN_ALPHA * bflo(hv[0]) + bflo(t[0]);
      v[g * 4 + 1] = DN_ALPHA * bfhi(hv[0]) + bfhi(t[0]);
      v[g * 4 + 2] = DN_ALPHA * bflo(hv[1]) + bflo(t[1]);
      v[g * 4 + 3] = DN_ALPHA * bfhi(hv[1]) + bfhi(t[1]);
    }
    ln_rows16(v, P.ln1g, P.ln1b, lane);
#pragma unroll
    for (int g = 0; g < 4; ++g) {
      u32x2 o;
      o[0] = cvt_pk_bf16(v[g * 4 + 0], v[g * 4 + 1]);
      o[1] = cvt_pk_bf16(v[g * 4 + 2], v[g * 4 + 3]);
      *(u32x2*)(h1 + (size_t)tok * 1024 + g * 256 + lane * 4) = o;
    }
  }
}

#define CE_DESC(a, b) { const float _hi = fmaxf(a, b), _lo = fminf(a, b); a = _hi; b = _lo; }
DI void sort16_desc(float (&v)[16]) {
#define S2(a, b) CE_DESC(v[a], v[b])
  S2(0, 13) S2(1, 12) S2(2, 15) S2(3, 14) S2(4, 8) S2(5, 6) S2(7, 11) S2(9, 10)
  S2(0, 5) S2(1, 7) S2(2, 9) S2(3, 4) S2(6, 13) S2(8, 14) S2(10, 15) S2(11, 12)
  S2(0, 1) S2(2, 3) S2(4, 5) S2(6, 8) S2(7, 9) S2(10, 11) S2(12, 13) S2(14, 15)
  S2(0, 2) S2(1, 3) S2(4, 10) S2(5, 11) S2(6, 7) S2(8, 9) S2(12, 14) S2(13, 15)
  S2(1, 2) S2(3, 12) S2(4, 6) S2(5, 7) S2(8, 10) S2(9, 11) S2(13, 14)
  S2(1, 4) S2(2, 6) S2(5, 8) S2(7, 10) S2(9, 13) S2(11, 14)
  S2(2, 4) S2(3, 6) S2(9, 12) S2(11, 13)
  S2(3, 5) S2(6, 8) S2(7, 9) S2(10, 12)
  S2(3, 4) S2(5, 6) S2(7, 8) S2(9, 10) S2(11, 12)
  S2(6, 7) S2(8, 9)
#undef S2
}
DI void merge16_desc(float (&a)[16], const float (&b)[16]) {
#pragma unroll
  for (int i = 0; i < 16; ++i) a[i] = fmaxf(a[i], b[15 - i]);
#pragma unroll
  for (int jj = 3; jj >= 0; --jj)
#pragma unroll
    for (int i = 0; i < 16; ++i) {
      const int j = 1 << jj, l = i ^ j;
      if (l > i) CE_DESC(a[i], a[l])
    }
}
DI float pack_code(float v, unsigned mask, unsigned code) { return __uint_as_float((__float_as_uint(v) & mask) | code); }

DI void phase_select(const Params& P, char* smem) {
  char* ws = P.ws;
  const bf16_t* qp = (const bf16_t*)(ws + OFF_QP);
  const bf16_t* subk = (const bf16_t*)(ws + OFF_SUBK);
  unsigned short* idx_out = (unsigned short*)(ws + OFF_IDX);
  float* g_out = (float*)(ws + OFF_GW);
  const int tid = otid(), lane = tid & 63, w = tid >> 6;
  const int r = lane & 31, hh = lane >> 5;
  bf16_t* sk = (bf16_t*)smem;
  float* lst = (float*)(smem + 69632) + w * 1024;
  __syncthreads();
  {
    const bf16_t* sg = subk + tid * 8;
    bf16_t* sl = sk + (tid >> 4) * 136 + (tid & 15) * 8;
#pragma unroll
    for (int c = 0; c < 2; ++c)
#pragma unroll
      for (int i = 0; i < 4; ++i)
        *(u32x4*)(sl + c * (128 * 136) + i * (32 * 136)) = *(const u32x4*)(sg + c * 16384 + i * 4096);
  }
  __syncthreads();
  pg8::StaticOrder S;
  S.init(NTOK, 3072, (int)gridDim.x, (int)blockIdx.x);
  pg8::Unit uu;
  for (int ui = 0; S.next(ui, uu); ++ui) {
    if (uu.pn < 4) continue;
    const int tg = uu.pm * 8 + w, h = uu.pn - 4;
    const int tok = tg * 32 + r;
    float L[2][16];
#pragma unroll
    for (int c = 0; c < 2; ++c) {
      f32x16 sacc[4];
#pragma unroll
      for (int t = 0; t < 4; ++t)
#pragma unroll
        for (int e = 0; e < 16; ++e) sacc[t][e] = 0.f;
      const bf16_t* qrow = qp + (size_t)tok * 2048 + h * 256 + c * 128 + 8 * hh;
#pragma unroll 2
      for (int s = 0; s < 8; ++s) {
        const bf16x8 bq = *(const bf16x8*)(qrow + 16 * s);
#pragma unroll
        for (int kt = 0; kt < 4; ++kt) {
          const bf16x8 ak = *(const bf16x8*)(sk + c * (128 * 136) + (32 * kt + r) * 136 + 16 * s + 8 * hh);
          sacc[kt] = MFMA32(ak, bq, sacc[kt]);
        }
      }
      float T[4][16];
#pragma unroll
      for (int kt = 0; kt < 4; ++kt) {
#pragma unroll
        for (int e = 0; e < 16; ++e)
          T[kt][e] = pack_code(sacc[kt][e], 0xFFFFFF80u, (unsigned)(32 * kt + (e & 3) + 8 * (e >> 2)));
        sort16_desc(T[kt]);
      }
      merge16_desc(T[0], T[1]);
      merge16_desc(T[2], T[3]);
      merge16_desc(T[0], T[2]);
      {
        const unsigned hb = (unsigned)hh << 2;
#pragma unroll
        for (int i = 0; i < 16; ++i) T[0][i] = __uint_as_float(__float_as_uint(T[0][i]) | hb);
      }
      float Pn[16];
#pragma unroll
      for (int i = 0; i < 16; ++i) Pn[i] = __shfl_xor(T[0][i], 32);
      merge16_desc(T[0], Pn);
#pragma unroll
      for (int i = 0; i < 16; ++i) L[c][i] = T[0][i];
    }
    float A0[16], B1[16], C2[16], D3[16];
#pragma unroll
    for (int j = 0; j < 16; ++j) A0[j] = pack_code(L[0][0] + L[1][j], 0xFFFFFF00u, (unsigned)j);
#pragma unroll
    for (int j = 0; j < 16; ++j) B1[j] = (j < 8) ? pack_code(L[0][1] + L[1][j], 0xFFFFFF00u, (unsigned)(16 + j)) : -INFINITY;
    {
      int n = 0;
#pragma unroll
      for (int i = 2; i <= 4; ++i)
#pragma unroll
        for (int j = 0; j < 16 / (i + 1); ++j) { C2[n] = pack_code(L[0][i] + L[1][j], 0xFFFFFF00u, (unsigned)(16 * i + j)); ++n; }
#pragma unroll
      for (int q = 12; q < 16; ++q) C2[q] = -INFINITY;
      n = 0;
#pragma unroll
      for (int i = 5; i <= 15; ++i)
#pragma unroll
        for (int j = 0; j < 16 / (i + 1); ++j) { D3[n] = pack_code(L[0][i] + L[1][j], 0xFFFFFF00u, (unsigned)(16 * i + j)); ++n; }
      D3[14] = -INFINITY; D3[15] = -INFINITY;
    }
    sort16_desc(C2);
    sort16_desc(D3);
    merge16_desc(A0, B1);
    merge16_desc(C2, D3);
    merge16_desc(A0, C2);
    if (hh == 0) {
#pragma unroll
      for (int i = 0; i < 16; ++i) {
        lst[i * 32 + r] = L[0][i];
        lst[(16 + i) * 32 + r] = L[1][i];
      }
    }
    float cv[16];
    int eid[16];
#pragma unroll
    for (int k = 0; k < 16; ++k) {
      const unsigned code = __float_as_uint(A0[k]) & 255u;
      const float v1 = lst[(code >> 4) * 32 + r];
      const float v2 = lst[(16 + (code & 15u)) * 32 + r];
      cv[k] = v1 + v2;
      eid[k] = (int)((__float_as_uint(v1) & 127u) * 128u + (__float_as_uint(v2) & 127u));
    }
    float mx = cv[0];
#pragma unroll
    for (int k = 1; k < 16; ++k) mx = fmaxf(mx, cv[k]);
    float sum = 0.f;
#pragma unroll
    for (int k = 0; k < 16; ++k) { cv[k] = __expf(cv[k] - mx); sum += cv[k]; }
    const float inv = 1.f / sum;
    const size_t o = (size_t)tok * 128 + h * 16;
    if (hh == 0) {
#pragma unroll
      for (int q = 0; q < 2; ++q) {
        u32x4 t;
#pragma unroll
        for (int c = 0; c < 4; ++c) t[c] = (unsigned)eid[8 * q + 2 * c] | ((unsigned)eid[8 * q + 2 * c + 1] << 16);
        *(u32x4*)(idx_out + o + 8 * q) = t;
      }
    } else {
#pragma unroll
      for (int q = 0; q < 4; ++q) {
        f32x4 t;
#pragma unroll
        for (int c = 0; c < 4; ++c) t[c] = cv[4 * q + c] * inv;
        *(f32x4*)(g_out + o + 4 * q) = t;
      }
    }
  }
}

constexpr unsigned PEER_CHUNK_TOK = 32;
constexpr unsigned PEER_NCHUNK = NTOK / PEER_CHUNK_TOK;

#define PSB() __builtin_amdgcn_sched_barrier(0)
struct PeerTok { int j, tok; bool done; };
struct PeerStream { unsigned* qc; unsigned xcc, qq, pend; int j, tok, left; bool done; };
DI void ps_init(PeerStream& s, unsigned* qc, unsigned xcc, int lane) {
  (void)lane;
  s.qc = qc; s.xcc = xcc; s.qq = 0; s.j = (int)(xcc & 7u); s.tok = 0; s.left = 0; s.done = false; s.pend = 0;
}
DI PeerTok ps_next(PeerStream& s, int lane) {
  if (!s.done) {
    if (s.left > 0) { ++s.tok; --s.left; }
    else {
      for (;;) {
        unsigned p = 0;
        if (lane == 0) p = __hip_atomic_fetch_add(s.qc + s.j * 64, 1u, __ATOMIC_RELAXED, __HIP_MEMORY_SCOPE_AGENT);
        const unsigned c = (unsigned)__builtin_amdgcn_readfirstlane((int)p);
        if (c < PEER_NCHUNK) { s.tok = (int)(c * PEER_CHUNK_TOK); s.left = (int)PEER_CHUNK_TOK - 1; break; }
        if (++s.qq == 8u) { s.done = true; break; }
        s.j = (int)((s.xcc + s.qq) & 7u);
      }
    }
  }
  PeerTok e; e.j = s.j; e.tok = s.tok; e.done = s.done;
  return e;
}
struct PeerIds { u32x4 q[2]; };
DI unsigned pp_rowoff(const PeerIds& I, int k, unsigned cb) {
  unsigned r;
  const unsigned w = I.q[k >> 3][(k & 7) >> 1], c128 = 128u;
  if (k & 1) asm("v_mad_u32_u16 %0, %1, %2, %3 op_sel:[1,0,0,0]" : "=v"(r) : "v"(w), "s"(c128), "v"(cb));
  else asm("v_mad_u32_u16 %0, %1, %2, %3" : "=v"(r) : "v"(w), "s"(c128), "v"(cb));
  return r;
}
DI void pp_ids(PeerIds& I, const Params& P, const PeerTok& e) {
  const int lane = otid() & 63;
  const unsigned short* ip = (const unsigned short*)(P.ws + OFF_IDX) + (size_t)e.tok * 128 + (lane >> 3) * 16;
#pragma unroll
  for (int q = 0; q < 2; ++q) I.q[q] = *(const u32x4*)(ip + 8 * q);
}
struct PeerSet { u32x4 xa, xb; u32x4 uv[16]; };
template <int PASS>
DI void pp_gather(PeerSet& S, const PeerIds& I, const Params& P, const PeerTok& e) {
  const int lane = otid() & 63;
  const int ch = lane & 7;
  const unsigned char* T8 = (const unsigned char*)(P.ws + (PASS == 0 ? OFF_UBF : OFF_VBF)) + (size_t)e.j * SLICE_BYTES;
  const unsigned cb = (unsigned)ch * 16u;
#pragma unroll
  for (int i = 0; i < 16; ++i) S.uv[i] = *(const u32x4*)(T8 + pp_rowoff(I, i, cb));
  if (PASS == 0) {
    const bf16_t* xp = (const bf16_t*)(P.ws + OFF_H) + (size_t)e.tok * 1024 + e.j * 128 + ch * 16;
    S.xa = *(const u32x4*)xp; S.xb = *(const u32x4*)(xp + 8);
  } else {
    const bf16_t* ap = (const bf16_t*)(P.ws + OFF_ACT) + (size_t)e.tok * 128 + (lane >> 3) * 16;
    S.xa = *(const u32x4*)ap; S.xb = *(const u32x4*)(ap + 8);
  }
}
typedef short pp_s16x4 __attribute__((ext_vector_type(4)));
typedef __bf16 pp_bf16x2 __attribute__((ext_vector_type(2)));
template <int PASS, int MODE>
DI void pp_step(const PeerSet& C, PeerSet& N, const PeerIds& IN, const Params& P, const PeerTok& ec, const PeerTok& en) {
  const int lane = otid() & 63;
  const int eg = lane >> 3, ch = lane & 7;
  const unsigned char* T8 = (const unsigned char*)(P.ws + (PASS == 0 ? OFF_UBF : OFF_VBF)) + (size_t)en.j * SLICE_BYTES;
  const unsigned cb = (unsigned)ch * 16u;
  if (PASS == 0) {
    const bf16_t* xp = (const bf16_t*)(P.ws + OFF_H) + (size_t)en.tok * 1024 + en.j * 128 + ch * 16;
    N.xa = *(const u32x4*)xp; N.xb = *(const u32x4*)(xp + 8);
  } else {
    const bf16_t* ap = (const bf16_t*)(P.ws + OFF_ACT) + (size_t)en.tok * 128 + eg * 16;
    N.xa = *(const u32x4*)ap; N.xb = *(const u32x4*)(ap + 8);
  }
  PSB();
  if (PASS == 0) {
    pp_s16x4 xg[4];
    { const u32x2 t0 = {C.xa[0], C.xa[1]}, t1 = {C.xa[2], C.xa[3]}, t2 = {C.xb[0], C.xb[1]}, t3 = {C.xb[2], C.xb[3]};
      xg[0] = __builtin_bit_cast(pp_s16x4, t0); xg[1] = __builtin_bit_cast(pp_s16x4, t1);
      xg[2] = __builtin_bit_cast(pp_s16x4, t2); xg[3] = __builtin_bit_cast(pp_s16x4, t3); }
    float keep0 = 0.f, keep1 = 0.f;
    f32x4 accp = {0.f, 0.f, 0.f, 0.f};
#define PA_REDUCE(ri)                                                                                                     \
    {                                                                                                                     \
      const float d0 = accp[0], d1 = accp[1], d2 = accp[2], d3 = accp[3];     \
      float sm = __builtin_bit_cast(float, __builtin_amdgcn_update_dpp(0, __builtin_bit_cast(int, d0), 0x00, 0xF, 0xF, true)); \
      sm += __builtin_bit_cast(float, __builtin_amdgcn_update_dpp(0, __builtin_bit_cast(int, d1), 0x55, 0xF, 0xF, true));  \
      sm += __builtin_bit_cast(float, __builtin_amdgcn_update_dpp(0, __builtin_bit_cast(int, d2), 0xAA, 0xF, 0xF, true));  \
      sm += __builtin_bit_cast(float, __builtin_amdgcn_update_dpp(0, __builtin_bit_cast(int, d3), 0xFF, 0xF, 0xF, true));  \
      sm += __builtin_bit_cast(float, __builtin_amdgcn_update_dpp(0, __builtin_bit_cast(int, sm), 0x141, 0xF, 0xF, true));  \
      if (((ri) & 1) == 0) { if (ch == ((ri) >> 1)) keep0 = sm; }                                                         \
      else { if (ch == ((ri) >> 1)) keep1 = sm; }                                                                         \
    }
#pragma unroll
    for (int i = 0; i < 16; ++i) {
      if (MODE != 2) N.uv[i] = *(const u32x4*)(T8 + pp_rowoff(IN, i, cb));
      PSB();
      if (MODE != 1) {
        f32x4 acc = {0.f, 0.f, 0.f, 0.f};
#pragma unroll
        for (int g = 0; g < 4; ++g) {
          const pp_bf16x2 lo = __builtin_amdgcn_cvt_scalef32_pk_bf16_fp8((int)C.uv[i][g], 1.0f, false);
          const pp_bf16x2 hi = __builtin_amdgcn_cvt_scalef32_pk_bf16_fp8((int)C.uv[i][g], 1.0f, true);
          const u32x2 av = {__builtin_bit_cast(unsigned, lo), __builtin_bit_cast(unsigned, hi)};
          acc = __builtin_amdgcn_mfma_f32_4x4x4bf16_1k(__builtin_bit_cast(pp_s16x4, av), xg[g], acc, 0, 0, 0);
        }
        if (i > 0) PA_REDUCE(i - 1)
        accp = acc;
      }
      asm volatile("" : "+v"(keep0), "+v"(keep1), "+v"(accp) : : "memory");
      PSB();
    }
    if (MODE != 1) PA_REDUCE(15)
#undef PA_REDUCE
    bf16_t* pa = (bf16_t*)(P.ws + OFF_PA) + ((size_t)ec.j * NTOK + ec.tok) * 128 + eg * 16 + 2 * ch;
    *(unsigned*)pa = cvt_pk_bf16(keep0, keep1);
  } else {
    const int q = lane & 3;
    const unsigned lo16 = 0x0c0c0504u, hi16 = 0x05040c0cu, zz = 0x0c0c0c0cu;
    const unsigned s0e = q == 0 ? lo16 : (q == 1 ? hi16 : zz), s1e = q == 2 ? lo16 : (q == 3 ? hi16 : zz);
    const unsigned s0o = q == 0 ? lo16 + 0x0202u : (q == 1 ? hi16 + 0x02020000u : zz), s1o = q == 2 ? lo16 + 0x0202u : (q == 3 ? hi16 + 0x02020000u : zz);
    f32x4 ag[4];
#pragma unroll
    for (int g = 0; g < 4; ++g) ag[g] = f32x4{0.f, 0.f, 0.f, 0.f};
#pragma unroll
    for (int i = 0; i < 16; ++i) {
      if (MODE != 2) N.uv[i] = *(const u32x4*)(T8 + pp_rowoff(IN, i, cb));
      PSB();
      if (MODE != 1) {
        const unsigned aw = (i < 8) ? C.xa[(i & 7) >> 1] : C.xb[(i & 7) >> 1];
        const u32x2 asel = {__builtin_amdgcn_perm(aw, 0u, (i & 1) ? s0o : s0e), __builtin_amdgcn_perm(aw, 0u, (i & 1) ? s1o : s1e)};
        const pp_s16x4 av = __builtin_bit_cast(pp_s16x4, asel);
#pragma unroll
        for (int g = 0; g < 4; ++g) {
          const pp_bf16x2 lo = __builtin_amdgcn_cvt_scalef32_pk_bf16_fp8((int)C.uv[i][g], 1.0f, false);
          const pp_bf16x2 hi = __builtin_amdgcn_cvt_scalef32_pk_bf16_fp8((int)C.uv[i][g], 1.0f, true);
          const u32x2 bv = {__builtin_bit_cast(unsigned, lo), __builtin_bit_cast(unsigned, hi)};
          ag[g] = __builtin_amdgcn_mfma_f32_4x4x4bf16_1k(av, __builtin_bit_cast(pp_s16x4, bv), ag[g], 0, 0, 0);
        }
      }
      asm volatile("" : "+v"(ag[0]), "+v"(ag[1]), "+v"(ag[2]), "+v"(ag[3]) : : "memory");
      PSB();
    }
    f32x2 acc[8];
#pragma unroll
    for (int g = 0; g < 4; ++g) {
      const f32x4 t = ag[g];
      acc[2 * g][0] = t[0]; acc[2 * g][1] = t[1]; acc[2 * g + 1][0] = t[2]; acc[2 * g + 1][1] = t[3];
    }
    const bool b3 = (lane & 8) != 0, b4 = (lane & 16) != 0, b5 = (lane & 32) != 0;
    f32x2 r1[4], r2[2], r3;
#pragma unroll
    for (int m = 0; m < 4; ++m)
#pragma unroll
      for (int c = 0; c < 2; ++c) {
        const float snd = b3 ? acc[m][c] : acc[m + 4][c];
        const float kp = b3 ? acc[m + 4][c] : acc[m][c];
        r1[m][c] = kp + __builtin_bit_cast(float, __builtin_amdgcn_update_dpp(0, __builtin_bit_cast(int, snd), 0x128, 0xF, 0xF, true));
      }
#pragma unroll
    for (int m = 0; m < 2; ++m)
#pragma unroll
      for (int c = 0; c < 2; ++c) {
        const float snd = b4 ? r1[m][c] : r1[m + 2][c];
        const float kp = b4 ? r1[m + 2][c] : r1[m][c];
        r2[m][c] = kp + __shfl_xor(snd, 16);
      }
#pragma unroll
    for (int c = 0; c < 2; ++c) {
      const float snd = b5 ? r2[0][c] : r2[1][c];
      const float kp = b5 ? r2[1][c] : r2[0][c];
      r3[c] = kp + __shfl_xor(snd, 32);
    }
    const int mstar = (b3 ? 4 : 0) + (b4 ? 2 : 0) + (b5 ? 1 : 0);
    bf16_t* op = (bf16_t*)(P.ws + OFF_FFN) + (size_t)ec.tok * 1024 + ec.j * 128 + ch * 16 + 2 * mstar;
    *(unsigned*)op = cvt_pk_bf16(r3[0], r3[1]);
  }
}

template <int PASS, int QSET = PASS, int MODE = 0>
DI void phase_peer_pass(const Params& P, unsigned xcc) {
  const int lane = otid() & 63;
  PeerStream st;
  ps_init(st, (unsigned*)(P.ws + OFF_QUEUE) + QSET * 8 * 64, xcc, lane);
  PeerIds I0, I1;
  PeerSet A, B;
  PeerTok ec = ps_next(st, lane);
  pp_ids(I0, P, ec);
  PeerTok en = ps_next(st, lane);
  pp_ids(I1, P, en);
  PSB();
  pp_gather<PASS>(A, I0, P, ec);
  PSB();
  for (;;) {
    if (ec.done) break;
    PeerTok e2 = ps_next(st, lane);
    pp_ids(I0, P, e2); PSB();
    pp_step<PASS, MODE>(A, B, I1, P, ec, en); PSB();
    if (en.done) break;
    PeerTok e3 = ps_next(st, lane);
    pp_ids(I1, P, e3); PSB();
    pp_step<PASS, MODE>(B, A, I0, P, en, e2); PSB();
    ec = e2; en = e3;
  }
}

DI void phase_peer_act(const Params& P, char* smem) {
  char* ws = P.ws;
  const bf16_t* pa = (const bf16_t*)(ws + OFF_PA);
  const unsigned short* idx = (const unsigned short*)(ws + OFF_IDX);
  const float* gw = (const float*)(ws + OFF_GW);
  bf16_t* act = (bf16_t*)(ws + OFF_ACT);
  float LAS* lsu = (float LAS*)smem;
  float LAS* lsv = (float LAS*)(smem + 65536);
  __syncthreads();
  for (int i = otid(); i < 16384 / 4; i += NT) {
    *(f32x4 LAS*)(lsu + 4 * i) = *(const f32x4*)((const float*)(ws + OFF_SU) + 4 * i);
    *(f32x4 LAS*)(lsv + 4 * i) = *(const f32x4*)((const float*)(ws + OFF_SV) + 4 * i);
  }
  __syncthreads();
  for (size_t i8 = (size_t)blockIdx.x * NT + otid(); i8 < (size_t)NTOK * 16; i8 += (size_t)gridDim.x * NT) {
    const size_t i = i8 * 8;
    float sm[8];
#pragma unroll
    for (int c = 0; c < 8; ++c) sm[c] = 0.f;
#pragma unroll
    for (int j = 0; j < 8; ++j) {
      const u32x4 t = *(const u32x4*)(pa + (size_t)j * NTOK * 128 + i);
#pragma unroll
      for (int c = 0; c < 4; ++c) { sm[2 * c] += bflo(t[c]); sm[2 * c + 1] += bfhi(t[c]); }
    }
    const u32x4 iw = *(const u32x4*)(idx + i);
    const f32x4 ga = *(const f32x4*)(gw + i), gb = *(const f32x4*)(gw + i + 4);
    float o[8];
#pragma unroll
    for (int c = 0; c < 8; ++c) {
      const unsigned w2 = iw[c >> 1];
      const int id = (int)((c & 1) ? (w2 >> 16) : (w2 & 0xffffu));
      const float g = c < 4 ? ga[c & 3] : gb[c & 3];
      const float hp = sm[c] * lsu[id];
      o[c] = g * 0.5f * hp * (1.f + erff(hp * 0.70710678118654752f)) * lsv[id];
    }
    u32x4 ov;
#pragma unroll
    for (int c = 0; c < 4; ++c) ov[c] = cvt_pk_bf16(o[2 * c], o[2 * c + 1]);
    *(u32x4*)(act + i) = ov;
  }
  __syncthreads();
}

DI void phase_ln2(const Params& P) {
  const int lane = otid() & 63, w = otid() >> 6;
  const bf16_t* h1 = (const bf16_t*)(P.ws + OFF_H);
  const bf16_t* G = (const bf16_t*)(P.ws + OFF_G);
  const bf16_t* pp = (const bf16_t*)(P.ws + OFF_PP);
  for (int tok = blockIdx.x * NW + w; tok < NTOK; tok += gridDim.x * NW) {
    float v[16];
    float* orow = P.out + (size_t)tok * 1024;
#pragma unroll
    for (int g = 0; g < 4; ++g) {
      const size_t o = (size_t)tok * 1024 + g * 256 + lane * 4;
      const u32x2 t = *(const u32x2*)((const bf16_t*)(P.ws + OFF_FFN) + o);
      const u32x2 hv = *(const u32x2*)(h1 + o), gv = *(const u32x2*)(G + o), pv = *(const u32x2*)(pp + o);
      v[g * 4 + 0] = DN_ALPHA * bflo(hv[0]) + bflo(gv[0]) * bflo(pv[0]) + bflo(t[0]);
      v[g * 4 + 1] = DN_ALPHA * bfhi(hv[0]) + bfhi(gv[0]) * bfhi(pv[0]) + bfhi(t[0]);
      v[g * 4 + 2] = DN_ALPHA * bflo(hv[1]) + bflo(gv[1]) * bflo(pv[1]) + bflo(t[1]);
      v[g * 4 + 3] = DN_ALPHA * bfhi(hv[1]) + bfhi(gv[1]) * bfhi(pv[1]) + bfhi(t[1]);
    }
    ln_rows16(v, P.ln2g, P.ln2b, lane);
#pragma unroll
    for (int g = 0; g < 4; ++g) {
      f32x4 o;
#pragma unroll
      for (int c = 0; c < 4; ++c) o[c] = v[g * 4 + c];
      *(f32x4*)(orow + g * 256 + lane * 4) = o;
    }
  }
}

#define XB_TMO      128
#define XB_XCNT(j)  (256  + 64 * (j))
#define XB_XSUB(j)  (1280 + 64 * (j))
#define XB_XGEN(j)  (2304 + 64 * (j))
#define XB_TOP      3328
#define XB_TOPGEN   3392
#define XCD_BAR_WORDS 3456
#define XB_SPIN_CAP (1u << 22)
DI unsigned xb_ld(unsigned* p) { return __hip_atomic_load(p, __ATOMIC_RELAXED, __HIP_MEMORY_SCOPE_AGENT); }
DI unsigned xb_add(unsigned* p, unsigned v) { return __hip_atomic_fetch_add(p, v, __ATOMIC_RELAXED, __HIP_MEMORY_SCOPE_AGENT); }
DI unsigned xb_xcc_id() { return (unsigned)__builtin_amdgcn_s_getreg((3 << 11) | 20) & 0xFu; }
#define XB_SPIN(cond, bar) do { unsigned _sp = 0; while (cond) { __builtin_amdgcn_s_sleep(1); \
    if ((++_sp & 255u) == 0u) { if (xb_ld(&(bar)[XB_TMO])) break; if (_sp > XB_SPIN_CAP) { atomicAdd(&(bar)[XB_TMO], 1u); break; } } } } while (0)
struct XcdBarrier { unsigned* bar; unsigned x; volatile LAS unsigned* st; };
DI XcdBarrier xcd_barrier_post(unsigned* bar, volatile LAS unsigned* st) {
  XcdBarrier b; b.bar = bar; b.x = xb_xcc_id(); b.st = st;
  if (otid() == 0) (void)xb_add(&bar[XB_XCNT(b.x)], 1u);
  return b;
}
DI void xcd_barrier_complete(unsigned* bar, unsigned x, unsigned& nloc, unsigned& nx) {
  const unsigned G = gridDim.x * gridDim.y * gridDim.z;
  unsigned sum, cnt, mine, sp = 0u;
  for (;;) {
    sum = 0u; cnt = 0u; mine = 0u;
#pragma unroll
    for (unsigned j = 0; j < 16; ++j) { const unsigned c = xb_ld(&bar[XB_XCNT(j)]); sum += c; cnt += (c > 0u) ? 1u : 0u; mine = (j == x) ? c : mine; }
    if (sum == G) break;
    __builtin_amdgcn_s_sleep(1);
    if ((++sp & 255u) == 0u) { if (xb_ld(&bar[XB_TMO])) break; if (sp > XB_SPIN_CAP) { atomicAdd(&bar[XB_TMO], 1u); break; } }
  }
  nloc = mine > 0u ? mine : 1u; nx = cnt > 0u ? cnt : 1u;
}
DI void xcd_barrier(const XcdBarrier& b) {
  asm volatile("s_waitcnt vmcnt(0)" ::: "memory");
  __syncthreads();
  if (otid() == 0) {
    unsigned* bar = b.bar;
    __builtin_amdgcn_s_waitcnt(0);
    unsigned nloc = b.st[0], nx = b.st[1];
    if (nloc == 0u) { xcd_barrier_complete(bar, b.x, nloc, nx); b.st[0] = nloc; b.st[1] = nx; }
    const unsigned old = xb_add(&bar[XB_XSUB(b.x)], 1u);
    const unsigned gen = old / nloc;
    if (old + 1u == (gen + 1u) * nloc) {
      __builtin_amdgcn_fence(__ATOMIC_RELEASE, "agent");
      asm volatile("s_waitcnt vmcnt(0)" ::: "memory");
      const unsigned og = xb_add(&bar[XB_TOP], 1u);
      const unsigned tg = og / nx;
      if (og + 1u == (tg + 1u) * nx) xb_add(&bar[XB_TOPGEN], 1u);
      else XB_SPIN(xb_ld(&bar[XB_TOPGEN]) == tg, bar);
      __builtin_amdgcn_fence(__ATOMIC_ACQUIRE, "agent");
      xb_add(&bar[XB_XGEN(b.x)], 1u);
      asm volatile("s_waitcnt vmcnt(0)" ::: "memory");
    } else {
      XB_SPIN(xb_ld(&bar[XB_XGEN(b.x)]) == gen, bar);
      __builtin_amdgcn_fence(__ATOMIC_ACQUIRE, "agent");
      asm volatile("s_waitcnt vmcnt(0)" ::: "memory");
    }
  }
  __syncthreads();
}


template <int PH>
DI void run_phase(const Params& P, char* smem, unsigned xcc) {
  char* ws = P.ws;
  if constexpr (PH == 0) {
    phase0(P, smem);
  } else if constexpr (PH == 1) {
    EpiInMain e{(bf16_t*)(ws + OFF_QNA), (bf16_t*)(ws + OFF_KNA), (bf16_t*)(ws + OFF_CQ), (bf16_t*)(ws + OFF_CKV), (float*)(ws + OFF_KR)};
    run_gemm((const bf16_t*)(ws + OFF_H), (const bf16_t*)(ws + OFF_WINA), NTOK, 1792, 1024, smem, e);
    EpiVT ev{(bf16_t*)(ws + OFF_VNAT), 1};
    run_gemm((const bf16_t*)(ws + OFF_WINV), (const bf16_t*)(ws + OFF_H), 512, NTOK, 1024, smem, ev);
  } else if constexpr (PH == 2) {
    phase_stats(P);
  } else if constexpr (PH == 3) {
#ifndef P3SEL
#define P3SEL 7
#endif
    if (P3SEL & 1) {
    EpiUpQ eq{(bf16_t*)(ws + OFF_QM)};
    run_gemm((const bf16_t*)(ws + OFF_CQ), (const bf16_t*)(ws + OFF_WUQT), NTOK, 768, 384, smem, eq);
    }
    if (P3SEL & 2) {
    EpiUpK ek{(bf16_t*)(ws + OFF_KM)};
    run_gemm((const bf16_t*)(ws + OFF_CKV), (const bf16_t*)(ws + OFF_WUKT), NTOK, 512, 256, smem, ek);
    }
    if (P3SEL & 4) {
    EpiVT ev{(bf16_t*)(ws + OFF_VMT), 0};
    run_gemm((const bf16_t*)(ws + OFF_WUVT), (const bf16_t*)(ws + OFF_CKV), 512, NTOK, 256, smem, ev);
    }
  } else if constexpr (PH == 4) {
    phase_attn<3>(P, smem);
  } else if constexpr (PH == 5) {
    EpiWo e{(bf16_t*)(ws + OFF_Y1)};
    run_gemm((const bf16_t*)(ws + OFF_MIX), (const bf16_t*)(ws + OFF_WOT), NTOK, 1024, 1024, smem, e);
  } else if constexpr (PH == 6) {
    phase_ln1(P);
  } else if constexpr (PH == 7) {
    EpiPle ep{(bf16_t*)(ws + OFF_PP)};
    run_gemm((const bf16_t*)(ws + OFF_PB), (const bf16_t*)(ws + OFF_PLEWT), NTOK, 1024, 256, smem, ep);
    float LAS* gbl = (float LAS*)(smem + SMEM_BYTES + 16);
    __syncthreads();
    for (int i = otid(); i < 1024; i += NT) gbl[i] = P.gate_b[i];
    __syncthreads();
    EpiGateQ e{gbl, (bf16_t*)(ws + OFF_G), (bf16_t*)(ws + OFF_QP)};
    run_gemm((const bf16_t*)(ws + OFF_H), (const bf16_t*)(ws + OFF_GATEWT), NTOK, 3072, 1024, smem, e);
    phase_select(P, smem);
  } else if constexpr (PH == 8) {
  } else if constexpr (PH == 9) {
    phase_peer_pass<0>(P, xcc);
  } else if constexpr (PH == 10) {
    phase_peer_act(P, smem);
  } else if constexpr (PH == 11) {
    phase_peer_pass<1>(P, xcc);
  } else if constexpr (PH == 12) {
    phase_ln2(P);
  }
}

#ifndef REP_PHASE
#define REP_PHASE -1
#endif
#define GSYNC() xcd_barrier(xb)
#define RUNP(k) do { if (REP_PHASE == (k) && (k) != 9) { run_phase<k>(P, smem, xb.x); GSYNC(); } run_phase<k>(P, smem, xb.x); } while (0)

__global__ void __launch_bounds__(512, 2) k_mega(Params P) {
  extern __shared__ __attribute__((aligned(16))) char smem[];
  cg::grid_group grid = cg::this_grid();
  if (P.ws == nullptr) grid.sync();
  volatile LAS unsigned* st = (volatile LAS unsigned*)(smem + SMEM_BYTES);
  if (threadIdx.x < 4) st[threadIdx.x] = 0u;
  __syncthreads();
  XcdBarrier xb = xcd_barrier_post((unsigned*)(P.ws + OFF_BAR), st);
  RUNP(0); GSYNC();
  RUNP(1); GSYNC();
  RUNP(2); GSYNC();
  RUNP(3); GSYNC();
#ifdef ATT_REP
  phase_attn<ATT_REP>(P, smem); GSYNC();
#endif
  RUNP(4); GSYNC();
  RUNP(5); GSYNC();
  RUNP(6); GSYNC();
  RUNP(7); GSYNC();
#if REP_PHASE == 9
  phase_peer_pass<0, 2>(P, xb.x); GSYNC();
#endif
  RUNP(9); GSYNC();
  RUNP(10); GSYNC();
#if REP_PHASE == 11
  phase_peer_pass<1, 3>(P, xb.x); GSYNC();
#endif
  run_phase<11>(P, smem, xb.x); GSYNC();
  run_phase<12>(P, smem, xb.x);
}

extern "C" void kernel_launch(void* const* d_in, const int* in_sizes, int n_in, void* d_out, int out_size, void* d_ws,
                              size_t ws_size, hipStream_t stream) {
  (void)in_sizes; (void)n_in; (void)out_size; (void)ws_size;
  Params P{};
  const float** pp = (const float**)&P;
  for (int i = 0; i < 22; ++i) pp[i] = (const float*)d_in[i];
  P.out = (float*)d_out;
  P.ws = (char*)d_ws;
  constexpr size_t kDynLds = SMEM_BYTES + 16 + 4096;
  static int grid = 0;
  if (!grid) {
    int dev = 0, cus = 0, per_cu = 0;
    (void)hipGetDevice(&dev);
    (void)hipDeviceGetAttribute(&cus, hipDeviceAttributeMultiprocessorCount, dev);
    (void)hipFuncSetAttribute((const void*)k_mega, hipFuncAttributeMaxDynamicSharedMemorySize, (int)kDynLds);
    (void)hipOccupancyMaxActiveBlocksPerMultiprocessor(&per_cu, k_mega, NT, kDynLds);
    if (per_cu > 1) per_cu = 1;
    if (per_cu < 1) per_cu = 1;
    grid = cus * per_cu;
  }
  void* args[] = {&P};
  (void)hipMemsetAsync((char*)d_ws + OFF_BAR, 0, BAR_MEMSET_BYTES, stream);
  hipError_t e = hipLaunchCooperativeKernel((void*)k_mega, dim3(grid), dim3(NT), args, kDynLds, stream);
  if (e != hipSuccess) fprintf(stderr, "cooperative launch failed: %s\n", hipGetErrorString(e));
}

#ifdef PHASE_KERNELS
template <int PH>
__global__ void __launch_bounds__(512, 2) k_phase(Params P) {
  extern __shared__ __attribute__((aligned(16))) char smem[];
  run_phase<PH>(P, smem, xb_xcc_id());
}
template __global__ void k_phase<0>(Params);
template __global__ void k_phase<1>(Params);
template __global__ void k_phase<2>(Params);
template __global__ void k_phase<3>(Params);
template __global__ void k_phase<4>(Params);
template __global__ void k_phase<5>(Params);
template __global__ void k_phase<6>(Params);
template __global__ void k_phase<7>(Params);
template __global__ void k_phase<8>(Params);
template __global__ void k_phase<9>(Params);
template __global__ void k_phase<10>(Params);
template __global__ void k_phase<11>(Params);
template __global__ void k_phase<12>(Params);
#endif
```

```cpp
#include <hip/hip_runtime.h>
#include <hip/hip_cooperative_groups.h>
#include <stdint.h>
#include <stdio.h>

#ifndef MEGA
#define MEGA 1
#endif

namespace cg = cooperative_groups;

#define DI __device__ __forceinline__
typedef unsigned short bf16_t;
using bf16x8 = __attribute__((ext_vector_type(8))) short;
using f32x16 = __attribute__((ext_vector_type(16))) float;
using f32x4  = __attribute__((ext_vector_type(4))) float;
using u32x4  = __attribute__((ext_vector_type(4))) unsigned;
using u32x2  = __attribute__((ext_vector_type(2))) unsigned;
typedef float f32x2 __attribute__((ext_vector_type(2)));

#define MFMA32(a, b, c) __builtin_amdgcn_mfma_f32_32x32x16_bf16((a), (b), (c), 0, 0, 0)

constexpr int NT = 512;
constexpr int NW = 8;
constexpr int NTOK = 32768;
constexpr float DN_ALPHA = 1.189207115002721f;
constexpr float LN_EPS = 1e-5f;
constexpr float LOG2E = 1.4426950408889634f;
constexpr float QNA_SCALE = 0.125f * LOG2E;
constexpr float QM_SCALE = 0.10206207261596577f * LOG2E;

constexpr size_t MBy = 1ull << 20;
constexpr size_t OFF_WINA = 0;
constexpr size_t OFF_WINV = 4 * MBy;
constexpr size_t OFF_WUQT = 5 * MBy;
constexpr size_t OFF_WUKT = 6 * MBy;
constexpr size_t OFF_WUVT = 6 * MBy + 512 * 1024;
constexpr size_t OFF_WOT = 16 * MBy;
constexpr size_t OFF_WQT = 9 * MBy;
constexpr size_t OFF_SUBK = 13 * MBy;
constexpr size_t OFF_ROPE = 14 * MBy;
constexpr size_t OFF_PLEWT = 15 * MBy;
constexpr size_t OFF_GATEWT = 7 * MBy;
constexpr size_t OFF_RQ = 18 * MBy;
constexpr size_t OFF_RKV = 18 * MBy + 256 * 1024;
constexpr size_t OFF_BAR = 19 * MBy;
constexpr size_t OFF_QUEUE = 19 * MBy + 16 * 1024;
constexpr size_t BAR_MEMSET_BYTES = 32 * 1024;
constexpr size_t OFF_SU = 19 * MBy + 64 * 1024;
constexpr size_t OFF_SV = 19 * MBy + 128 * 1024;
constexpr size_t SLICE_BYTES = 16384 * 128;
constexpr size_t OFF_UBF = 20 * MBy;
constexpr size_t OFF_VBF = 52 * MBy;
constexpr size_t OFF_PB = 84 * MBy;
constexpr size_t OFF_H = 100 * MBy;
constexpr size_t OFF_QNA = 164 * MBy;
constexpr size_t OFF_KNA = 196 * MBy;
constexpr size_t OFF_VNAT = 228 * MBy;
constexpr size_t OFF_CQ = 260 * MBy;
constexpr size_t OFF_CKV = 284 * MBy;
constexpr size_t OFF_KR = 300 * MBy;
constexpr size_t OFF_QM = 304 * MBy;
constexpr size_t OFF_KM = 352 * MBy;
constexpr size_t OFF_VMT = 400 * MBy;
constexpr size_t OFF_MIX = 432 * MBy;
constexpr size_t OFF_QP = 164 * MBy;
constexpr size_t OFF_G = 292 * MBy;
constexpr size_t OFF_IDX = 356 * MBy;
constexpr size_t OFF_GW = 372 * MBy;
constexpr size_t OFF_PA = 164 * MBy;
constexpr size_t OFF_ACT = 388 * MBy;
constexpr size_t OFF_PP = 404 * MBy;
constexpr size_t OFF_Y1 = 164 * MBy;
constexpr size_t OFF_FFN = 164 * MBy;

constexpr int SMEM_BYTES = 131072;

struct Params {
  const float *x, *p, *emb_g, *emb_b, *w_in, *qg, *kvg, *w_uq, *w_ukv, *rpb, *w_o, *ln1g, *ln1b, *w_q, *subk, *pu, *pv,
      *ple_w, *gate_w, *gate_b, *ln2g, *ln2b;
  float* out;
  char* ws;
};

DI int otid() { int t = (int)threadIdx.x; asm volatile("" : "+v"(t)); return t; }
DI unsigned short f2bf(float x) {
  unsigned u = __float_as_uint(x);
  u += 0x7fffu + ((u >> 16) & 1u);
  return (unsigned short)(u >> 16);
}
DI float bf2f(unsigned short b) { return __uint_as_float(((unsigned)b) << 16); }
DI unsigned pack2(float lo, float hi) { return (unsigned)f2bf(lo) | ((unsigned)f2bf(hi) << 16); }
DI float bflo(unsigned u) { return __uint_as_float(u << 16); }
DI float bfhi(unsigned u) { return __uint_as_float(u & 0xffff0000u); }
typedef unsigned xl_u32x2 __attribute__((ext_vector_type(2)));
template <int CTRL> DI float xl_dppf(float v) { return __builtin_bit_cast(float, __builtin_amdgcn_update_dpp(0, __builtin_bit_cast(int, v), CTRL, 0xF, 0xF, true)); }
DI float xl_maxf(float a, float b) {
  float m;
  asm("v_max_f32 %0, %1, %2\n\ts_nop 1" : "=v"(m) : "v"(a), "v"(b));
  return m;
}
DI float xsum16(float x) { const xl_u32x2 r = __builtin_amdgcn_permlane16_swap(__float_as_uint(x), __float_as_uint(x), false, false); return __uint_as_float(r[0]) + __uint_as_float(r[1]); }
DI float xsum32(float x) { const xl_u32x2 r = __builtin_amdgcn_permlane32_swap(__float_as_uint(x), __float_as_uint(x), false, false); return __uint_as_float(r[0]) + __uint_as_float(r[1]); }
DI float xmax16(float x) { const xl_u32x2 r = __builtin_amdgcn_permlane16_swap(__float_as_uint(x), __float_as_uint(x), false, false); return xl_maxf(__uint_as_float(r[0]), __uint_as_float(r[1])); }
DI float xmax32(float x) { const xl_u32x2 r = __builtin_amdgcn_permlane32_swap(__float_as_uint(x), __float_as_uint(x), false, false); return xl_maxf(__uint_as_float(r[0]), __uint_as_float(r[1])); }
DI float xmax16_32_tight(float x) {
  float t;
  asm("v_mov_b32 %1, %0\n\ts_nop 1\n\tv_permlane16_swap_b32 %0, %1\n\tv_max_f32 %0, %0, %1\n\tv_mov_b32 %1, %0\n\ts_nop 1\n\tv_permlane32_swap_b32 %0, %1\n\tv_max_f32 %0, %0, %1\n\ts_nop 1"
      : "+v"(x), "=&v"(t));
  return x;
}
DI float wave_sum(float v) {
  v += xl_dppf<0xB1>(v);
  v += xl_dppf<0x4E>(v);
  v += xl_dppf<0x141>(v);
  v += xl_dppf<0x140>(v);
  return xsum32(xsum16(v));
}
DI float wave_max(float v) {
  v = fmaxf(v, xl_dppf<0xB1>(v));
  v = fmaxf(v, xl_dppf<0x4E>(v));
  v = fmaxf(v, xl_dppf<0x141>(v));
  v = fmaxf(v, xl_dppf<0x140>(v));
  return xmax32(xmax16(v));
}
DI float fast_exp2(float x) { return __builtin_amdgcn_exp2f(x); }
DI int pi_swap23(int r) { return (r & ~12) | ((r & 4) << 1) | ((r & 8) >> 1); }

DI void transpose_cvt(const float* __restrict__ in, int ldn, int col0, int ncols, bf16_t* __restrict__ out, int K,
                      const float* __restrict__ g, char* smem, int bid, int nblk) {
  float* tile = (float*)smem;
  const int tk = K >> 6, tn = (ncols + 63) >> 6;
  const int tid = otid();
  const int lr = tid >> 3, lc = (tid & 7) * 8;
  for (int t = bid; t < tk * tn; t += nblk) {
    const int k0 = (t / tn) << 6, n0 = (t % tn) << 6;
    const bool full = (n0 + lc + 8 <= ncols);
    f32x4 v0 = {0.f, 0.f, 0.f, 0.f}, v1 = {0.f, 0.f, 0.f, 0.f};
    if (full) {
      const float* src = in + (size_t)(k0 + lr) * ldn + col0 + n0 + lc;
      v0 = *(const f32x4*)src;
      v1 = *(const f32x4*)(src + 4);
    }
    if (g) { const float gg = g[k0 + lr]; v0 *= gg; v1 *= gg; }
    __syncthreads();
#pragma unroll
    for (int j = 0; j < 4; ++j) { tile[lr * 65 + lc + j] = v0[j]; tile[lr * 65 + lc + 4 + j] = v1[j]; }
    __syncthreads();
    if (n0 + lr < ncols) {
      u32x4 o;
#pragma unroll
      for (int j = 0; j < 4; ++j) o[j] = pack2(tile[(lc + 2 * j) * 65 + lr], tile[(lc + 2 * j + 1) * 65 + lr]);
      *(u32x4*)(out + (size_t)(n0 + lr) * K + k0 + lc) = o;
    }
  }
}

DI void straight_cvt(const float* __restrict__ in, bf16_t* __restrict__ out, size_t n, int bid, int nblk) {
  const size_t n4 = n >> 2;
  for (size_t i = (size_t)bid * NT + otid(); i < n4; i += (size_t)nblk * NT) {
    const f32x4 v = *(const f32x4*)(in + i * 4);
    u32x2 o;
    o[0] = pack2(v[0], v[1]);
    o[1] = pack2(v[2], v[3]);
    *(u32x2*)(out + i * 4) = o;
  }
}

DI void ln_rows16(float (&v)[16], const float* __restrict__ gam, const float* __restrict__ bet, int lane) {
  float s = 0.f;
#pragma unroll
  for (int i = 0; i < 16; ++i) s += v[i];
  const float mu = wave_sum(s) * (1.f / 1024.f);
  float q = 0.f;
#pragma unroll
  for (int i = 0; i < 16; ++i) {
    v[i] -= mu;
    q += v[i] * v[i];
  }
  const float rstd = rsqrtf(wave_sum(q) * (1.f / 1024.f) + LN_EPS);
#pragma unroll
  for (int g = 0; g < 4; ++g) {
    const f32x4 gg = *(const f32x4*)(gam + g * 256 + lane * 4);
    const f32x4 bb = *(const f32x4*)(bet + g * 256 + lane * 4);
#pragma unroll
    for (int c = 0; c < 4; ++c) v[g * 4 + c] = v[g * 4 + c] * rstd * gg[c] + bb[c];
  }
}

DI void cvt_table_fp8(const float* __restrict__ in, unsigned char* __restrict__ out8, float* __restrict__ inv_scale, int bid, int nblk) {
  const int lane = otid() & 63, w = otid() >> 6;
  for (int e = bid * NW + w; e < 16384; e += nblk * NW) {
    f32x4 v[4];
    float mx = 0.f;
#pragma unroll
    for (int g = 0; g < 4; ++g) {
      v[g] = *(const f32x4*)(in + (size_t)e * 1024 + g * 256 + lane * 4);
#pragma unroll
      for (int c = 0; c < 4; ++c) mx = fmaxf(mx, fabsf(v[g][c]));
    }
    mx = fmaxf(wave_max(mx), 1e-30f);
    const float sc = 440.f / mx;
#pragma unroll
    for (int g = 0; g < 4; ++g) {
      int p = 0;
      p = __builtin_amdgcn_cvt_pk_fp8_f32(v[g][0] * sc, v[g][1] * sc, p, false);
      p = __builtin_amdgcn_cvt_pk_fp8_f32(v[g][2] * sc, v[g][3] * sc, p, true);
      const int j = 2 * g + (lane >> 5), c = (lane & 31) * 4;
      *(int*)(out8 + (size_t)j * SLICE_BYTES + (size_t)e * 128 + c) = p;
    }
    if (lane == 0) inv_scale[e] = mx * (1.f / 440.f);
  }
}

#ifndef P0_TB
#define P0_TB 48
#endif
DI void phase0(const Params& P, char* smem) {
  char* ws = P.ws;
  const int ntb = ((int)gridDim.x > 2 * P0_TB) ? P0_TB : 0;
  if (ntb == 0 || (int)blockIdx.x < ntb) {
    const int bid = (int)blockIdx.x, nb = ntb ? ntb : (int)gridDim.x;
    bf16_t* wina = (bf16_t*)(ws + OFF_WINA);
    transpose_cvt(P.w_in, 2208, 0, 1024, wina, 1024, nullptr, smem, bid, nb);
    transpose_cvt(P.w_in, 2208, 1536, 672, wina + (size_t)1024 * 1024, 1024, nullptr, smem, bid, nb);
    for (int i = bid * NT + otid(); i < 96 * 1024 / 2; i += nb * NT)
      ((unsigned*)(wina + (size_t)1696 * 1024))[i] = 0u;
    transpose_cvt(P.w_in, 2208, 1024, 512, (bf16_t*)(ws + OFF_WINV), 1024, nullptr, smem, bid, nb);
    transpose_cvt(P.w_uq, 768, 0, 768, (bf16_t*)(ws + OFF_WUQT), 384, P.qg, smem, bid, nb);
    for (int h = 0; h < 8; ++h) {
      transpose_cvt(P.w_ukv, 1024, h * 128, 64, (bf16_t*)(ws + OFF_WUKT) + (size_t)h * 64 * 256, 256, P.kvg, smem, bid, nb);
      transpose_cvt(P.w_ukv, 1024, h * 128 + 64, 64, (bf16_t*)(ws + OFF_WUVT) + (size_t)h * 64 * 256, 256, P.kvg, smem, bid, nb);
    }
    transpose_cvt(P.w_o, 1024, 0, 1024, (bf16_t*)(ws + OFF_WOT), 1024, nullptr, smem, bid, nb);
    transpose_cvt(P.w_q, 2048, 0, 2048, (bf16_t*)(ws + OFF_WQT), 1024, nullptr, smem, bid, nb);
    transpose_cvt(P.ple_w, 1024, 0, 1024, (bf16_t*)(ws + OFF_PLEWT), 256, nullptr, smem, bid, nb);
    transpose_cvt(P.gate_w, 1024, 0, 1024, (bf16_t*)(ws + OFF_GATEWT), 1024, nullptr, smem, bid, nb);
    straight_cvt(P.subk, (bf16_t*)(ws + OFF_SUBK), 2 * 128 * 128, bid, nb);
    float* rope = (float*)(ws + OFF_ROPE);
    for (int i = bid * NT + otid(); i < 2048 * 16; i += nb * NT) {
      const int s = i >> 4, j = i & 15;
      const float inv = powf(10000.f, -(float)(2 * (j & 7)) / 16.f);
      const float pos = (j < 8) ? (float)(s >> 6) : (float)(s & 63);
      const float ang = pos * inv;
      rope[s * 32 + j] = cosf(ang);
      rope[s * 32 + 16 + j] = sinf(ang);
    }
  }
  if (ntb == 0 || (int)blockIdx.x >= ntb) {
    const int bid = (int)blockIdx.x - ntb, nb = (int)gridDim.x - ntb;
    cvt_table_fp8(P.pu, (unsigned char*)(ws + OFF_UBF), (float*)(ws + OFF_SU), bid, nb);
    cvt_table_fp8(P.pv, (unsigned char*)(ws + OFF_VBF), (float*)(ws + OFF_SV), bid, nb);
    straight_cvt(P.p, (bf16_t*)(ws + OFF_PB), (size_t)NTOK * 256, bid, nb);
    const int lane = otid() & 63, w = otid() >> 6;
    bf16_t* h0 = (bf16_t*)(ws + OFF_H);
    for (int tok = bid * NW + w; tok < NTOK; tok += nb * NW) {
      float v[16];
#pragma unroll
      for (int g = 0; g < 4; ++g) {
        const f32x4 t = *(const f32x4*)(P.x + (size_t)tok * 1024 + g * 256 + lane * 4);
#pragma unroll
        for (int c = 0; c < 4; ++c) v[g * 4 + c] = t[c];
      }
      ln_rows16(v, P.emb_g, P.emb_b, lane);
#pragma unroll
      for (int g = 0; g < 4; ++g) {
        u32x2 o;
        o[0] = pack2(v[g * 4 + 0], v[g * 4 + 1]);
        o[1] = pack2(v[g * 4 + 2], v[g * 4 + 3]);
        *(u32x2*)(h0 + (size_t)tok * 1024 + g * 256 + lane * 4) = o;
      }
    }
  }
}

namespace pg8 {
#define PG8_LAS __attribute__((address_space(3)))
typedef unsigned short bf16_t;
typedef short bf16x8 __attribute__((ext_vector_type(8)));
typedef float f32x4 __attribute__((ext_vector_type(4)));
typedef unsigned u32x4 __attribute__((ext_vector_type(4)));
constexpr int BM = 256, BK = 64, HALF = 128, HTB = HALF * BK * 2  , STAGE_BYTES = 8 * HTB, NXCD = 8, WGM = 8;

__host__ __device__ __forceinline__ int lds_byte(int r, int c) { return (r >> 3) * 1024 + (r & 7) * 128 + ((((c >> 3) ^ (r >> 1)) & 7) * 16) + (c & 7) * 2; }
__host__ __device__ __forceinline__ void stage_rc(int b, int& R, int& C) { R = (b >> 10) * 8 + ((b >> 7) & 7); C = ((((b >> 4) & 7) ^ ((R >> 1) & 7)) * 8) + ((b & 15) >> 1); }
__host__ __device__ __forceinline__ int perm32(int rho) { const int n = rho >> 4, i = rho & 15; return 8 * (i >> 2) + 4 * n + (i & 3); }
struct Unit { int pm, pn; };
struct Gemm { const bf16_t* A; const bf16_t* Bt; int M, N, K; };
struct StaticOrder {
    int nM, nN, nwg, G, c;
    __host__ __device__ void init(int M, int N, int G_, int c_) { nM = M / BM; nN = N / BM; nwg = nM * nN; G = G_; c = c_; }
    __host__ __device__ bool next(int i, Unit& u) const {
        const long L = (long)i * G + c; if (L >= nwg) return false;
        int wgid = (int)L; { const int q = nwg / NXCD, r = nwg % NXCD, xcd = wgid % NXCD, off = wgid / NXCD; wgid = (xcd < r ? xcd * (q + 1) : r * (q + 1) + (xcd - r) * q) + off; }
        const int nig = WGM * nN, gid = wgid / nig, fm = gid * WGM, gsz = (nM - fm) < WGM ? (nM - fm) : WGM;
        u.pm = fm + ((wgid % nig) % gsz); u.pn = (wgid % nig) / gsz; return true;
    }
    __device__ __forceinline__ void a_ready(const Unit&) const {}
    __device__ __forceinline__ void done(const Unit&) const {}
};
__device__ __forceinline__ unsigned cvt_pk_bf16(float lo, float hi) { unsigned r; asm volatile("v_cvt_pk_bf16_f32 %0, %1, %2" : "=v"(r) : "v"(lo), "v"(hi)); return r; }
template <class Epi, class Sched, bool STAMP = false>
__device__ __forceinline__ void gemm_phase(PG8_LAS unsigned char* lds, const Gemm g, const Sched& S, const Epi& E, unsigned long long* stamps) {
    const int tid = otid(), wid = __builtin_amdgcn_readfirstlane(tid >> 6), lane = tid & 63, wr = wid >> 2, wc = wid & 3, fr = lane & 15, fq = lane >> 4;
    const int K = g.K, nt = K / BK;
    int ts_lo = 0, ts_hi = 0, nts = 0; const unsigned long long rt_entry = STAMP ? (unsigned long long)wall_clock64() : 0ull;
#define PG8_STAMP() do { if (STAMP && wid == 0 && nts < 64) { const unsigned long long _c = (unsigned long long)clock64(); \
        ts_lo = (lane == nts) ? (int)(unsigned)_c : ts_lo; ts_hi = (lane == nts) ? (int)(unsigned)(_c >> 32) : ts_hi; ++nts; } } while (0)
    PG8_STAMP();
    unsigned voffA[2], voffB[2];
#pragma unroll
    for (int i = 0; i < 2; ++i) { int R, C; stage_rc(tid * 16 + i * 8192, R, C); const int Rb = Epi::PERM ? ((R & ~31) + perm32(R & 31)) : R;
        voffA[i] = (unsigned)(R * K + C) * 2u; voffB[i] = (unsigned)(Rb * K + C) * 2u; }
    const size_t kstep = (size_t)(BK * 2);
    const size_t hstep = (size_t)HALF * K * 2;
    const size_t tstep = 2 * hstep;
    const unsigned ldsw = (unsigned)wid * 1024u;
    const int aoff = lds_byte(wr * 64 + fr, fq * 8), boff = lds_byte(wc * 32 + fr, fq * 8), aoff1 = aoff ^ 64, boff1 = boff ^ 64;
#define PG8_SA(b, h) (((b) * 2 + (h)) * HTB)
#define PG8_SB(b, h) ((4 + (b) * 2 + (h)) * HTB)
#define PG8_STAGE(bufoff, gbase, voff) do { _Pragma("unroll") for (int _i = 0; _i < 2; ++_i) \
        __builtin_amdgcn_global_load_lds((const unsigned*)((const char*)(gbase) + (voff)[_i]), (PG8_LAS unsigned*)(lds + (bufoff) + ldsw + _i * 8192), 16, 0, 0); } while (0)
#define PG8_LDA(dst, b, h) do { _Pragma("unroll") for (int m = 0; m < 4; ++m) _Pragma("unroll") for (int k = 0; k < 2; ++k) dst[m][k] = *(const PG8_LAS bf16x8*)(lds + PG8_SA(b, h) + (k ? aoff1 : aoff) + m * 2048); } while (0)
#define PG8_LDB(dst, b, h) do { _Pragma("unroll") for (int n = 0; n < 2; ++n) _Pragma("unroll") for (int k = 0; k < 2; ++k) dst[n][k] = *(const PG8_LAS bf16x8*)(lds + PG8_SB(b, h) + (k ? boff1 : boff) + n * 2048); } while (0)
#define PG8_MMA(ai, bj, At, Bt) do { __builtin_amdgcn_s_setprio(1); _Pragma("unroll") for (int m = 0; m < 4; ++m) _Pragma("unroll") for (int n = 0; n < 2; ++n) _Pragma("unroll") for (int k = 0; k < 2; ++k) \
        acc[ai][bj][m][n] = __builtin_amdgcn_mfma_f32_16x16x32_bf16(Bt[n][k], At[m][k], acc[ai][bj][m][n], 0, 0, 0); __builtin_amdgcn_s_setprio(0); } while (0)
#define PG8_WAIT_V(n) asm volatile("s_waitcnt vmcnt(" #n ")" ::: "memory")
#define PG8_WAIT_L(n) asm volatile("s_waitcnt lgkmcnt(" #n ")" ::: "memory")
#define PG8_BAR __builtin_amdgcn_s_barrier()
#define PG8_SCHED __builtin_amdgcn_sched_barrier(0)
    Unit cur, nxt; int ui = 0;
    if (!S.next(0, cur)) return;
    f32x4 acc[2][2][4][2];
#pragma unroll
    for (int a = 0; a < 2; ++a)
#pragma unroll
        for (int b = 0; b < 2; ++b)
#pragma unroll
            for (int m = 0; m < 4; ++m)
#pragma unroll
                for (int n = 0; n < 2; ++n) acc[a][b][m][n] = (f32x4){0.f, 0.f, 0.f, 0.f};
    bf16x8 At[4][2], B0[2][2], B1[2][2];
    const char* cA = (const char*)g.A + (size_t)cur.pm * tstep; const char* cB = (const char*)g.Bt + (size_t)cur.pn * tstep;
    S.a_ready(cur);
    PG8_STAGE(PG8_SB(0, 0), cB, voffB); PG8_STAGE(PG8_SA(0, 0), cA, voffA); PG8_STAGE(PG8_SB(0, 1), cB + hstep, voffB); PG8_STAGE(PG8_SA(0, 1), cA + hstep, voffA);
    if (wr == 1) PG8_BAR;
    PG8_WAIT_V(4); PG8_BAR;
    PG8_STAGE(PG8_SB(1, 0), cB + kstep, voffB); PG8_STAGE(PG8_SA(1, 0), cA + kstep, voffA); PG8_STAGE(PG8_SB(1, 1), cB + hstep + kstep, voffB);
    PG8_WAIT_V(6); PG8_BAR;
    PG8_STAMP();
    for (;;) {
        const bool has_next = S.next(ui + 1, nxt);
        const char* nA = has_next ? (const char*)g.A + (size_t)nxt.pm * tstep : cA; const char* nB = has_next ? (const char*)g.Bt + (size_t)nxt.pn * tstep : cB;
#pragma unroll 1
        for (int t = 0; t < nt; t += 2) {
            const bool last = (t == nt - 2);
            const char* a1 = cA + (size_t)(t + 1) * kstep;
            const char* a2 = last ? nA : cA + (size_t)(t + 2) * kstep; const char* b2 = last ? nB : cB + (size_t)(t + 2) * kstep;
            const char* a3 = a2 + kstep; const char* b3 = b2 + kstep;
            if (last && has_next) S.a_ready(nxt);
            PG8_LDB(B0, 0, 0); PG8_SCHED; PG8_LDA(At, 0, 0); PG8_STAGE(PG8_SA(1, 1), a1 + hstep, voffA);
            PG8_WAIT_L(8); PG8_BAR; PG8_WAIT_L(0); PG8_MMA(0, 0, At, B0); PG8_BAR; PG8_SCHED;
            PG8_LDB(B1, 0, 1); PG8_STAGE(PG8_SB(0, 0), b2, voffB);
            PG8_BAR; PG8_WAIT_L(0); PG8_MMA(0, 1, At, B1); PG8_BAR;
            PG8_LDA(At, 0, 1); PG8_STAGE(PG8_SA(0, 0), a2, voffA);
            PG8_BAR; PG8_WAIT_L(0); PG8_MMA(1, 0, At, B0); PG8_BAR; PG8_SCHED;
            PG8_STAGE(PG8_SB(0, 1), b2 + hstep, voffB);
            PG8_WAIT_V(6); PG8_BAR; PG8_MMA(1, 1, At, B1); PG8_BAR;
            PG8_LDB(B0, 1, 0); PG8_SCHED; PG8_LDA(At, 1, 0); PG8_STAGE(PG8_SA(0, 1), a2 + hstep, voffA);
            PG8_WAIT_L(8); PG8_BAR; PG8_WAIT_L(0); PG8_MMA(0, 0, At, B0); PG8_BAR; PG8_SCHED;
            PG8_LDB(B1, 1, 1); PG8_STAGE(PG8_SB(1, 0), b3, voffB);
            PG8_BAR; PG8_WAIT_L(0); PG8_MMA(0, 1, At, B1); PG8_BAR;
            PG8_LDA(At, 1, 1); PG8_STAGE(PG8_SA(1, 0), a3, voffA);
            PG8_BAR; PG8_WAIT_L(0); PG8_MMA(1, 0, At, B0); PG8_BAR; PG8_SCHED;
            PG8_STAGE(PG8_SB(1, 1), b3 + hstep, voffB);
            PG8_WAIT_V(6); PG8_BAR; PG8_MMA(1, 1, At, B1); PG8_BAR;
        }
        PG8_STAMP();
        if constexpr (!Epi::AFTER_DRAIN) { E(acc, cur, wr, wc, fr, fq); S.done(cur); }
        PG8_STAMP();
        if (!has_next) break;
#pragma unroll
        for (int a = 0; a < 2; ++a)
#pragma unroll
            for (int b = 0; b < 2; ++b)
#pragma unroll
                for (int m = 0; m < 4; ++m)
#pragma unroll
                    for (int n = 0; n < 2; ++n) acc[a][b][m][n] = (f32x4){0.f, 0.f, 0.f, 0.f};
        cur = nxt; cA = nA; cB = nB; ++ui;
    }
    PG8_WAIT_V(0);
    if (wr == 0) PG8_BAR;
    PG8_BAR;
    if constexpr (Epi::AFTER_DRAIN) { E.fused(acc, cur, wr, wc, fr, fq, lds, wid, lane); S.done(cur); }
    PG8_STAMP();
    if (STAMP && wid == 0) { stamps[lane] = lane < nts ? (((unsigned long long)(unsigned)ts_hi << 32) | (unsigned)ts_lo) : 0ull;
        if (lane == 62) stamps[62] = rt_entry; if (lane == 63) stamps[63] = (unsigned long long)wall_clock64(); }
#undef PG8_STAMP
#undef PG8_SA
#undef PG8_SB
#undef PG8_STAGE
#undef PG8_LDA
#undef PG8_LDB
#undef PG8_MMA
#undef PG8_WAIT_V
#undef PG8_WAIT_L
#undef PG8_BAR
#undef PG8_SCHED
}
}
using pg8::Unit;
using pg8::cvt_pk_bf16;
DI unsigned cvt_pk_bf16_t(float lo, float hi) { unsigned r; asm volatile("s_nop 1\n\tv_cvt_pk_bf16_f32 %0, %1, %2" : "=v"(r) : "v"(lo), "v"(hi)); return r; }
DI u32x4 pack8_t(const f32x4& a, const f32x4& b) {
  u32x4 o;
  o[0] = cvt_pk_bf16_t(a[0], a[1]);
  o[1] = cvt_pk_bf16_t(a[2], a[3]);
  o[2] = cvt_pk_bf16_t(b[0], b[1]);
  o[3] = cvt_pk_bf16_t(b[2], b[3]);
  return o;
}
#define LAS __attribute__((address_space(3)))

DI u32x4 pack8(const f32x4& a, const f32x4& b) {
  u32x4 o;
  o[0] = cvt_pk_bf16(a[0], a[1]);
  o[1] = cvt_pk_bf16(a[2], a[3]);
  o[2] = cvt_pk_bf16(b[0], b[1]);
  o[3] = cvt_pk_bf16(b[2], b[3]);
  return o;
}

#define EPI_HEAD static constexpr bool PERM = true, AFTER_DRAIN = false;
#define EPI_ARGS const f32x4 (&acc)[2][2][4][2], const Unit& u, int wr, int wc, int fr, int fq
#define EPI_FOR_BJ _Pragma("unroll") for (int bj = 0; bj < 2; ++bj)
#define EPI_FOR_ROWS _Pragma("unroll") for (int ai = 0; ai < 2; ++ai) _Pragma("unroll") for (int m = 0; m < 4; ++m)
#define EPI_ROW (u.pm * 256 + ai * 128 + wr * 64 + m * 16 + fr)
#define EPI_C0 (u.pn * 256 + bj * 128 + wc * 32 + 8 * fq)

#define EPI_RO (ai * 128 + m * 16)
struct EpiInMain {
  EPI_HEAD
  bf16_t *qna, *kna, *cq, *ckv;
  float* kr;
  DI void operator()(EPI_ARGS) const {
    const int rowb = u.pm * 256 + wr * 64 + fr, bb = rowb >> 11, s0 = rowb & 2047;
    EPI_FOR_BJ {
      const int c0 = EPI_C0;
      if (c0 < 1024) {
        const float sc = c0 < 512 ? QNA_SCALE : 1.f;
        const int cc = c0 & 511, h = cc >> 6, d = cc & 63;
        bf16_t* base = (c0 < 512 ? qna : kna) + ((size_t)(bb * 8 + h) * 2048 + s0) * 64 + d;
        EPI_FOR_ROWS { *(u32x4*)(base + EPI_RO * 64) = pack8(acc[ai][bj][m][0] * sc, acc[ai][bj][m][1] * sc); }
      } else if (c0 < 1408) {
        bf16_t* base = cq + (size_t)rowb * 384 + (c0 - 1024);
        EPI_FOR_ROWS { *(u32x4*)(base + EPI_RO * 384) = pack8(acc[ai][bj][m][0], acc[ai][bj][m][1]); }
      } else if (c0 < 1664) {
        bf16_t* base = ckv + (size_t)rowb * 256 + (c0 - 1408);
        EPI_FOR_ROWS { *(u32x4*)(base + EPI_RO * 256) = pack8(acc[ai][bj][m][0], acc[ai][bj][m][1]); }
      } else if (c0 < 1696) {
        float* base = kr + (size_t)rowb * 32 + (c0 - 1664);
        EPI_FOR_ROWS {
          *(f32x4*)(base + EPI_RO * 32) = acc[ai][bj][m][0];
          *(f32x4*)(base + EPI_RO * 32 + 4) = acc[ai][bj][m][1];
        }
      }
    }
  }
};
struct EpiVT {
  EPI_HEAD
  bf16_t* out;
  int rowblocked;
  DI void operator()(EPI_ARGS) const {
    const int rowb = u.pm * 256 + wr * 64 + fr;
    EPI_FOR_BJ {
      const int c0 = EPI_C0, b = c0 >> 11, s = c0 & 2047;
      if (rowblocked) {
        EPI_FOR_ROWS {
          const int row = rowb + EPI_RO, hh_ = row >> 6, dv = row & 63;
          *(u32x4*)(out + (((size_t)(b * 8 + hh_) * 32 + (s >> 6)) * 64 + dv) * 64 + (s & 63)) = pack8(acc[ai][bj][m][0], acc[ai][bj][m][1]);
        }
      } else {
        bf16_t* base = out + ((size_t)(b * 512 + rowb)) * 2048 + s;
        EPI_FOR_ROWS { *(u32x4*)(base + EPI_RO * 2048) = pack8(acc[ai][bj][m][0], acc[ai][bj][m][1]); }
      }
    }
  }
};
struct EpiUpQ {
  EPI_HEAD
  bf16_t* qm;
  DI void operator()(EPI_ARGS) const {
    const int rowb = u.pm * 256 + wr * 64 + fr, bb = rowb >> 11, s0 = rowb & 2047;
    EPI_FOR_BJ {
      const int c0 = EPI_C0, hd = c0 / 96, d0 = c0 - hd * 96;
      bf16_t* base = qm + ((size_t)(bb * 8 + hd) * 2048 + s0) * 96 + d0;
      EPI_FOR_ROWS { *(u32x4*)(base + EPI_RO * 96) = pack8(acc[ai][bj][m][0] * QM_SCALE, acc[ai][bj][m][1] * QM_SCALE); }
    }
  }
};
struct EpiUpK {
  EPI_HEAD
  bf16_t* km;
  DI void operator()(EPI_ARGS) const {
    const int rowb = u.pm * 256 + wr * 64 + fr, bb = rowb >> 11, s0 = rowb & 2047;
    EPI_FOR_BJ {
      const int c0 = EPI_C0, hd = c0 >> 6, d = c0 & 63;
      bf16_t* base = km + ((size_t)(bb * 8 + hd) * 2048 + s0) * 96 + d;
      EPI_FOR_ROWS { *(u32x4*)(base + EPI_RO * 96) = pack8(acc[ai][bj][m][0], acc[ai][bj][m][1]); }
    }
  }
};
struct EpiWo {
  EPI_HEAD
  bf16_t* y1;
  DI void operator()(EPI_ARGS) const {
    const int rowb = u.pm * 256 + wr * 64 + fr;
    EPI_FOR_BJ {
      bf16_t* yb = y1 + (size_t)rowb * 1024 + EPI_C0;
      EPI_FOR_ROWS { *(u32x4*)(yb + EPI_RO * 1024) = pack8(acc[ai][bj][m][0], acc[ai][bj][m][1]); }
    }
  }
};
struct EpiGateQ {
  EPI_HEAD
  const float LAS* gbl;
  bf16_t* G;
  bf16_t* qp;
  DI void operator()(EPI_ARGS) const {
    const int rowb = u.pm * 256 + wr * 64 + fr;
    if (u.pn < 4) {
      EPI_FOR_BJ {
        const int c0 = EPI_C0;
        const f32x4 b0 = *(const f32x4 LAS*)(gbl + c0), b1 = *(const f32x4 LAS*)(gbl + c0 + 4);
        bf16_t* base = G + (size_t)rowb * 1024 + c0;
        EPI_FOR_ROWS {
          f32x4 a = acc[ai][bj][m][0] + b0, c = acc[ai][bj][m][1] + b1;
#pragma unroll
          for (int q = 0; q < 4; ++q) {
            a[q] = __builtin_amdgcn_rcpf(1.f + fast_exp2(-LOG2E * a[q]));
            c[q] = __builtin_amdgcn_rcpf(1.f + fast_exp2(-LOG2E * c[q]));
          }
          *(u32x4*)(base + EPI_RO * 1024) = pack8_t(a, c);
        }
      }
    } else {
      EPI_FOR_BJ {
        const int q8 = (EPI_C0 - 1024) >> 3;
        EPI_FOR_ROWS {
          const int row = rowb + EPI_RO;
          *(u32x4*)(qp + ((size_t)((row >> 5) * 256 + q8) * 32 + (row & 31)) * 8) = pack8(acc[ai][bj][m][0], acc[ai][bj][m][1]);
        }
      }
    }
  }
};
struct EpiPle {
  EPI_HEAD
  bf16_t* pp;
  DI void operator()(EPI_ARGS) const {
    const int rowb = u.pm * 256 + wr * 64 + fr;
    EPI_FOR_BJ {
      bf16_t* base = pp + (size_t)rowb * 2048 + 1024 + EPI_C0;
      EPI_FOR_ROWS { *(u32x4*)(base + EPI_RO * 2048) = pack8(acc[ai][bj][m][0], acc[ai][bj][m][1]); }
    }
  }
};

struct OneUnit {
  pg8::Unit u; bool ok;
  DI bool next(int i, pg8::Unit& o) const { if (i == 0 && ok) { o = u; return true; } return false; }
  DI void a_ready(const pg8::Unit&) const {}
  DI void done(const pg8::Unit&) const {}
};
template <class Epi>
DI void run_gemm(const bf16_t* A, const bf16_t* Bt, int M, int N, int K, char* smem, const Epi& e, int G = -1, int c = -1) {
  pg8::Gemm g{A, Bt, M, N, K};
  pg8::StaticOrder S;
  S.init(M, N, G > 0 ? G : (int)gridDim.x, G > 0 ? c : (int)blockIdx.x);
#ifdef ONE_UNIT_PER_CALL
  for (int i = 0;; ++i) {
    OneUnit o;
    o.ok = S.next(i, o.u);
    if (!o.ok) break;
    pg8::gemm_phase<Epi, OneUnit, false>((LAS unsigned char*)smem, g, o, e, nullptr);
  }
#else
  pg8::gemm_phase<Epi, pg8::StaticOrder, false>((LAS unsigned char*)smem, g, S, e, nullptr);
#endif
}

DI void phase_stats(const Params& P) {
  char* ws = P.ws;
  bf16_t* cq = (bf16_t*)(ws + OFF_CQ);
  bf16_t* ckv = (bf16_t*)(ws + OFF_CKV);
  const float* kr = (const float*)(ws + OFF_KR);
  const float* rope = (const float*)(ws + OFF_ROPE);
  bf16_t* km = (bf16_t*)(ws + OFF_KM);
  const int lane = otid() & 63, w = otid() >> 6;
  const int stride = gridDim.x * NW;
  for (int tok0 = blockIdx.x * NW + w; tok0 < NTOK; tok0 += 8 * stride) {
    unsigned qv[8][3], kv[8][2];
    float x1[8], x2[8], cs[8], sn[8];
#pragma unroll
    for (int u = 0; u < 8; ++u) {
      const int tok = tok0 + u * stride;
      if (tok < NTOK) {
        const unsigned* q32 = (const unsigned*)(cq + (size_t)tok * 384);
        const unsigned* k32 = (const unsigned*)(ckv + (size_t)tok * 256);
#pragma unroll
        for (int i = 0; i < 3; ++i) qv[u][i] = q32[i * 64 + lane];
#pragma unroll
        for (int i = 0; i < 2; ++i) kv[u][i] = k32[i * 64 + lane];
        if (lane < 16) {
          const int s = tok & 2047;
          x1[u] = kr[(size_t)tok * 32 + 2 * lane]; x2[u] = kr[(size_t)tok * 32 + 2 * lane + 1];
          cs[u] = rope[s * 32 + lane]; sn[u] = rope[s * 32 + 16 + lane];
        }
      }
    }
#pragma unroll
    for (int u = 0; u < 8; ++u) {
      const int tok = tok0 + u * stride;
      if (tok < NTOK) {
        unsigned* q32 = (unsigned*)(cq + (size_t)tok * 384);
        unsigned* k32 = (unsigned*)(ckv + (size_t)tok * 256);
        float s1 = 0.f, s2 = 0.f;
#pragma unroll
        for (int i = 0; i < 3; ++i) { const float a = bflo(qv[u][i]), b = bfhi(qv[u][i]); s1 += a * a + b * b; }
#pragma unroll
        for (int i = 0; i < 2; ++i) { const float a = bflo(kv[u][i]), b = bfhi(kv[u][i]); s2 += a * a + b * b; }
        const float r1 = rsqrtf(wave_sum(s1) * (1.f / 384.f) + LN_EPS);
        const float r2 = rsqrtf(wave_sum(s2) * (1.f / 256.f) + LN_EPS);
#pragma unroll
        for (int i = 0; i < 3; ++i) q32[i * 64 + lane] = cvt_pk_bf16(bflo(qv[u][i]) * r1, bfhi(qv[u][i]) * r1);
#pragma unroll
        for (int i = 0; i < 2; ++i) k32[i * 64 + lane] = cvt_pk_bf16(bflo(kv[u][i]) * r2, bfhi(kv[u][i]) * r2);
        if (lane < 16) {
          const int b = tok >> 11, s = tok & 2047;
          const unsigned o = cvt_pk_bf16(x1[u] * cs[u] - x2[u] * sn[u], x1[u] * sn[u] + x2[u] * cs[u]);
#pragma unroll
          for (int h = 0; h < 8; ++h) *(unsigned*)(km + ((size_t)(b * 8 + h) * 2048 + s) * 96 + 64 + 2 * lane) = o;
        }
      }
    }
  }
}

DI bf16x8 pack8s(const f32x16& x, int base) {
  u32x4 p;
  asm volatile("s_nop 1\n\tv_cvt_pk_bf16_f32 %0, %4, %5\n\tv_cvt_pk_bf16_f32 %1, %6, %7\n\tv_cvt_pk_bf16_f32 %2, %8, %9\n\tv_cvt_pk_bf16_f32 %3, %10, %11"
               : "=&v"(p[0]), "=&v"(p[1]), "=&v"(p[2]), "=&v"(p[3])
               : "v"(x[base + 0]), "v"(x[base + 1]), "v"(x[base + 2]), "v"(x[base + 3]), "v"(x[base + 4]), "v"(x[base + 5]), "v"(x[base + 6]), "v"(x[base + 7]));
  return __builtin_bit_cast(bf16x8, p);
}

DI void softmax_step(f32x16 (&sacc)[2], float& m, float& l, f32x16 (&oacc)[2], bf16x8 (&pf)[4], bool first) {
  float mx = sacc[0][0];
#pragma unroll
  for (int e = 1; e < 16; ++e) mx = fmaxf(mx, sacc[0][e]);
#pragma unroll
  for (int e = 0; e < 16; ++e) mx = fmaxf(mx, sacc[1][e]);
  mx = xmax32(mx);
  if (first || __builtin_amdgcn_ballot_w64(mx > 8.f) != 0ull) {
    const float d = first ? mx : fmaxf(mx, 0.f);
    const float alpha = first ? 0.f : fast_exp2(-d);
    m += d;
    l *= alpha;
#pragma unroll
    for (int t = 0; t < 2; ++t)
#pragma unroll
      for (int e = 0; e < 16; ++e) { oacc[t][e] *= alpha; sacc[t][e] -= d; }
  }
  float psa = 0.f, psb = 0.f;
#pragma unroll
  for (int t = 0; t < 2; ++t)
#pragma unroll
    for (int e = 0; e < 16; e += 2) {
      const float p0 = fast_exp2(sacc[t][e]), p1 = fast_exp2(sacc[t][e + 1]);
      sacc[t][e] = p0;
      sacc[t][e + 1] = p1;
      psa += p0; asm("" : "+v"(psa));
      psb += p1; asm("" : "+v"(psb));
    }
  l += psa + psb;
  pf[0] = pack8s(sacc[0], 0);
  pf[1] = pack8s(sacc[0], 8);
  pf[2] = pack8s(sacc[1], 0);
  pf[3] = pack8s(sacc[1], 8);
}

DI void store_o(const f32x16 (&oacc)[2], float l, bf16_t* dst  , int hh) {
  const float lt = xsum32(l);
  const float inv = 1.f / lt;
  u32x2 o2[8];
#pragma unroll
  for (int dt = 0; dt < 2; ++dt)
#pragma unroll
    for (int g = 0; g < 4; ++g) {
      o2[4 * dt + g][0] = cvt_pk_bf16(oacc[dt][4 * g + 0] * inv, oacc[dt][4 * g + 1] * inv);
      o2[4 * dt + g][1] = cvt_pk_bf16(oacc[dt][4 * g + 2] * inv, oacc[dt][4 * g + 3] * inv);
    }
#pragma unroll
  for (int k = 0; k < 8; k += 2) {
    const xl_u32x2 rx = __builtin_amdgcn_permlane32_swap(o2[k][0], o2[k + 1][0], false, false);
    const xl_u32x2 ry = __builtin_amdgcn_permlane32_swap(o2[k][1], o2[k + 1][1], false, false);
    u32x4 o;
    o[0] = rx[0]; o[1] = ry[0]; o[2] = rx[1]; o[3] = ry[1];
    *(u32x4*)(dst + 8 * k + 8 * hh) = o;
  }
}

#ifndef NA_U
#define NA_U 2
#endif
#ifndef NA_ROWS
#define NA_ROWS 4
#endif
template <int SEL>
DI void phase_attn(const Params& P, char* smem) {
  char* ws = P.ws;
  const bf16_t* QNA = (const bf16_t*)(ws + OFF_QNA);
  const bf16_t* KNA = (const bf16_t*)(ws + OFF_KNA);
  const bf16_t* VNAT = (const bf16_t*)(ws + OFF_VNAT);
  const bf16_t* QM = (const bf16_t*)(ws + OFF_QM);
  const bf16_t* KM = (const bf16_t*)(ws + OFF_KM);
  const bf16_t* VMT = (const bf16_t*)(ws + OFF_VMT);
  bf16_t* mix = (bf16_t*)(ws + OFF_MIX);
  const int tid = otid(), lane = tid & 63, w = tid >> 6;
  const int r = lane & 31, hh = lane >> 5;
  const int pr = pi_swap23(r);
  float* bl = (float*)(smem + 45056);
  __syncthreads();
  for (int i = tid; i < 8 * 465; i += NT) bl[i] = P.rpb[i] * LOG2E;
  __syncthreads();
  const int vb = (gridDim.x == 256) ? (int)(((blockIdx.x & 7) << 5) | (blockIdx.x >> 3)) : (int)blockIdx.x;
  if (SEL & 1)
  for (int item = vb * NW + w; item < 16384 / NA_ROWS; item += gridDim.x * NW) {
    const int qg = item & 3, it2 = item >> 2;
    const int h = it2 & 7, rp = (it2 >> 3) % (32 / NA_ROWS), b = (it2 >> 3) / (32 / NA_ROWS);
    const int c = lane & 15, g = lane >> 4;
    const size_t bh = (size_t)(b * 8 + h);
    const int krow = 8 * (c >> 2) + (c & 3);
    const int kb = (qg == 0) ? 0 : (qg == 1) ? 8 : (qg == 2) ? 24 : 32;
    const int qc = 16 * qg + c;
    int cs = qc - 8; cs = cs < 0 ? 0 : (cs > 48 ? 48 : cs);
    int rr[NA_ROWS], rs[NA_ROWS];
#pragma unroll
    for (int u = 0; u < NA_ROWS; ++u) { rr[u] = NA_ROWS * rp + u; int t = rr[u] - 4; rs[u] = t < 0 ? 0 : (t > 24 ? 24 : t); }
    const int ni = 8 + rs[NA_ROWS - 1] - rs[0];
    bf16x8 q0[NA_ROWS], q1[NA_ROWS];
    f32x4 oacc[NA_ROWS][4];
    float m[NA_ROWS], l[NA_ROWS];
    bf16x8 kf[4], vn[4];
#pragma unroll
    for (int u = 0; u < NA_ROWS; ++u) {
      const bf16_t* qp = QNA + (bh * 2048 + rr[u] * 64 + qc) * 64 + 8 * g;
      q0[u] = *(const bf16x8*)qp; q1[u] = *(const bf16x8*)(qp + 32);
#pragma unroll
      for (int t4 = 0; t4 < 4; ++t4) { oacc[u][t4][0] = 0.f; oacc[u][t4][1] = 0.f; oacc[u][t4][2] = 0.f; oacc[u][t4][3] = 0.f; }
      m[u] = -1e30f; l[u] = 0.f;
    }
    const bf16_t* kp = KNA + (bh * 2048 + rs[0] * 64 + kb + krow) * 64 + 8 * g;
    const bf16_t* vp = VNAT + ((bh * 32 + rs[0]) * 64 + c) * 64 + kb + 8 * g;
    const bf16_t* vq = vp + 2048;
#pragma unroll
    for (int t2 = 0; t2 < 2; ++t2)
#pragma unroll
      for (int s2 = 0; s2 < 2; ++s2) kf[t2 * 2 + s2] = *(const bf16x8*)(kp + (4 * t2) * 64 + 32 * s2);
    vn[0] = *(const bf16x8*)(vp); vn[1] = *(const bf16x8*)(vp + 1024);
    vn[2] = *(const bf16x8*)(vq); vn[3] = *(const bf16x8*)(vq + 1024);
    for (int i = 0; i < ni; ++i) {
      const int grow = rs[0] + i;
      f32x4 sc[NA_ROWS][2];
#pragma unroll
      for (int u = 0; u < NA_ROWS; ++u)
#pragma unroll
        for (int t2 = 0; t2 < 2; ++t2) {
          sc[u][t2][0] = 0.f; sc[u][t2][1] = 0.f; sc[u][t2][2] = 0.f; sc[u][t2][3] = 0.f;
          sc[u][t2] = __builtin_amdgcn_mfma_f32_16x16x32_bf16(kf[t2 * 2], q0[u], sc[u][t2], 0, 0, 0);
          sc[u][t2] = __builtin_amdgcn_mfma_f32_16x16x32_bf16(kf[t2 * 2 + 1], q1[u], sc[u][t2], 0, 0, 0);
        }
      if (i + 1 < ni) {
        kp += 4096;
#pragma unroll
        for (int t2 = 0; t2 < 2; ++t2)
#pragma unroll
          for (int s2 = 0; s2 < 2; ++s2) kf[t2 * 2 + s2] = *(const bf16x8*)(kp + (4 * t2) * 64 + 32 * s2);
      }
      bf16x8 pfr[NA_ROWS];
#pragma unroll
      for (int u = 0; u < NA_ROWS; ++u) {
        const float* brow = bl + h * 465 + (grow - rr[u] + 7) * 31;
        const unsigned lim = ((unsigned)(grow - rs[u]) < 8u) ? 16u : 0u;
        float mx = -INFINITY;
#pragma unroll
        for (int t2 = 0; t2 < 2; ++t2)
#pragma unroll
          for (int e = 0; e < 4; ++e) {
            const int kc = kb + 8 * g + 4 * t2 + e;
            const float pen = ((unsigned)(kc - cs) < lim) ? 0.f : -INFINITY;
            int dj = kc - qc + 15;
            dj = dj < 0 ? 0 : (dj > 30 ? 30 : dj);
            int bi = grow - rr[u] + 7; bi = bi < 0 ? 0 : (bi > 14 ? 14 : bi);
            sc[u][t2][e] = (sc[u][t2][e] + (bl + h * 465 + bi * 31)[dj]) + pen;
            mx = fmaxf(mx, sc[u][t2][e]);
          }
        (void)brow;
        mx = fmaxf(mx, __shfl_xor(mx, 16));
        { float t; asm("v_mov_b32 %1, %0\n\ts_nop 1\n\tv_permlane32_swap_b32 %0, %1\n\tv_max_f32 %0, %0, %1\n\ts_nop 1" : "+v"(mx), "=&v"(t)); }
        const float mnew = fmaxf(m[u], mx);
        const float alpha = fast_exp2(m[u] - mnew);
        m[u] = mnew;
#pragma unroll
        for (int t4 = 0; t4 < 4; ++t4) oacc[u][t4] *= alpha;
        float ps = 0.f;
#pragma unroll
        for (int t2 = 0; t2 < 2; ++t2)
#pragma unroll
          for (int e = 0; e < 4; ++e) { sc[u][t2][e] = fast_exp2(sc[u][t2][e] - mnew); ps += sc[u][t2][e]; }
        l[u] = l[u] * alpha + ps;
        u32x4 pu;
        asm volatile("s_nop 1\n\tv_cvt_pk_bf16_f32 %0, %4, %5\n\tv_cvt_pk_bf16_f32 %1, %6, %7\n\tv_cvt_pk_bf16_f32 %2, %8, %9\n\tv_cvt_pk_bf16_f32 %3, %10, %11"
                     : "=&v"(pu[0]), "=&v"(pu[1]), "=&v"(pu[2]), "=&v"(pu[3])
                     : "v"(sc[u][0][0]), "v"(sc[u][0][1]), "v"(sc[u][0][2]), "v"(sc[u][0][3]), "v"(sc[u][1][0]), "v"(sc[u][1][1]), "v"(sc[u][1][2]), "v"(sc[u][1][3]));
        pfr[u] = __builtin_bit_cast(bf16x8, pu);
      }
#pragma unroll
      for (int u = 0; u < NA_ROWS; ++u)
#pragma unroll
        for (int dvt = 0; dvt < 4; ++dvt) oacc[u][dvt] = __builtin_amdgcn_mfma_f32_16x16x32_bf16(vn[dvt], pfr[u], oacc[u][dvt], 0, 0, 0);
      if (i + 1 < ni) {
        vp += 4096; vq += 4096;
        vn[0] = *(const bf16x8*)(vp); vn[1] = *(const bf16x8*)(vp + 1024);
        vn[2] = *(const bf16x8*)(vq); vn[3] = *(const bf16x8*)(vq + 1024);
      }
    }
#pragma unroll
    for (int u = 0; u < NA_ROWS; ++u) {
      const float lt = xsum32(xsum16(l[u]));
      const float inv = 1.f / lt;
      bf16_t* dst = mix + ((size_t)b * 2048 + rr[u] * 64 + qc) * 1024 + h * 64 + 16 * (g & 1) + 8 * (g >> 1);
#pragma unroll
      for (int k = 0; k < 4; k += 2) {
        const unsigned ax = cvt_pk_bf16(oacc[u][k][0] * inv, oacc[u][k][1] * inv), ay = cvt_pk_bf16(oacc[u][k][2] * inv, oacc[u][k][3] * inv);
        const unsigned bx = cvt_pk_bf16(oacc[u][k + 1][0] * inv, oacc[u][k + 1][1] * inv), by = cvt_pk_bf16(oacc[u][k + 1][2] * inv, oacc[u][k + 1][3] * inv);
        const xl_u32x2 rx = __builtin_amdgcn_permlane16_swap(ax, bx, false, false);
        const xl_u32x2 ry = __builtin_amdgcn_permlane16_swap(ay, by, false, false);
        u32x4 o;
        o[0] = rx[0]; o[1] = ry[0]; o[2] = rx[1]; o[3] = ry[1];
        *(u32x4*)(dst + 16 * k) = o;
      }
    }
  }
  bf16_t* Ks = (bf16_t*)smem;
  bf16_t* Vs = (bf16_t*)(smem + 2 * 13312);
  if (SEL & 2)
  for (int it = blockIdx.x; it < 1024; it += gridDim.x) {
    const int item = (gridDim.x == 256) ? (((it & 7) << 7) | (it >> 3)) : it;
    const int bh = item >> 3, qt = item & 7;
    const int b = bh >> 3, h = bh & 7;
    const int q0 = qt * 256 + w * 32;
    bf16x8 qf[6];
#pragma unroll
    for (int s = 0; s < 6; ++s) qf[s] = *(const bf16x8*)(QM + ((size_t)bh * 2048 + q0 + r) * 96 + 16 * s + 8 * hh);
    {
      const float* rp = (const float*)(ws + OFF_ROPE) + (q0 + r) * 32 + 4 * hh;
#pragma unroll
      for (int s = 4; s < 6; ++s) {
        const f32x4 cs = *(const f32x4*)(rp + 8 * (s - 4)), sn = *(const f32x4*)(rp + 16 + 8 * (s - 4));
        const u32x4 qu = __builtin_bit_cast(u32x4, qf[s]);
        u32x4 o;
#pragma unroll
        for (int p = 0; p < 4; ++p) {
          const float x1 = bflo(qu[p]), x2 = bfhi(qu[p]);
          o[p] = cvt_pk_bf16(x1 * cs[p] - x2 * sn[p], x1 * sn[p] + x2 * cs[p]);
        }
        qf[s] = __builtin_bit_cast(bf16x8, o);
      }
    }
    f32x16 oacc[2];
#pragma unroll
    for (int t = 0; t < 2; ++t)
#pragma unroll
      for (int e = 0; e < 16; ++e) oacc[t][e] = 0.f;
    float m = 0.f, l = 0.f;
    const bf16_t* kg = KM + (size_t)bh * 2048 * 96;
    const bf16_t* vg = VMT + (size_t)bh * 64 * 2048;
    const bool k2 = tid < 256;
    const int klds0 = (tid / 12) * 104 + (tid % 12) * 8;
    const int klds1 = ((tid + 512) / 12) * 104 + ((tid + 512) % 12) * 8;
    const int vlds = (tid >> 3) * 72 + (tid & 7) * 8;
    const size_t vgo = (size_t)(tid >> 3) * 2048 + (tid & 7) * 8;
    u32x4 ak0, ak1 = {0u, 0u, 0u, 0u}, av, bk0, bk1 = {0u, 0u, 0u, 0u}, bv;
#define MLA_LOAD(K0, K1, V, tile) do { const bf16_t* kgn_ = kg + (size_t)(tile) * 64 * 96; \
      K0 = *(const u32x4*)(kgn_ + (size_t)tid * 8); if (k2) K1 = *(const u32x4*)(kgn_ + (size_t)(tid + 512) * 8); \
      V = *(const u32x4*)(vg + vgo + (tile) * 64); } while (0)
#define MLA_WRITE(K0, K1, V, buf) do { *(u32x4*)(Ks + (buf) * (64 * 104) + klds0) = K0; if (k2) *(u32x4*)(Ks + (buf) * (64 * 104) + klds1) = K1; \
      *(u32x4*)(Vs + (buf) * (64 * 72) + vlds) = V; } while (0)
#define MLA_COMPUTE(buf, FIRST) do { \
      const bf16_t* ks = Ks + (buf) * (64 * 104); const bf16_t* vs = Vs + (buf) * (64 * 72); \
      f32x16 sacc[2]; \
      _Pragma("unroll") for (int t = 0; t < 2; ++t) _Pragma("unroll") for (int e = 0; e < 16; ++e) sacc[t][e] = -m; \
      _Pragma("unroll") for (int kt = 0; kt < 2; ++kt) _Pragma("unroll") for (int s = 0; s < 6; ++s) { \
          const bf16x8 kf = *(const bf16x8*)(ks + (32 * kt + pr) * 104 + 16 * s + 8 * hh); sacc[kt] = MFMA32(kf, qf[s], sacc[kt]); } \
      bf16x8 pf[4]; softmax_step(sacc, m, l, oacc, pf, (FIRST)); \
      _Pragma("unroll") for (int dt = 0; dt < 2; ++dt) _Pragma("unroll") for (int s = 0; s < 4; ++s) { \
          const bf16x8 vf = *(const bf16x8*)(vs + (32 * dt + r) * 72 + 16 * s + 8 * hh); oacc[dt] = MFMA32(vf, pf[s], oacc[dt]); } } while (0)
    __syncthreads();
    MLA_LOAD(ak0, ak1, av, 0);
    MLA_LOAD(bk0, bk1, bv, 1);
    MLA_WRITE(ak0, ak1, av, 0);
    __syncthreads();
    for (int j = 0; j < 32; j += 2) {
      if (j + 2 < 32) MLA_LOAD(ak0, ak1, av, j + 2);
      MLA_COMPUTE(0, j == 0);
      __builtin_amdgcn_sched_barrier(0);
      MLA_WRITE(bk0, bk1, bv, 1);
      __syncthreads();
      if (j + 3 < 32) MLA_LOAD(bk0, bk1, bv, j + 3);
      MLA_COMPUTE(1, false);
      __builtin_amdgcn_sched_barrier(0);
      if (j + 2 < 32) MLA_WRITE(ak0, ak1, av, 0);
      __syncthreads();
    }
#undef MLA_LOAD
#undef MLA_WRITE
#undef MLA_COMPUTE
    store_o(oacc, l, mix + ((size_t)b * 2048 + q0 + r) * 1024 + 512 + h * 64, hh);
  }
}

DI void phase_ln1(const Params& P) {
  const int lane = otid() & 63, w = otid() >> 6;
  bf16_t* h1 = (bf16_t*)(P.ws + OFF_H);
  for (int tok = blockIdx.x * NW + w; tok < NTOK; tok += gridDim.x * NW) {
    float v[16];
#pragma unroll
    for (int g = 0; g < 4; ++g) {
      const u32x2 t = *(const u32x2*)((const bf16_t*)(P.ws + OFF_Y1) + (size_t)tok * 1024 + g * 256 + lane * 4);
      const u32x2 hv = *(const u32x2*)(h1 + (size_t)tok * 1024 + g * 256 + lane * 4);
      v[g * 4 + 0] = DN_ALPHA * bflo(hv[0]) + bflo(t[0]);
      v[g * 4 + 1] = DN_ALPHA * bfhi(hv[0]) + bfhi(t[0]);
      v[g * 4 + 2] = DN_ALPHA * bflo(hv[1]) + bflo(t[1]);
      v[g * 4 + 3] = DN_ALPHA * bfhi(hv[1]) + bfhi(t[1]);
    }
    ln_rows16(v, P.ln1g, P.ln1b, lane);
#pragma unroll
    for (int g = 0; g < 4; ++g) {
      u32x2 o;
      o[0] = cvt_pk_bf16(v[g * 4 + 0], v[g * 4 + 1]);
      o[1] = cvt_pk_bf16(v[g * 4 + 2], v[g * 4 + 3]);
      *(u32x2*)(h1 + (size_t)tok * 1024 + g * 256 + lane * 4) = o;
    }
  }
}

#define CE_DESC(a, b) { const float _hi = fmaxf(a, b), _lo = fminf(a, b); a = _hi; b = _lo; }
DI void sort16_desc(float (&v)[16]) {
#define S2(a, b) CE_DESC(v[a], v[b])
  S2(0, 13) S2(1, 12) S2(2, 15) S2(3, 14) S2(4, 8) S2(5, 6) S2(7, 11) S2(9, 10)
  S2(0, 5) S2(1, 7) S2(2, 9) S2(3, 4) S2(6, 13) S2(8, 14) S2(10, 15) S2(11, 12)
  S2(0, 1) S2(2, 3) S2(4, 5) S2(6, 8) S2(7, 9) S2(10, 11) S2(12, 13) S2(14, 15)
  S2(0, 2) S2(1, 3) S2(4, 10) S2(5, 11) S2(6, 7) S2(8, 9) S2(12, 14) S2(13, 15)
  S2(1, 2) S2(3, 12) S2(4, 6) S2(5, 7) S2(8, 10) S2(9, 11) S2(13, 14)
  S2(1, 4) S2(2, 6) S2(5, 8) S2(7, 10) S2(9, 13) S2(11, 14)
  S2(2, 4) S2(3, 6) S2(9, 12) S2(11, 13)
  S2(3, 5) S2(6, 8) S2(7, 9) S2(10, 12)
  S2(3, 4) S2(5, 6) S2(7, 8) S2(9, 10) S2(11, 12)
  S2(6, 7) S2(8, 9)
#undef S2
}
DI void merge16_desc(float (&a)[16], const float (&b)[16]) {
#pragma unroll
  for (int i = 0; i < 16; ++i) a[i] = fmaxf(a[i], b[15 - i]);
#pragma unroll
  for (int jj = 3; jj >= 0; --jj)
#pragma unroll
    for (int i = 0; i < 16; ++i) {
      const int j = 1 << jj, l = i ^ j;
      if (l > i) CE_DESC(a[i], a[l])
    }
}
DI float pack_code(float v, unsigned mask, unsigned code) { return __uint_as_float((__float_as_uint(v) & mask) | code); }

DI void phase_select(const Params& P, char* smem) {
  char* ws = P.ws;
  const bf16_t* qp = (const bf16_t*)(ws + OFF_QP);
  const bf16_t* subk = (const bf16_t*)(ws + OFF_SUBK);
  unsigned short* idx_out = (unsigned short*)(ws + OFF_IDX);
  float* g_out = (float*)(ws + OFF_GW);
  const int tid = otid(), lane = tid & 63, w = tid >> 6;
  const int r = lane & 31, hh = lane >> 5;
  bf16_t* sk = (bf16_t*)smem;
  float* lst = (float*)(smem + 69632) + w * 1024;
  __syncthreads();
  {
    const bf16_t* sg = subk + tid * 8;
    bf16_t* sl = sk + (tid >> 4) * 136 + (tid & 15) * 8;
#pragma unroll
    for (int c = 0; c < 2; ++c)
#pragma unroll
      for (int i = 0; i < 4; ++i)
        *(u32x4*)(sl + c * (128 * 136) + i * (32 * 136)) = *(const u32x4*)(sg + c * 16384 + i * 4096);
  }
  __syncthreads();
  pg8::StaticOrder S;
  S.init(NTOK, 3072, (int)gridDim.x, (int)blockIdx.x);
  pg8::Unit uu;
  for (int ui = 0; S.next(ui, uu); ++ui) {
    if (uu.pn < 4) continue;
    const int tg = uu.pm * 8 + w, h = uu.pn - 4;
    const int tok = tg * 32 + r;
    float L[2][16];
#pragma unroll
    for (int c = 0; c < 2; ++c) {
      f32x16 sacc[4];
#pragma unroll
      for (int t = 0; t < 4; ++t)
#pragma unroll
        for (int e = 0; e < 16; ++e) sacc[t][e] = 0.f;
      const bf16_t* qrow = qp + ((size_t)(tg * 256 + h * 32 + c * 16 + hh) * 32 + r) * 8;
#pragma unroll 2
      for (int s = 0; s < 8; ++s) {
        const bf16x8 bq = *(const bf16x8*)(qrow + 512 * s);
#pragma unroll
        for (int kt = 0; kt < 4; ++kt) {
          const bf16x8 ak = *(const bf16x8*)(sk + c * (128 * 136) + (32 * kt + r) * 136 + 16 * s + 8 * hh);
          sacc[kt] = MFMA32(ak, bq, sacc[kt]);
        }
      }
      float T[4][16];
#pragma unroll
      for (int kt = 0; kt < 4; ++kt) {
#pragma unroll
        for (int e = 0; e < 16; ++e)
          T[kt][e] = pack_code(sacc[kt][e], 0xFFFFFF80u, (unsigned)(32 * kt + (e & 3) + 8 * (e >> 2)));
        sort16_desc(T[kt]);
      }
      merge16_desc(T[0], T[1]);
      merge16_desc(T[2], T[3]);
      merge16_desc(T[0], T[2]);
      {
        const unsigned hb = (unsigned)hh << 2;
#pragma unroll
        for (int i = 0; i < 16; ++i) T[0][i] = __uint_as_float(__float_as_uint(T[0][i]) | hb);
      }
      float Pn[16];
#pragma unroll
      for (int i = 0; i < 16; ++i) {
        const xl_u32x2 sw = __builtin_amdgcn_permlane32_swap(__float_as_uint(T[0][i]), __float_as_uint(T[0][i]), false, false);
        Pn[i] = __uint_as_float(hh ? sw[0] : sw[1]);
      }
      merge16_desc(T[0], Pn);
#pragma unroll
      for (int i = 0; i < 16; ++i) L[c][i] = T[0][i];
    }
    float A0[16], B1[16], C2[16], D3[16];
#pragma unroll
    for (int j = 0; j < 16; ++j) A0[j] = pack_code(L[0][0] + L[1][j], 0xFFFFFF00u, (unsigned)j);
#pragma unroll
    for (int j = 0; j < 16; ++j) B1[j] = (j < 8) ? pack_code(L[0][1] + L[1][j], 0xFFFFFF00u, (unsigned)(16 + j)) : -INFINITY;
    {
      int n = 0;
#pragma unroll
      for (int i = 2; i <= 4; ++i)
#pragma unroll
        for (int j = 0; j < 16 / (i + 1); ++j) { C2[n] = pack_code(L[0][i] + L[1][j], 0xFFFFFF00u, (unsigned)(16 * i + j)); ++n; }
#pragma unroll
      for (int q = 12; q < 16; ++q) C2[q] = -INFINITY;
      n = 0;
#pragma unroll
      for (int i = 5; i <= 15; ++i)
#pragma unroll
        for (int j = 0; j < 16 / (i + 1); ++j) { D3[n] = pack_code(L[0][i] + L[1][j], 0xFFFFFF00u, (unsigned)(16 * i + j)); ++n; }
      D3[14] = -INFINITY; D3[15] = -INFINITY;
    }
    sort16_desc(C2);
    sort16_desc(D3);
    merge16_desc(A0, B1);
    merge16_desc(C2, D3);
    merge16_desc(A0, C2);
    if (hh == 0) {
#pragma unroll
      for (int i = 0; i < 16; ++i) {
        lst[i * 32 + r] = L[0][i];
        lst[(16 + i) * 32 + r] = L[1][i];
      }
    }
    float cv[16];
    int eid[16];
#pragma unroll
    for (int k = 0; k < 16; ++k) {
      const unsigned code = __float_as_uint(A0[k]) & 255u;
      const float v1 = lst[(code >> 4) * 32 + r];
      const float v2 = lst[(16 + (code & 15u)) * 32 + r];
      cv[k] = v1 + v2;
      eid[k] = (int)((__float_as_uint(v1) & 127u) * 128u + (__float_as_uint(v2) & 127u));
    }
    float mx = cv[0];
#pragma unroll
    for (int k = 1; k < 16; ++k) mx = fmaxf(mx, cv[k]);
    float sum = 0.f;
#pragma unroll
    for (int k = 0; k < 16; ++k) { cv[k] = __expf(cv[k] - mx); sum += cv[k]; }
    const float inv = 1.f / sum;
    const size_t o = (size_t)tok * 128 + h * 16;
    if (hh == 0) {
#pragma unroll
      for (int q = 0; q < 2; ++q) {
        u32x4 t;
#pragma unroll
        for (int c = 0; c < 4; ++c) t[c] = (unsigned)eid[8 * q + 2 * c] | ((unsigned)eid[8 * q + 2 * c + 1] << 16);
        *(u32x4*)(idx_out + (size_t)tok * 128 + q * 64 + h * 8) = t;
      }
    } else {
#pragma unroll
      for (int q = 0; q < 4; ++q) {
        f32x4 t;
#pragma unroll
        for (int c = 0; c < 4; ++c) t[c] = cv[4 * q + c] * inv;
        *(f32x4*)(g_out + o + 4 * q) = t;
      }
    }
  }
}

constexpr unsigned PEER_CHUNK_TOK = 32;
constexpr unsigned PEER_NCHUNK = NTOK / PEER_CHUNK_TOK;

#define PSB() __builtin_amdgcn_sched_barrier(0)
struct PeerTok { int j, tok; bool done; };
struct PeerStream { unsigned* qc; unsigned xcc, qq, pend; int j, tok, left; bool done; };
DI void ps_init(PeerStream& s, unsigned* qc, unsigned xcc, int lane) {
  (void)lane;
  s.qc = qc; s.xcc = xcc; s.qq = 0; s.j = (int)(xcc & 7u); s.tok = 0; s.left = 0; s.done = false; s.pend = 0;
}
DI PeerTok ps_next(PeerStream& s, int lane) {
  if (!s.done) {
    if (s.left > 0) { ++s.tok; --s.left; }
    else {
      for (;;) {
        unsigned p = 0;
        if (lane == 0) p = __hip_atomic_fetch_add(s.qc + s.j * 64, 1u, __ATOMIC_RELAXED, __HIP_MEMORY_SCOPE_AGENT);
        const unsigned c = (unsigned)__builtin_amdgcn_readfirstlane((int)p);
        if (c < PEER_NCHUNK) { s.tok = (int)(c * PEER_CHUNK_TOK); s.left = (int)PEER_CHUNK_TOK - 1; break; }
        if (++s.qq == 8u) { s.done = true; break; }
        s.j = (int)((s.xcc + s.qq) & 7u);
      }
    }
  }
  PeerTok e; e.j = s.j; e.tok = s.tok; e.done = s.done;
  return e;
}
struct PeerIds { u32x4 q[2]; };
DI unsigned pp_rowoff(const PeerIds& I, int k, unsigned cb) {
  unsigned r;
  const unsigned w = I.q[k >> 3][(k & 7) >> 1], c128 = 128u;
  if (k & 1) asm("v_mad_u32_u16 %0, %1, %2, %3 op_sel:[1,0,0,0]" : "=v"(r) : "v"(w), "s"(c128), "v"(cb));
  else asm("v_mad_u32_u16 %0, %1, %2, %3" : "=v"(r) : "v"(w), "s"(c128), "v"(cb));
  return r;
}
DI void pp_ids(PeerIds& I, const Params& P, const PeerTok& e) {
  const int lane = otid() & 63;
  const unsigned short* ip = (const unsigned short*)(P.ws + OFF_IDX) + (size_t)e.tok * 128 + (lane >> 3) * 8;
#pragma unroll
  for (int q = 0; q < 2; ++q) I.q[q] = *(const u32x4*)(ip + 64 * q);
}
struct PeerSet { u32x4 xa, xb; u32x4 uv[16]; };
template <int PASS>
DI void pp_gather(PeerSet& S, const PeerIds& I, const Params& P, const PeerTok& e) {
  const int lane = otid() & 63;
  const int ch = lane & 7;
  const unsigned char* T8 = (const unsigned char*)(P.ws + (PASS == 0 ? OFF_UBF : OFF_VBF)) + (size_t)e.j * SLICE_BYTES;
  const unsigned cb = (unsigned)ch * 16u;
#pragma unroll
  for (int i = 0; i < 16; ++i) S.uv[i] = *(const u32x4*)(T8 + pp_rowoff(I, i, cb));
  if (PASS == 0) {
    const bf16_t* xp = (const bf16_t*)(P.ws + OFF_H) + (size_t)e.tok * 1024 + e.j * 128 + ch * 16;
    S.xa = *(const u32x4*)xp; S.xb = *(const u32x4*)(xp + 8);
  } else {
    const bf16_t* ap = (const bf16_t*)(P.ws + OFF_ACT) + (size_t)e.tok * 128 + (lane >> 3) * 8;
    S.xa = *(const u32x4*)ap; S.xb = *(const u32x4*)(ap + 64);
  }
}
typedef short pp_s16x4 __attribute__((ext_vector_type(4)));
typedef __bf16 pp_bf16x2 __attribute__((ext_vector_type(2)));
template <int PASS, int MODE>
DI void pp_step(const PeerSet& C, PeerSet& N, const PeerIds& IN, const Params& P, const PeerTok& ec, const PeerTok& en) {
  const int lane = otid() & 63;
  const int eg = lane >> 3, ch = lane & 7;
  const unsigned char* T8 = (const unsigned char*)(P.ws + (PASS == 0 ? OFF_UBF : OFF_VBF)) + (size_t)en.j * SLICE_BYTES;
  const unsigned cb = (unsigned)ch * 16u;
  if (PASS == 0) {
    const bf16_t* xp = (const bf16_t*)(P.ws + OFF_H) + (size_t)en.tok * 1024 + en.j * 128 + ch * 16;
    N.xa = *(const u32x4*)xp; N.xb = *(const u32x4*)(xp + 8);
  } else {
    const bf16_t* ap = (const bf16_t*)(P.ws + OFF_ACT) + (size_t)en.tok * 128 + eg * 8;
    N.xa = *(const u32x4*)ap; N.xb = *(const u32x4*)(ap + 64);
  }
  PSB();
  if (PASS == 0) {
    pp_s16x4 xg[4];
    { const u32x2 t0 = {C.xa[0], C.xa[1]}, t1 = {C.xa[2], C.xa[3]}, t2 = {C.xb[0], C.xb[1]}, t3 = {C.xb[2], C.xb[3]};
      xg[0] = __builtin_bit_cast(pp_s16x4, t0); xg[1] = __builtin_bit_cast(pp_s16x4, t1);
      xg[2] = __builtin_bit_cast(pp_s16x4, t2); xg[3] = __builtin_bit_cast(pp_s16x4, t3); }
    float keep0 = 0.f, keep1 = 0.f;
    f32x4 accp = {0.f, 0.f, 0.f, 0.f};
#define PA_REDUCE(ri)                                                                                                     \
    {                                                                                                                     \
      const float d0 = accp[0], d1 = accp[1], d2 = accp[2], d3 = accp[3];     \
      float sm = __builtin_bit_cast(float, __builtin_amdgcn_update_dpp(0, __builtin_bit_cast(int, d0), 0x00, 0xF, 0xF, true)); \
      sm += __builtin_bit_cast(float, __builtin_amdgcn_update_dpp(0, __builtin_bit_cast(int, d1), 0x55, 0xF, 0xF, true));  \
      sm += __builtin_bit_cast(float, __builtin_amdgcn_update_dpp(0, __builtin_bit_cast(int, d2), 0xAA, 0xF, 0xF, true));  \
      sm += __builtin_bit_cast(float, __builtin_amdgcn_update_dpp(0, __builtin_bit_cast(int, d3), 0xFF, 0xF, 0xF, true));  \
      sm += __builtin_bit_cast(float, __builtin_amdgcn_update_dpp(0, __builtin_bit_cast(int, sm), 0x141, 0xF, 0xF, true));  \
      if (((ri) & 1) == 0) { if (ch == ((ri) >> 1)) keep0 = sm; }                                                         \
      else { if (ch == ((ri) >> 1)) keep1 = sm; }                                                                         \
    }
#pragma unroll
    for (int i = 0; i < 16; ++i) {
      if (MODE != 2) N.uv[i] = *(const u32x4*)(T8 + pp_rowoff(IN, i, cb));
      PSB();
      if (MODE != 1) {
        f32x4 acc = {0.f, 0.f, 0.f, 0.f};
#pragma unroll
        for (int g = 0; g < 4; ++g) {
          const pp_bf16x2 lo = __builtin_amdgcn_cvt_scalef32_pk_bf16_fp8((int)C.uv[i][g], 1.0f, false);
          const pp_bf16x2 hi = __builtin_amdgcn_cvt_scalef32_pk_bf16_fp8((int)C.uv[i][g], 1.0f, true);
          const u32x2 av = {__builtin_bit_cast(unsigned, lo), __builtin_bit_cast(unsigned, hi)};
          acc = __builtin_amdgcn_mfma_f32_4x4x4bf16_1k(__builtin_bit_cast(pp_s16x4, av), xg[g], acc, 0, 0, 0);
        }
        if (i > 0) PA_REDUCE(i - 1)
        accp = acc;
      }
      asm volatile("" : "+v"(keep0), "+v"(keep1), "+v"(accp) : : "memory");
      PSB();
    }
    if (MODE != 1) PA_REDUCE(15)
#undef PA_REDUCE
    bf16_t* pa = (bf16_t*)(P.ws + OFF_PA) + ((size_t)ec.j * NTOK + ec.tok) * 128 + eg * 16 + 2 * ch;
    *(unsigned*)pa = cvt_pk_bf16(keep0, keep1);
  } else {
    const int q = lane & 3;
    const unsigned lo16 = 0x0c0c0504u, hi16 = 0x05040c0cu, zz = 0x0c0c0c0cu;
    const unsigned s0e = q == 0 ? lo16 : (q == 1 ? hi16 : zz), s1e = q == 2 ? lo16 : (q == 3 ? hi16 : zz);
    const unsigned s0o = q == 0 ? lo16 + 0x0202u : (q == 1 ? hi16 + 0x02020000u : zz), s1o = q == 2 ? lo16 + 0x0202u : (q == 3 ? hi16 + 0x02020000u : zz);
    f32x4 ag[4];
#pragma unroll
    for (int g = 0; g < 4; ++g) ag[g] = f32x4{0.f, 0.f, 0.f, 0.f};
#pragma unroll
    for (int i = 0; i < 16; ++i) {
      if (MODE != 2) N.uv[i] = *(const u32x4*)(T8 + pp_rowoff(IN, i, cb));
      PSB();
      if (MODE != 1) {
        const unsigned aw = (i < 8) ? C.xa[(i & 7) >> 1] : C.xb[(i & 7) >> 1];
        const u32x2 asel = {__builtin_amdgcn_perm(aw, 0u, (i & 1) ? s0o : s0e), __builtin_amdgcn_perm(aw, 0u, (i & 1) ? s1o : s1e)};
        const pp_s16x4 av = __builtin_bit_cast(pp_s16x4, asel);
#pragma unroll
        for (int g = 0; g < 4; ++g) {
          const pp_bf16x2 lo = __builtin_amdgcn_cvt_scalef32_pk_bf16_fp8((int)C.uv[i][g], 1.0f, false);
          const pp_bf16x2 hi = __builtin_amdgcn_cvt_scalef32_pk_bf16_fp8((int)C.uv[i][g], 1.0f, true);
          const u32x2 bv = {__builtin_bit_cast(unsigned, lo), __builtin_bit_cast(unsigned, hi)};
          ag[g] = __builtin_amdgcn_mfma_f32_4x4x4bf16_1k(av, __builtin_bit_cast(pp_s16x4, bv), ag[g], 0, 0, 0);
        }
      }
      asm volatile("" : "+v"(ag[0]), "+v"(ag[1]), "+v"(ag[2]), "+v"(ag[3]) : : "memory");
      PSB();
    }
    f32x2 acc[8];
#pragma unroll
    for (int g = 0; g < 4; ++g) {
      const f32x4 t = ag[g];
      acc[2 * g][0] = t[0]; acc[2 * g][1] = t[1]; acc[2 * g + 1][0] = t[2]; acc[2 * g + 1][1] = t[3];
    }
    const bool b3 = (lane & 8) != 0, b4 = (lane & 16) != 0, b5 = (lane & 32) != 0;
    f32x2 r1[4], r2[2], r3;
#pragma unroll
    for (int m = 0; m < 4; ++m)
#pragma unroll
      for (int c = 0; c < 2; ++c) {
        const float snd = b3 ? acc[m][c] : acc[m + 4][c];
        const float kp = b3 ? acc[m + 4][c] : acc[m][c];
        r1[m][c] = kp + __builtin_bit_cast(float, __builtin_amdgcn_update_dpp(0, __builtin_bit_cast(int, snd), 0x128, 0xF, 0xF, true));
      }
#pragma unroll
    for (int m = 0; m < 2; ++m)
#pragma unroll
      for (int c = 0; c < 2; ++c) {
        const float ke = r1[m][c], ko = r1[m + 2][c];
        const xl_u32x2 sw = __builtin_amdgcn_permlane16_swap(__float_as_uint(ke), __float_as_uint(ko), false, false);
        r2[m][c] = __uint_as_float(sw[0]) + __uint_as_float(sw[1]);
      }
#pragma unroll
    for (int c = 0; c < 2; ++c) {
      const float kl = r2[0][c], kh = r2[1][c];
      const xl_u32x2 sw = __builtin_amdgcn_permlane32_swap(__float_as_uint(kl), __float_as_uint(kh), false, false);
      r3[c] = __uint_as_float(sw[0]) + __uint_as_float(sw[1]);
    }
    const int mstar = (b3 ? 4 : 0) + (b4 ? 2 : 0) + (b5 ? 1 : 0);
    bf16_t* op = (bf16_t*)(P.ws + OFF_FFN) + (size_t)ec.tok * 1024 + ec.j * 128 + ch * 16 + 2 * mstar;
    *(unsigned*)op = cvt_pk_bf16(r3[0], r3[1]);
  }
}

template <int PASS, int QSET = PASS, int MODE = 0>
DI void phase_peer_pass(const Params& P, unsigned xcc) {
  const int lane = otid() & 63;
  PeerStream st;
  ps_init(st, (unsigned*)(P.ws + OFF_QUEUE) + QSET * 8 * 64, xcc, lane);
  PeerIds I0, I1;
  PeerSet A, B;
  PeerTok ec = ps_next(st, lane);
  pp_ids(I0, P, ec);
  PeerTok en = ps_next(st, lane);
  pp_ids(I1, P, en);
  PSB();
  pp_gather<PASS>(A, I0, P, ec);
  PSB();
  for (;;) {
    if (ec.done) break;
    PeerTok e2 = ps_next(st, lane);
    pp_ids(I0, P, e2); PSB();
    pp_step<PASS, MODE>(A, B, I1, P, ec, en); PSB();
    if (en.done) break;
    PeerTok e3 = ps_next(st, lane);
    pp_ids(I1, P, e3); PSB();
    pp_step<PASS, MODE>(B, A, I0, P, en, e2); PSB();
    ec = e2; en = e3;
  }
}

DI void phase_peer_act(const Params& P, char* smem) {
  char* ws = P.ws;
  const bf16_t* pa = (const bf16_t*)(ws + OFF_PA);
  const unsigned short* idx = (const unsigned short*)(ws + OFF_IDX);
  const float* gw = (const float*)(ws + OFF_GW);
  bf16_t* act = (bf16_t*)(ws + OFF_ACT);
  float LAS* lsu = (float LAS*)smem;
  float LAS* lsv = (float LAS*)(smem + 65536);
  __syncthreads();
  for (int i = otid(); i < 16384 / 4; i += NT) {
    *(f32x4 LAS*)(lsu + 4 * i) = *(const f32x4*)((const float*)(ws + OFF_SU) + 4 * i);
    *(f32x4 LAS*)(lsv + 4 * i) = *(const f32x4*)((const float*)(ws + OFF_SV) + 4 * i);
  }
  __syncthreads();
  for (size_t i8 = (size_t)blockIdx.x * NT + otid(); i8 < (size_t)NTOK * 16; i8 += (size_t)gridDim.x * NT) {
    const size_t i = i8 * 8;
    float sm[8];
#pragma unroll
    for (int c = 0; c < 8; ++c) sm[c] = 0.f;
#pragma unroll
    for (int j = 0; j < 8; ++j) {
      const u32x4 t = *(const u32x4*)(pa + (size_t)j * NTOK * 128 + i);
#pragma unroll
      for (int c = 0; c < 4; ++c) { sm[2 * c] += bflo(t[c]); sm[2 * c + 1] += bfhi(t[c]); }
    }
    const size_t ib = (i & ~(size_t)127) + ((i >> 3) & 1) * 64 + ((i & 127) >> 4) * 8;
    const u32x4 iw = *(const u32x4*)(idx + ib);
    const f32x4 ga = *(const f32x4*)(gw + i), gb = *(const f32x4*)(gw + i + 4);
    float o[8];
#pragma unroll
    for (int c = 0; c < 8; ++c) {
      const unsigned w2 = iw[c >> 1];
      const int id = (int)((c & 1) ? (w2 >> 16) : (w2 & 0xffffu));
      const float g = c < 4 ? ga[c & 3] : gb[c & 3];
      const float hp = sm[c] * lsu[id];
      o[c] = g * 0.5f * hp * (1.f + erff(hp * 0.70710678118654752f)) * lsv[id];
    }
    u32x4 ov;
#pragma unroll
    for (int c = 0; c < 4; ++c) ov[c] = cvt_pk_bf16(o[2 * c], o[2 * c + 1]);
    *(u32x4*)(act + ib) = ov;
  }
  __syncthreads();
}

DI void phase_ln2(const Params& P) {
  const int lane = otid() & 63, w = otid() >> 6;
  const bf16_t* h1 = (const bf16_t*)(P.ws + OFF_H);
  const bf16_t* G = (const bf16_t*)(P.ws + OFF_G);
  const bf16_t* ppo = (const bf16_t*)P.out;
  for (int tok = blockIdx.x * NW + w; tok < NTOK; tok += gridDim.x * NW) {
    float v[16];
    float* orow = P.out + (size_t)tok * 1024;
#pragma unroll
    for (int g = 0; g < 4; ++g) {
      const size_t o = (size_t)tok * 1024 + g * 256 + lane * 4;
      const u32x2 t = *(const u32x2*)((const bf16_t*)(P.ws + OFF_FFN) + o);
      const u32x2 hv = *(const u32x2*)(h1 + o), gv = *(const u32x2*)(G + o), pv = *(const u32x2*)(ppo + (size_t)tok * 2048 + 1024 + g * 256 + lane * 4);
      v[g * 4 + 0] = DN_ALPHA * bflo(hv[0]) + bflo(gv[0]) * bflo(pv[0]) + bflo(t[0]);
      v[g * 4 + 1] = DN_ALPHA * bfhi(hv[0]) + bfhi(gv[0]) * bfhi(pv[0]) + bfhi(t[0]);
      v[g * 4 + 2] = DN_ALPHA * bflo(hv[1]) + bflo(gv[1]) * bflo(pv[1]) + bflo(t[1]);
      v[g * 4 + 3] = DN_ALPHA * bfhi(hv[1]) + bfhi(gv[1]) * bfhi(pv[1]) + bfhi(t[1]);
    }
    ln_rows16(v, P.ln2g, P.ln2b, lane);
#pragma unroll
    for (int g = 0; g < 4; ++g) {
      f32x4 o;
#pragma unroll
      for (int c = 0; c < 4; ++c) o[c] = v[g * 4 + c];
      *(f32x4*)(orow + g * 256 + lane * 4) = o;
    }
  }
}

#define XB_TMO      128
#define XB_XCNT(j)  (256  + 64 * (j))
#define XB_XSUB(j)  (1280 + 64 * (j))
#define XB_XGEN(j)  (2304 + 64 * (j))
#define XB_TOP      3328
#define XB_TOPGEN   3392
#define XCD_BAR_WORDS 3456
#define XB_SPIN_CAP (1u << 22)
DI unsigned xb_ld(unsigned* p) { return __hip_atomic_load(p, __ATOMIC_RELAXED, __HIP_MEMORY_SCOPE_AGENT); }
DI unsigned xb_add(unsigned* p, unsigned v) { return __hip_atomic_fetch_add(p, v, __ATOMIC_RELAXED, __HIP_MEMORY_SCOPE_AGENT); }
DI unsigned xb_xcc_id() { return (unsigned)__builtin_amdgcn_s_getreg((3 << 11) | 20) & 0xFu; }
#define XB_SPIN(cond, bar) do { unsigned _sp = 0; while (cond) { __builtin_amdgcn_s_sleep(1); \
    if ((++_sp & 255u) == 0u) { if (xb_ld(&(bar)[XB_TMO])) break; if (_sp > XB_SPIN_CAP) { atomicAdd(&(bar)[XB_TMO], 1u); break; } } } } while (0)
struct XcdBarrier { unsigned* bar; unsigned x; volatile LAS unsigned* st; };
DI XcdBarrier xcd_barrier_post(unsigned* bar, volatile LAS unsigned* st) {
  XcdBarrier b; b.bar = bar; b.x = xb_xcc_id(); b.st = st;
  if (otid() == 0) (void)xb_add(&bar[XB_XCNT(b.x)], 1u);
  return b;
}
DI void xcd_barrier_complete(unsigned* bar, unsigned x, unsigned& nloc, unsigned& nx) {
  const unsigned G = gridDim.x * gridDim.y * gridDim.z;
  unsigned sum, cnt, mine, sp = 0u;
  for (;;) {
    sum = 0u; cnt = 0u; mine = 0u;
#pragma unroll
    for (unsigned j = 0; j < 16; ++j) { const unsigned c = xb_ld(&bar[XB_XCNT(j)]); sum += c; cnt += (c > 0u) ? 1u : 0u; mine = (j == x) ? c : mine; }
    if (sum == G) break;
    __builtin_amdgcn_s_sleep(1);
    if ((++sp & 255u) == 0u) { if (xb_ld(&bar[XB_TMO])) break; if (sp > XB_SPIN_CAP) { atomicAdd(&bar[XB_TMO], 1u); break; } }
  }
  nloc = mine > 0u ? mine : 1u; nx = cnt > 0u ? cnt : 1u;
}
DI void xcd_barrier(const XcdBarrier& b) {
  asm volatile("s_waitcnt vmcnt(0)" ::: "memory");
  __syncthreads();
  if (otid() == 0) {
    unsigned* bar = b.bar;
    __builtin_amdgcn_s_waitcnt(0);
    unsigned nloc = b.st[0], nx = b.st[1];
    if (nloc == 0u) { xcd_barrier_complete(bar, b.x, nloc, nx); b.st[0] = nloc; b.st[1] = nx; }
    const unsigned old = xb_add(&bar[XB_XSUB(b.x)], 1u);
    const unsigned gen = old / nloc;
    if (old + 1u == (gen + 1u) * nloc) {
      __builtin_amdgcn_fence(__ATOMIC_RELEASE, "agent");
      asm volatile("s_waitcnt vmcnt(0)" ::: "memory");
      const unsigned og = xb_add(&bar[XB_TOP], 1u);
      const unsigned tg = og / nx;
      if (og + 1u == (tg + 1u) * nx) {
#pragma unroll
        for (unsigned j = 0; j < 16; ++j) (void)xb_add(&bar[XB_XGEN(j)], 1u);
      }
    }
    XB_SPIN(xb_ld(&bar[XB_XGEN(b.x)]) == gen, bar);
    __builtin_amdgcn_fence(__ATOMIC_ACQUIRE, "agent");
    asm volatile("s_waitcnt vmcnt(0)" ::: "memory");
  }
  __syncthreads();
}


template <int PH>
DI void run_phase(const Params& P, char* smem, unsigned xcc) {
  char* ws = P.ws;
  if constexpr (PH == 0) {
    phase0(P, smem);
  } else if constexpr (PH == 1) {
    EpiInMain e{(bf16_t*)(ws + OFF_QNA), (bf16_t*)(ws + OFF_KNA), (bf16_t*)(ws + OFF_CQ), (bf16_t*)(ws + OFF_CKV), (float*)(ws + OFF_KR)};
    run_gemm((const bf16_t*)(ws + OFF_H), (const bf16_t*)(ws + OFF_WINA), NTOK, 1792, 1024, smem, e);
    {
      EpiPle ep{(bf16_t*)P.out};
      if ((int)gridDim.x == 256) { if ((int)blockIdx.x >= 128) run_gemm((const bf16_t*)(ws + OFF_PB), (const bf16_t*)(ws + OFF_PLEWT), NTOK, 1024, 256, smem, ep, 128, (int)blockIdx.x - 128); }
      else run_gemm((const bf16_t*)(ws + OFF_PB), (const bf16_t*)(ws + OFF_PLEWT), NTOK, 1024, 256, smem, ep);
    }
    EpiVT ev{(bf16_t*)(ws + OFF_VNAT), 1};
    run_gemm((const bf16_t*)(ws + OFF_WINV), (const bf16_t*)(ws + OFF_H), 512, NTOK, 1024, smem, ev);
  } else if constexpr (PH == 2) {
    phase_stats(P);
  } else if constexpr (PH == 3) {
#ifndef P3SEL
#define P3SEL 7
#endif
    if (P3SEL & 1) {
    EpiUpQ eq{(bf16_t*)(ws + OFF_QM)};
    run_gemm((const bf16_t*)(ws + OFF_CQ), (const bf16_t*)(ws + OFF_WUQT), NTOK, 768, 384, smem, eq);
    }
    if (P3SEL & 2) {
    EpiUpK ek{(bf16_t*)(ws + OFF_KM)};
    run_gemm((const bf16_t*)(ws + OFF_CKV), (const bf16_t*)(ws + OFF_WUKT), NTOK, 512, 256, smem, ek);
    }
    if (P3SEL & 4) {
    EpiVT ev{(bf16_t*)(ws + OFF_VMT), 0};
    run_gemm((const bf16_t*)(ws + OFF_WUVT), (const bf16_t*)(ws + OFF_CKV), 512, NTOK, 256, smem, ev);
    }
  } else if constexpr (PH == 4) {
    phase_attn<3>(P, smem);
  } else if constexpr (PH == 5) {
    EpiWo e{(bf16_t*)(ws + OFF_Y1)};
    run_gemm((const bf16_t*)(ws + OFF_MIX), (const bf16_t*)(ws + OFF_WOT), NTOK, 1024, 1024, smem, e);
  } else if constexpr (PH == 6) {
    phase_ln1(P);
  } else if constexpr (PH == 7) {
    float LAS* gbl = (float LAS*)(smem + SMEM_BYTES + 16);
    __syncthreads();
    for (int i = otid(); i < 1024; i += NT) gbl[i] = P.gate_b[i];
    __syncthreads();
    EpiGateQ e{gbl, (bf16_t*)(ws + OFF_G), (bf16_t*)(ws + OFF_QP)};
    run_gemm((const bf16_t*)(ws + OFF_H), (const bf16_t*)(ws + OFF_GATEWT), NTOK, 3072, 1024, smem, e);
    phase_select(P, smem);
  } else if constexpr (PH == 8) {
  } else if constexpr (PH == 9) {
    phase_peer_pass<0>(P, xcc);
  } else if constexpr (PH == 10) {
    phase_peer_act(P, smem);
  } else if constexpr (PH == 11) {
    phase_peer_pass<1>(P, xcc);
  } else if constexpr (PH == 12) {
    phase_ln2(P);
  }
}

#ifndef REP_PHASE
#define REP_PHASE -1
#endif
#define GSYNC() xcd_barrier(xb)
#define RUNP(k) do { if (REP_PHASE == (k) && (k) != 9) { run_phase<k>(P, smem, xb.x); GSYNC(); } run_phase<k>(P, smem, xb.x); } while (0)

__global__ void __launch_bounds__(512, 2) k_mega(Params P) {
  extern __shared__ __attribute__((aligned(16))) char smem[];
  cg::grid_group grid = cg::this_grid();
  if (P.ws == nullptr) grid.sync();
  volatile LAS unsigned* st = (volatile LAS unsigned*)(smem + SMEM_BYTES);
  if (threadIdx.x < 4) st[threadIdx.x] = 0u;
  __syncthreads();
  XcdBarrier xb = xcd_barrier_post((unsigned*)(P.ws + OFF_BAR), st);
  RUNP(0); GSYNC();
  RUNP(1); GSYNC();
  RUNP(2); GSYNC();
  RUNP(3); GSYNC();
#ifdef ATT_REP
  phase_attn<ATT_REP>(P, smem); GSYNC();
#endif
  RUNP(4); GSYNC();
  RUNP(5); GSYNC();
  RUNP(6); GSYNC();
  RUNP(7); GSYNC();
#if REP_PHASE == 9
  phase_peer_pass<0, 2>(P, xb.x); GSYNC();
#endif
  RUNP(9); GSYNC();
  RUNP(10); GSYNC();
#if REP_PHASE == 11
  phase_peer_pass<1, 3>(P, xb.x); GSYNC();
#endif
  run_phase<11>(P, smem, xb.x); GSYNC();
  run_phase<12>(P, smem, xb.x);
}

extern "C" void kernel_launch(void* const* d_in, const int* in_sizes, int n_in, void* d_out, int out_size, void* d_ws,
                              size_t ws_size, hipStream_t stream) {
  (void)in_sizes; (void)n_in; (void)out_size; (void)ws_size;
  Params P{};
  const float** pp = (const float**)&P;
  for (int i = 0; i < 22; ++i) pp[i] = (const float*)d_in[i];
  P.out = (float*)d_out;
  P.ws = (char*)d_ws;
  constexpr size_t kDynLds = SMEM_BYTES + 16 + 4096;
  static int grid = 0;
  if (!grid) {
    int dev = 0, cus = 0, per_cu = 0;
    (void)hipGetDevice(&dev);
    (void)hipDeviceGetAttribute(&cus, hipDeviceAttributeMultiprocessorCount, dev);
    (void)hipFuncSetAttribute((const void*)k_mega, hipFuncAttributeMaxDynamicSharedMemorySize, (int)kDynLds);
    (void)hipOccupancyMaxActiveBlocksPerMultiprocessor(&per_cu, k_mega, NT, kDynLds);
    if (per_cu > 1) per_cu = 1;
    if (per_cu < 1) per_cu = 1;
    grid = cus * per_cu;
  }
  void* args[] = {&P};
  (void)hipMemsetAsync((char*)d_ws + OFF_BAR, 0, BAR_MEMSET_BYTES, stream);
  hipError_t e = hipLaunchCooperativeKernel((void*)k_mega, dim3(grid), dim3(NT), args, kDynLds, stream);
  if (e != hipSuccess) fprintf(stderr, "cooperative launch failed: %s\n", hipGetErrorString(e));
}

#ifdef PHASE_KERNELS
template <int PH>
__global__ void __launch_bounds__(512, 2) k_phase(Params P) {
  extern __shared__ __attribute__((aligned(16))) char smem[];
  run_phase<PH>(P, smem, xb_xcc_id());
}
template __global__ void k_phase<0>(Params);
template __global__ void k_phase<1>(Params);
template __global__ void k_phase<2>(Params);
template __global__ void k_phase<3>(Params);
template __global__ void k_phase<4>(Params);
template __global__ void k_phase<5>(Params);
template __global__ void k_phase<6>(Params);
template __global__ void k_phase<7>(Params);
template __global__ void k_phase<8>(Params);
template __global__ void k_phase<9>(Params);
template __global__ void k_phase<10>(Params);
template __global__ void k_phase<11>(Params);
template __global__ void k_phase<12>(Params);
#endif
```
